# Optimizing an MI355X kernel written in HIP

```python
import jax, jax.numpy as jnp
from jax import lax
import numpy as np

D_MODEL = 2048
BATCH = 2
SEQ = 4096
DEPTH = 1

HEAD_DIM = 128
ATTN_Q_HEADS = 8
ATTN_KV_HEADS = 2
ATTN_GROUP = ATTN_Q_HEADS // ATTN_KV_HEADS
WINDOW = 128
ATTN_BLOCK = 128
ROPE_THETA = 10000.0
RET_HEADS = 8
RET_QK_DIM = 128
RET_V_DIM = 256
RET_CHUNK = 128
PEER_HEADS = 8
PEER_N_KEYS = 128
PEER_N_EXPERTS = PEER_N_KEYS * PEER_N_KEYS
PEER_TOPK = 16
PEER_KEY_DIM = 256
PEER_HALF_DIM = PEER_KEY_DIM // 2
PEER_TOKEN_BLOCK = 128
NORM_EPS = 1e-6

ATTN_Q_W = ATTN_Q_HEADS * HEAD_DIM
ATTN_KV_W = ATTN_KV_HEADS * HEAD_DIM
RET_QK_W = RET_HEADS * RET_QK_DIM
RET_V_W = RET_HEADS * RET_V_DIM
IN_WIDTHS = (ATTN_Q_W, ATTN_KV_W, ATTN_KV_W, RET_QK_W, RET_QK_W, RET_V_W, RET_V_W, D_MODEL, D_MODEL)
IN_WIDTH = ATTN_Q_W + 2 * ATTN_KV_W + 2 * RET_QK_W + 2 * RET_V_W + 2 * D_MODEL

kernel_name = "hybrid_swa_retention_peer_block"


def _split_points():
    pts, acc = [], 0
    for w in IN_WIDTHS[:-1]:
        acc += w
        pts.append(acc)
    return pts


def rmsnorm(x, g):
    xf = x.astype(jnp.float32)
    y = xf * lax.rsqrt(jnp.mean(xf * xf, axis=-1, keepdims=True) + NORM_EPS)
    return (y * g.astype(jnp.float32)).astype(x.dtype)


def rope_tables(seq):
    pos = jnp.arange(seq, dtype=jnp.float32)
    inv_freq = 1.0 / (ROPE_THETA ** (jnp.arange(0, HEAD_DIM, 2, dtype=jnp.float32) / HEAD_DIM))
    ang = pos[:, None] * inv_freq[None, :]
    return jnp.cos(ang)[:, None, :], jnp.sin(ang)[:, None, :]


def apply_rope(x, cos, sin):
    cos = cos.astype(x.dtype)
    sin = sin.astype(x.dtype)
    x1, x2 = jnp.split(x, 2, axis=-1)
    return jnp.concatenate([x1 * cos - x2 * sin, x2 * cos + x1 * sin], axis=-1)


def sliding_window_attention(q, k, v, sinks, cos, sin):
    B, S, _ = q.shape
    C = ATTN_BLOCK
    N = S // C
    q = apply_rope(q.reshape(B, S, ATTN_Q_HEADS, HEAD_DIM), cos, sin)
    k = apply_rope(k.reshape(B, S, ATTN_KV_HEADS, HEAD_DIM), cos, sin)
    v = v.reshape(B, S, ATTN_KV_HEADS, HEAD_DIM)
    qb = q.reshape(B, N, C, ATTN_KV_HEADS, ATTN_GROUP, HEAD_DIM)

    def banded(t):
        tb = t.reshape(B, N, C, ATTN_KV_HEADS, HEAD_DIM)
        prev = jnp.concatenate([jnp.zeros_like(tb[:, :1]), tb[:, :-1]], axis=1)
        return jnp.concatenate([prev, tb], axis=2)

    kb, vb = banded(k), banded(v)
    scores = jnp.einsum('bnqhgd,bnkhd->bhgnqk', qb, kb).astype(jnp.float32) * (HEAD_DIM ** -0.5)
    qi = jnp.arange(C)[:, None]
    kj = jnp.arange(2 * C)[None, :]
    diff = qi + C - kj
    blk = jnp.arange(N)[:, None, None]
    allowed = (diff >= 0) & (diff < WINDOW) & ((blk > 0) | (kj >= C))
    scores = jnp.where(allowed, scores, jnp.float32(-1e30))
    sink = sinks.astype(jnp.float32).reshape(ATTN_KV_HEADS, ATTN_GROUP)[None, :, :, None, None, None]
    sink = jnp.broadcast_to(sink, scores.shape[:-1] + (1,))
    probs = jax.nn.softmax(jnp.concatenate([scores, sink], axis=-1), axis=-1)[..., :-1]
    out = jnp.einsum('bhgnqk,bnkhd->bnqhgd', probs.astype(v.dtype), vb)
    return out.reshape(B, S, ATTN_Q_W)


def retention(q, k, v, g, cos, sin):
    B, S, _ = q.shape
    C = RET_CHUNK
    N = S // C
    H = RET_HEADS
    q = apply_rope(q.reshape(B, S, H, RET_QK_DIM), cos, sin)
    k = apply_rope(k.reshape(B, S, H, RET_QK_DIM), cos, sin) * (RET_QK_DIM ** -0.5)
    v = v.reshape(B, S, H, RET_V_DIM)
    qc = q.reshape(B, N, C, H, RET_QK_DIM).transpose(0, 3, 1, 2, 4).astype(jnp.float32)
    kc = k.reshape(B, N, C, H, RET_QK_DIM).transpose(0, 3, 1, 2, 4).astype(jnp.float32)
    vc = v.reshape(B, N, C, H, RET_V_DIM).transpose(0, 3, 1, 2, 4).astype(jnp.float32)

    log_gamma = jnp.log(1.0 - 2.0 ** (-5.0 - jnp.arange(H, dtype=jnp.float32)))
    pos = jnp.arange(C, dtype=jnp.float32)
    d = pos[:, None] - pos[None, :]
    decay_mask = jnp.where(d >= 0, jnp.exp(log_gamma[:, None, None] * jnp.maximum(d, 0.0)), 0.0)
    inner = jnp.einsum('bhncd,bhnkd->bhnck', qc, kc) * decay_mask[None, :, None]
    o_intra = jnp.einsum('bhnck,bhnke->bhnce', inner, vc)

    k_decay = jnp.exp(log_gamma[:, None] * (C - 1.0 - pos)[None, :])
    q_decay = jnp.exp(log_gamma[:, None] * (pos + 1.0)[None, :])
    chunk_decay = jnp.exp(log_gamma * C)
    kv = jnp.einsum('bhnkd,bhnke->bhnde', kc * k_decay[None, :, None, :, None], vc)

    def step(state, kv_n):
        return state * chunk_decay[None, :, None, None] + kv_n, state

    init = jnp.zeros((B, H, RET_QK_DIM, RET_V_DIM), jnp.float32)
    _, prev_states = lax.scan(step, init, kv.transpose(2, 0, 1, 3, 4))
    prev_states = prev_states.transpose(1, 2, 0, 3, 4)
    o_cross = jnp.einsum('bhncd,bhnde->bhnce', qc * q_decay[None, :, None, :, None], prev_states)
    o = (o_intra + o_cross).transpose(0, 2, 3, 1, 4).reshape(B, S, H, RET_V_DIM)
    mu = jnp.mean(o, axis=-1, keepdims=True)
    var = jnp.mean(jnp.square(o - mu), axis=-1, keepdims=True)
    o = ((o - mu) * lax.rsqrt(var + NORM_EPS)).astype(g.dtype).reshape(B, S, RET_V_W)
    return o * jax.nn.silu(g)


def peer(x, w_query, sub_keys, expert_down, expert_up):
    B, S, D = x.shape
    T = B * S
    H, K = PEER_HEADS, PEER_TOPK
    xt = x.reshape(T, D)
    qry = (xt @ w_query).reshape(T, H, 2, PEER_HALF_DIM)
    s = jnp.einsum('thpd,phnd->thpn', qry, sub_keys).astype(jnp.float32)
    top_s, top_i = lax.top_k(s, K)
    cand_s = top_s[:, :, 0, :, None] + top_s[:, :, 1, None, :]
    cand_i = top_i[:, :, 0, :, None] * PEER_N_KEYS + top_i[:, :, 1, None, :]
    best_s, best_pos = lax.top_k(cand_s.reshape(T, H, K * K), K)
    expert_idx = jnp.take_along_axis(cand_i.reshape(T, H, K * K), best_pos, axis=-1)
    gates = jax.nn.softmax(best_s, axis=-1).astype(x.dtype)
    nb = T // PEER_TOKEN_BLOCK

    def block(args):
        xb, ib, gb = args
        u = expert_down[ib]
        act = jax.nn.gelu(jnp.einsum('td,thkd->thk', xb, u), approximate=False)
        vv = expert_up[ib]
        return jnp.einsum('thk,thkd->td', gb * act, vv)

    y = lax.map(block, (xt.reshape(nb, PEER_TOKEN_BLOCK, D),
                        expert_idx.reshape(nb, PEER_TOKEN_BLOCK, H, K),
                        gates.reshape(nb, PEER_TOKEN_BLOCK, H, K)))
    return y.reshape(B, S, D)


def setup_inputs(seed: int = 0) -> dict:
    key = jax.random.key(seed)
    ks = jax.random.split(key, 14)
    f32 = jnp.float32
    L, D = DEPTH, D_MODEL
    nrm = lambda k, shape, scale: jax.random.normal(k, shape, f32) * scale
    return {
        "x": jax.random.normal(ks[0], (BATCH, SEQ, D), f32),
        "attn_norm": 1.0 + nrm(ks[1], (L, D), 0.02),
        "w_in": nrm(ks[2], (L, D, IN_WIDTH), D ** -0.5),
        "attn_sinks": nrm(ks[3], (L, ATTN_Q_HEADS), 0.5),
        "w_attn_branch": nrm(ks[4], (L, ATTN_Q_W, D), ATTN_Q_W ** -0.5),
        "w_ret_branch": nrm(ks[5], (L, RET_V_W, D), RET_V_W ** -0.5),
        "w_out": nrm(ks[6], (L, D, D), D ** -0.5),
        "ffn_norm": 1.0 + nrm(ks[7], (L, D), 0.02),
        "w_peer_query": nrm(ks[8], (L, D, PEER_HEADS * PEER_KEY_DIM), D ** -0.5),
        "peer_sub_keys": nrm(ks[9], (L, 2, PEER_HEADS, PEER_N_KEYS, PEER_HALF_DIM), PEER_HALF_DIM ** -0.5),
        "peer_expert_down": nrm(ks[10], (L, PEER_N_EXPERTS, D), D ** -0.5),
        "peer_expert_up": nrm(ks[11], (L, PEER_N_EXPERTS, D), PEER_HEADS ** -0.5),
        "final_norm": 1.0 + nrm(ks[12], (D,), 0.02),
    }


def reference(x, attn_norm, w_in, attn_sinks, w_attn_branch, w_ret_branch, w_out, ffn_norm,
              w_peer_query, peer_sub_keys, peer_expert_down, peer_expert_up, final_norm):
    S = x.shape[1]
    cos, sin = rope_tables(S)
    splits = _split_points()
    h = x
    for layer in range(DEPTH):
        xn = rmsnorm(h, attn_norm[layer])
        proj = xn @ w_in[layer]
        q_a, k_a, v_a, q_r, k_r, v_r, g_r, gate_a, gate_r = jnp.split(proj, splits, axis=-1)
        y_a = sliding_window_attention(q_a, k_a, v_a, attn_sinks[layer], cos, sin) @ w_attn_branch[layer]
        y_r = retention(q_r, k_r, v_r, g_r, cos, sin) @ w_ret_branch[layer]
        merged = jax.nn.sigmoid(gate_a) * y_a + jax.nn.sigmoid(gate_r) * y_r
        h = h + merged @ w_out[layer]
        hn = rmsnorm(h, ffn_norm[layer])
        h = h + peer(hn, w_peer_query[layer], peer_sub_keys[layer],
                     peer_expert_down[layer], peer_expert_up[layer])
    return rmsnorm(h, final_norm)
```

```cpp
#include <hip/hip_runtime.h>
#include <hip/hip_cooperative_groups.h>
#include <cstdio>
#include <cstdint>
namespace cg = cooperative_groups;
namespace pg8 {
#define PG8_LAS __attribute__((address_space(3)))
typedef unsigned short bf16_t;
typedef short bf16x8 __attribute__((ext_vector_type(8)));
typedef float f32x4 __attribute__((ext_vector_type(4)));
typedef unsigned u32x4 __attribute__((ext_vector_type(4)));
typedef unsigned u32x2 __attribute__((ext_vector_type(2)));
typedef int i32x4_t __attribute__((ext_vector_type(4)));
typedef int i32x8_t __attribute__((ext_vector_type(8)));
constexpr int BM = 256, BK = 64, HALF = 128, HTB = HALF * BK * 2  , STAGE_BYTES = 8 * HTB, NXCD = 8, WGM = 8;

__host__ __device__ __forceinline__ int lds_byte(int r, int c) { const int st = (r >> 4) * 2 + (c >> 5), rr = r & 15, cc = c & 31, ob = rr * 64 + cc * 2; return st * 1024 + (ob ^ (((ob >> 9) & 1) << 5)); }
__host__ __device__ __forceinline__ void stage_rc(int b, int& R, int& C) { const int st = b / 1024, sb = b % 1024, swz = sb ^ (((sb >> 9) & 1) << 5); R = (st >> 1) * 16 + swz / 64; C = (st & 1) * 32 + (swz % 64) / 2; }
__host__ __device__ __forceinline__ int perm32(int rho) { const int n = rho >> 4, i = rho & 15; return 8 * (i >> 2) + 4 * n + (i & 3); }

struct Unit { int pm, pn; };
struct Gemm { const bf16_t* A; const bf16_t* Bt; int M, N, K; };

struct StaticOrder {
    int nM, nN, nwg, G, c;
    __host__ __device__ void init(int M, int N, int G_, int c_) { nM = M / BM; nN = N / BM; nwg = nM * nN; G = G_; c = c_; }
    __host__ __device__ bool next(int i, Unit& u) const {
        const long L = (long)i * G + c; if (L >= nwg) return false;
        int wgid = (int)L; { const int q = nwg / NXCD, r = nwg % NXCD, xcd = wgid % NXCD, off = wgid / NXCD; wgid = (xcd < r ? xcd * (q + 1) : r * (q + 1) + (xcd - r) * q) + off; }
        const int nig = WGM * nN, gid = wgid / nig, fm = gid * WGM, gsz = (nM - fm) < WGM ? (nM - fm) : WGM;
        u.pm = fm + ((wgid % nig) % gsz); u.pn = (wgid % nig) / gsz; return true;
    }
    __device__ __forceinline__ void a_ready(const Unit&) const {}
    __device__ __forceinline__ void done(const Unit&) const {}
};

__device__ __forceinline__ unsigned cvt_pk_bf16(float lo, float hi) { unsigned r; asm volatile("v_cvt_pk_bf16_f32 %0, %1, %2" : "=v"(r) : "v"(lo), "v"(hi)); return r; }
typedef float f32x2 __attribute__((ext_vector_type(2)));
__device__ __forceinline__ f32x2 gelu_pk(f32x2 v) {
    const f32x2 av = __builtin_elementwise_abs(v), d = av * 0.2316418882f + 1.0f;
    f32x2 t; t.x = __builtin_amdgcn_rcpf(d.x); t.y = __builtin_amdgcn_rcpf(d.y);
    f32x2 q = t * 0.5307027145f + (-0.7265760135f); q = q * t + 0.7107068705f; q = q * t + (-0.142248368f); q = q * t + 0.127414796f; q = q * t;
    const f32x2 s = (v * v) * (-0.72134752044f);
    f32x2 e; e.x = __builtin_amdgcn_exp2f(s.x); e.y = __builtin_amdgcn_exp2f(s.y);
    const f32x2 m = v * (q * e), r = v - m;
    f32x2 o; o.x = v.x < 0.f ? m.x : r.x; o.y = v.y < 0.f ? m.y : r.y; return o;
}

constexpr float QA_SCALE = 0.08838834764831845f * 1.4426950408889634f;
constexpr float KR_SCALE = 0.08838834764831845f;
constexpr int NPROJ = 11776;
__device__ __forceinline__ f32x4 rope4(f32x4 v, f32x4 cs) {
    f32x4 o; o[0] = v[0] * cs[0] - v[1] * cs[1]; o[1] = v[1] * cs[0] + v[0] * cs[1]; o[2] = v[2] * cs[2] - v[3] * cs[3]; o[3] = v[3] * cs[2] + v[2] * cs[3]; return o;
}
__device__ __forceinline__ float sigm(float x) { return __builtin_amdgcn_rcpf(1.0f + __builtin_amdgcn_exp2f(x * -1.4426950408889634f)); }
struct EpiProj {
    static constexpr bool PERM = true, AFTER_DRAIN = false;
    bf16_t* O; const float* r1; const f32x4* rope; float fixed; unsigned char* G8;
    __device__ __forceinline__ void operator()(const f32x4 (&acc)[2][2][4][2], const Unit& u, int wr, int wc, int fr, int fq) const {
        asm volatile("" : "+v"(fr), "+v"(fq));
        const int colt = u.pn * BM;
        int mode; float sc = 1.f;
        if (colt < 1024) { mode = 1; sc = QA_SCALE; } else if (colt < 1280) mode = 1; else if (colt < 1536) mode = 0;
        else if (colt < 2560) mode = 1; else if (colt < 3584) { mode = 1; sc = KR_SCALE; } else if (colt < 5632) mode = 0;
        else if (colt < 7680) mode = 2; else mode = 3;
        const int row0 = u.pm * BM + wr * 64 + fr, col0 = colt + wc * 32 + 8 * fq;
        float rsv[2][4];
#pragma unroll
        for (int ai = 0; ai < 2; ++ai)
#pragma unroll
            for (int m = 0; m < 4; ++m) rsv[ai][m] = (fixed != 0.f) ? fixed : r1[row0 + ai * HALF + m * 16];
#pragma unroll
        for (int ai = 0; ai < 2; ++ai)
#pragma unroll
            for (int m = 0; m < 4; ++m) {
                const int row = row0 + ai * HALF + m * 16; const float rs = rsv[ai][m] * sc;
                bf16_t* rowp = O + (size_t)row * NPROJ + col0;
                f32x4 cs0 = {1.f, 0.f, 1.f, 0.f}, cs1 = {1.f, 0.f, 1.f, 0.f};
                if (mode == 1) { const f32x4* rp = rope + (size_t)(row & 4095) * 32 + 8 * wc + 2 * fq; cs0 = rp[0]; cs1 = rp[1]; }
#pragma unroll
                for (int bj = 0; bj < 2; ++bj) {
                    f32x4 v0 = acc[ai][bj][m][0] * rs, v1 = acc[ai][bj][m][1] * rs;
                    if (mode == 1) { v0 = rope4(v0, cs0); v1 = rope4(v1, cs1); }
                    else if (mode == 2) {
#pragma unroll
                        for (int i = 0; i < 4; ++i) { v0[i] = v0[i] * sigm(v0[i]); v1[i] = v1[i] * sigm(v1[i]); } }
                    else if (mode == 3) {
#pragma unroll
                        for (int i = 0; i < 4; ++i) { v0[i] = sigm(v0[i]); v1[i] = sigm(v1[i]); } }
                    if (mode == 3) {
                        unsigned q[8];
#pragma unroll
                        for (int i = 0; i < 4; ++i) { q[i] = __builtin_bit_cast(unsigned, __builtin_fmaf(v0[i], 255.0f, 8388608.0f)); q[4 + i] = __builtin_bit_cast(unsigned, __builtin_fmaf(v1[i], 255.0f, 8388608.0f)); }
                        u32x2 o; o.x = __builtin_amdgcn_perm(__builtin_amdgcn_perm(q[3], q[2], 0x0c0c0400u), __builtin_amdgcn_perm(q[1], q[0], 0x0c0c0400u), 0x05040100u);
                        o.y = __builtin_amdgcn_perm(__builtin_amdgcn_perm(q[7], q[6], 0x0c0c0400u), __builtin_amdgcn_perm(q[5], q[4], 0x0c0c0400u), 0x05040100u);
                        *(u32x2*)(G8 + (size_t)row * 4096 + (col0 - 7680) + bj * HALF) = o; }
                    else { u32x4 w; w.x = cvt_pk_bf16(v0[0], v0[1]); w.y = cvt_pk_bf16(v0[2], v0[3]); w.z = cvt_pk_bf16(v1[0], v1[1]); w.w = cvt_pk_bf16(v1[2], v1[3]);
                    *(u32x4*)(rowp + bj * HALF) = w; } }
            }
    }
};
__device__ __forceinline__ float bf_lo(unsigned u) { return __uint_as_float(u << 16); }
__device__ __forceinline__ float bf_hi(unsigned u) { return __uint_as_float(u & 0xffff0000u); }
struct EpiGate1 {
    static constexpr bool PERM = true, AFTER_DRAIN = false;
    bf16_t* TMP; const unsigned char* G; int gcol; float fixed;
    __device__ __forceinline__ void operator()(const f32x4 (&acc)[2][2][4][2], const Unit& u, int wr, int wc, int fr, int fq) const {
        const int row0 = u.pm * BM + wr * 64 + fr, col0 = u.pn * BM + wc * 32 + 8 * fq;
#pragma unroll
        for (int ai = 0; ai < 2; ++ai)
#pragma unroll
            for (int m = 0; m < 4; ++m) { const int row = row0 + ai * HALF + m * 16;
#pragma unroll
                for (int bj = 0; bj < 2; ++bj) { const int col = col0 + bj * HALF;
                    const u32x2 gq = *(const u32x2*)(G + (size_t)row * 4096 + gcol + col); const unsigned g0 = gq.x, g1 = gq.y;
                    const float fx = fixed * (1.0f / 255.0f);
                    f32x4 v0 = acc[ai][bj][m][0] * fx, v1 = acc[ai][bj][m][1] * fx;
                    v0[0] *= (float)(g0 & 255u); v0[1] *= (float)((g0 >> 8) & 255u); v0[2] *= (float)((g0 >> 16) & 255u); v0[3] *= (float)(g0 >> 24);
                    v1[0] *= (float)(g1 & 255u); v1[1] *= (float)((g1 >> 8) & 255u); v1[2] *= (float)((g1 >> 16) & 255u); v1[3] *= (float)(g1 >> 24);
                    u32x4 w; w.x = cvt_pk_bf16(v0[0], v0[1]); w.y = cvt_pk_bf16(v0[2], v0[3]); w.z = cvt_pk_bf16(v1[0], v1[1]); w.w = cvt_pk_bf16(v1[2], v1[3]);
                    *(u32x4*)(TMP + (size_t)row * 2048 + col) = w; } }
    }
};
struct EpiGate2 {
    static constexpr bool PERM = true, AFTER_DRAIN = false;
    const bf16_t* TMP; const unsigned char* G; int gcol; bf16_t* MG; float fixed; float out8;
    __device__ __forceinline__ void operator()(const f32x4 (&acc)[2][2][4][2], const Unit& u, int wr, int wc, int fr, int fq) const {
        const int row0 = u.pm * BM + wr * 64 + fr, col0 = u.pn * BM + wc * 32 + 8 * fq;
#pragma unroll
        for (int ai = 0; ai < 2; ++ai)
#pragma unroll
            for (int m = 0; m < 4; ++m) { const int row = row0 + ai * HALF + m * 16;
#pragma unroll
                for (int bj = 0; bj < 2; ++bj) { const int col = col0 + bj * HALF;
                    const u32x2 gq = *(const u32x2*)(G + (size_t)row * 4096 + gcol + col); const unsigned g0 = gq.x, g1 = gq.y;
                    const float fx = fixed * (1.0f / 255.0f);
                    const u32x4 tq = *(const u32x4*)(TMP + (size_t)row * 2048 + col); const f32x4 t0 = {bf_lo(tq.x), bf_hi(tq.x), bf_lo(tq.y), bf_hi(tq.y)}, t1 = {bf_lo(tq.z), bf_hi(tq.z), bf_lo(tq.w), bf_hi(tq.w)};
                    f32x4 v0 = acc[ai][bj][m][0] * fx, v1 = acc[ai][bj][m][1] * fx;
                    v0[0] = t0[0] + v0[0] * (float)(g0 & 255u); v0[1] = t0[1] + v0[1] * (float)((g0 >> 8) & 255u); v0[2] = t0[2] + v0[2] * (float)((g0 >> 16) & 255u); v0[3] = t0[3] + v0[3] * (float)(g0 >> 24);
                    v1[0] = t1[0] + v1[0] * (float)(g1 & 255u); v1[1] = t1[1] + v1[1] * (float)((g1 >> 8) & 255u); v1[2] = t1[2] + v1[2] * (float)((g1 >> 16) & 255u); v1[3] = t1[3] + v1[3] * (float)(g1 >> 24);
                    if (out8 != 0.f) { v0 = v0 * out8; v1 = v1 * out8;
#pragma unroll
                        for (int i = 0; i < 4; ++i) { v0[i] = fminf(fmaxf(v0[i], -448.f), 448.f); v1[i] = fminf(fmaxf(v1[i], -448.f), 448.f); }
                        int p0 = 0, p1 = 0; p0 = __builtin_amdgcn_cvt_pk_fp8_f32(v0[0], v0[1], p0, false); p0 = __builtin_amdgcn_cvt_pk_fp8_f32(v0[2], v0[3], p0, true);
                        p1 = __builtin_amdgcn_cvt_pk_fp8_f32(v1[0], v1[1], p1, false); p1 = __builtin_amdgcn_cvt_pk_fp8_f32(v1[2], v1[3], p1, true);
                        f32x2 o; o.x = __builtin_bit_cast(float, p0); o.y = __builtin_bit_cast(float, p1); *(f32x2*)((unsigned char*)MG + (size_t)row * 2048 + col) = o; }
                    else { u32x4 w; w.x = cvt_pk_bf16(v0[0], v0[1]); w.y = cvt_pk_bf16(v0[2], v0[3]); w.z = cvt_pk_bf16(v1[0], v1[1]); w.w = cvt_pk_bf16(v1[2], v1[3]);
                    *(u32x4*)(MG + (size_t)row * 2048 + col) = w; } } }
    }
};
struct EpiHres {
    static constexpr bool PERM = true, AFTER_DRAIN = false;
    const float* X; bf16_t* Hb; float* ssq; float fixed;
    __device__ __forceinline__ void operator()(const f32x4 (&acc)[2][2][4][2], const Unit& u, int wr, int wc, int fr, int fq) const {
        const int row0 = u.pm * BM + wr * 64 + fr, col0 = u.pn * BM + wc * 32 + 8 * fq;
#pragma unroll
        for (int ai = 0; ai < 2; ++ai)
#pragma unroll
            for (int m = 0; m < 4; ++m) { const int row = row0 + ai * HALF + m * 16; float ss = 0.f;
#pragma unroll
                for (int bj = 0; bj < 2; ++bj) { const size_t off = (size_t)row * 2048 + col0 + bj * HALF;
                    const f32x4 x0 = *(const f32x4*)(X + off), x1 = *(const f32x4*)(X + off + 4);
                    const f32x4 v0 = acc[ai][bj][m][0] * fixed + x0, v1 = acc[ai][bj][m][1] * fixed + x1;
                    u32x4 w; w.x = cvt_pk_bf16(v0[0], v0[1]); w.y = cvt_pk_bf16(v0[2], v0[3]); w.z = cvt_pk_bf16(v1[0], v1[1]); w.w = cvt_pk_bf16(v1[2], v1[3]);
                    *(u32x4*)(Hb + off) = w;
                    ss += (v0[0] * v0[0] + v0[1] * v0[1]) + (v0[2] * v0[2] + v0[3] * v0[3]) + (v1[0] * v1[0] + v1[1] * v1[1]) + (v1[2] * v1[2] + v1[3] * v1[3]); }
                ss += __shfl_xor(ss, 16); ss += __shfl_xor(ss, 32);
                if (fq == 0) atomicAdd(ssq + row, ss); }
    }
};
struct EpiQry {
    static constexpr bool PERM = true, AFTER_DRAIN = false;
    bf16_t* Q; const float* ssq;
    __device__ __forceinline__ void operator()(const f32x4 (&acc)[2][2][4][2], const Unit& u, int wr, int wc, int fr, int fq) const {
        const int row0 = u.pm * BM + wr * 64 + fr, col0 = u.pn * BM + wc * 32 + 8 * fq;
#pragma unroll
        for (int ai = 0; ai < 2; ++ai)
#pragma unroll
            for (int m = 0; m < 4; ++m) { const int row = row0 + ai * HALF + m * 16;
                const float rs = 1.0f / sqrtf(__hip_atomic_load(ssq + row, __ATOMIC_RELAXED, __HIP_MEMORY_SCOPE_AGENT) * (1.0f / 2048.0f) + 1e-6f);
#pragma unroll
                for (int bj = 0; bj < 2; ++bj) { const f32x4 v0 = acc[ai][bj][m][0] * rs, v1 = acc[ai][bj][m][1] * rs;
                    u32x4 w; w.x = cvt_pk_bf16(v0[0], v0[1]); w.y = cvt_pk_bf16(v0[2], v0[3]); w.z = cvt_pk_bf16(v1[0], v1[1]); w.w = cvt_pk_bf16(v1[2], v1[3]);
                    *(u32x4*)(Q + (size_t)row * 2048 + col0 + bj * HALF) = w; } }
    }
};

template <class Epi, class Sched, bool ALIGN_EPI = false, bool SP2 = false, bool FP8 = false>
__device__ __forceinline__ void gemm_phase(PG8_LAS unsigned char* lds, const Gemm g, const Sched& S, const Epi& E) {
    const int tid = threadIdx.x, wid = __builtin_amdgcn_readfirstlane(tid >> 6), lane = tid & 63, wr = wid >> 2, wc = wid & 3, fr = lane & 15, fq = lane >> 4;
    const int K = g.K, nt = K / BK;
    unsigned voffA[2], voffB[2];
#pragma unroll
    for (int i = 0; i < 2; ++i) { int R, C; stage_rc(tid * 16 + i * 8192, R, C); const int Rb = Epi::PERM ? ((R & ~31) + perm32(R & 31)) : R;
        voffA[i] = (unsigned)(R * K + C) * 2u; voffB[i] = (unsigned)(Rb * K + C) * 2u; }
    const size_t kstep = (size_t)(BK * 2);
    const size_t hstep = (size_t)HALF * K * 2;
    const size_t tstep = 2 * hstep;
    const unsigned ldsw = (unsigned)wid * 1024u;
    const int aoff = lds_byte(wr * 64 + fr, fq * 8), boff = lds_byte(wc * 32 + fr, fq * 8);
#define PG8_SA(b, h) (((b) * 2 + (h)) * HTB)
#define PG8_SB(b, h) ((4 + (b) * 2 + (h)) * HTB)
#define PG8_STAGE(bufoff, gbase, voff) do { _Pragma("unroll") for (int _i = 0; _i < 2; ++_i) \
        __builtin_amdgcn_global_load_lds((const unsigned*)((const char*)(gbase) + (voff)[_i]), (PG8_LAS unsigned*)(lds + (bufoff) + ldsw + _i * 8192), 16, 0, 0); } while (0)
#define PG8_LD8(p_) ({ const i32x4_t lo_ = *(const PG8_LAS i32x4_t*)(p_), hi_ = *(const PG8_LAS i32x4_t*)((p_) + 1024); (i32x8_t){lo_[0], lo_[1], lo_[2], lo_[3], hi_[0], hi_[1], hi_[2], hi_[3]}; })
#define PG8_LDA(dst, b, h) do { if constexpr (FP8) { _Pragma("unroll") for (int m = 0; m < 4; ++m) dst##8[m] = PG8_LD8(lds + PG8_SA(b, h) + aoff + m * 2048); } \
        else { _Pragma("unroll") for (int m = 0; m < 4; ++m) _Pragma("unroll") for (int k = 0; k < 2; ++k) dst[m][k] = *(const PG8_LAS bf16x8*)(lds + PG8_SA(b, h) + aoff + m * 2048 + k * 1024); } } while (0)
#define PG8_LDB(dst, b, h) do { if constexpr (FP8) { _Pragma("unroll") for (int n = 0; n < 2; ++n) dst##8[n] = PG8_LD8(lds + PG8_SB(b, h) + boff + n * 2048); } \
        else { _Pragma("unroll") for (int n = 0; n < 2; ++n) _Pragma("unroll") for (int k = 0; k < 2; ++k) dst[n][k] = *(const PG8_LAS bf16x8*)(lds + PG8_SB(b, h) + boff + n * 2048 + k * 1024); } } while (0)
#define PG8_MMA(ai, bj, At, Bt) do { __builtin_amdgcn_s_setprio(1); \
        if constexpr (FP8) { _Pragma("unroll") for (int m = 0; m < 4; ++m) _Pragma("unroll") for (int n = 0; n < 2; ++n) \
            asm volatile("v_mfma_scale_f32_16x16x128_f8f6f4 %0, %1, %2, %0, %3, %3 op_sel_hi:[0,0,0]" : "+v"(acc[ai][bj][m][n]) : "v"(Bt##8[n]), "v"(At##8[m]), "v"(one_scale)); } \
              \
        else { _Pragma("unroll") for (int m = 0; m < 4; ++m) _Pragma("unroll") for (int n = 0; n < 2; ++n) _Pragma("unroll") for (int k = 0; k < 2; ++k) \
            acc[ai][bj][m][n] = __builtin_amdgcn_mfma_f32_16x16x32_bf16(Bt[n][k], At[m][k], acc[ai][bj][m][n], 0, 0, 0); } \
        __builtin_amdgcn_s_setprio(0); } while (0)
#define PG8_WAIT_V(n) asm volatile("s_waitcnt vmcnt(" #n ")" ::: "memory")
#define PG8_WAIT_L(n) asm volatile("s_waitcnt lgkmcnt(" #n ")" ::: "memory")
#define PG8_BAR __builtin_amdgcn_s_barrier()
#define PG8_SCHED __builtin_amdgcn_sched_barrier(0)
    Unit cur, nxt; int ui = 0;
    if (!S.next(0, cur)) return;
    f32x4 acc[2][2][4][2];
#pragma unroll
    for (int a = 0; a < 2; ++a)
#pragma unroll
        for (int b = 0; b < 2; ++b)
#pragma unroll
            for (int m = 0; m < 4; ++m)
#pragma unroll
                for (int n = 0; n < 2; ++n) acc[a][b][m][n] = (f32x4){0.f, 0.f, 0.f, 0.f};
    int one_scale = 0x7f7f7f7f; asm volatile("" : "+v"(one_scale));
    bf16x8 At[4][2], B0[2][2], B1[2][2]; i32x8_t At8[4], B08[2], B18[2];
    const char* cA = (const char*)g.A + (size_t)cur.pm * tstep; const char* cB = (const char*)g.Bt + (size_t)cur.pn * tstep;
    S.a_ready(cur);
    if constexpr (SP2) {
        PG8_STAGE(PG8_SB(0, 0), cB, voffB); PG8_STAGE(PG8_SB(0, 1), cB + hstep, voffB); PG8_STAGE(PG8_SA(0, 0), cA, voffA); PG8_STAGE(PG8_SA(0, 1), cA + hstep, voffA);
        if (wr == 1) PG8_BAR;
        PG8_WAIT_V(2); PG8_BAR;
        PG8_STAGE(PG8_SB(1, 0), cB + kstep, voffB); PG8_STAGE(PG8_SA(1, 0), cA + kstep, voffA); PG8_STAGE(PG8_SB(1, 1), cB + hstep + kstep, voffB);
        PG8_WAIT_V(6); PG8_BAR;
    } else {
        PG8_STAGE(PG8_SB(0, 0), cB, voffB); PG8_STAGE(PG8_SA(0, 0), cA, voffA); PG8_STAGE(PG8_SB(0, 1), cB + hstep, voffB); PG8_STAGE(PG8_SA(0, 1), cA + hstep, voffA);
        if (wr == 1) PG8_BAR;
        PG8_WAIT_V(4); PG8_BAR;
        PG8_STAGE(PG8_SB(1, 0), cB + kstep, voffB); PG8_STAGE(PG8_SA(1, 0), cA + kstep, voffA); PG8_STAGE(PG8_SB(1, 1), cB + hstep + kstep, voffB);
        PG8_WAIT_V(6); PG8_BAR;
    }
    for (;;) {
        const bool has_next = S.next(ui + 1, nxt);
        const char* nA = has_next ? (const char*)g.A + (size_t)nxt.pm * tstep : cA; const char* nB = has_next ? (const char*)g.Bt + (size_t)nxt.pn * tstep : cB;
        for (int t = 0; t < nt; t += 2) {
            const bool last = (t == nt - 2);
            const char* a1 = cA + (size_t)(t + 1) * kstep;
            const char* a2 = last ? nA : cA + (size_t)(t + 2) * kstep; const char* b2 = last ? nB : cB + (size_t)(t + 2) * kstep;
            const char* a3 = a2 + kstep; const char* b3 = b2 + kstep;
            if (last && has_next) S.a_ready(nxt);
            if constexpr (SP2) {
            PG8_LDB(B0, 0, 0); PG8_LDB(B1, 0, 1); PG8_SCHED; PG8_LDA(At, 0, 0); PG8_STAGE(PG8_SA(1, 1), a1 + hstep, voffA);
            PG8_WAIT_V(8); PG8_WAIT_L(0); PG8_BAR; PG8_MMA(0, 0, At, B0); PG8_MMA(0, 1, At, B1); PG8_BAR; PG8_SCHED;
            PG8_LDA(At, 0, 1); PG8_STAGE(PG8_SB(0, 0), b2, voffB); PG8_STAGE(PG8_SB(0, 1), b2 + hstep, voffB); PG8_STAGE(PG8_SA(0, 0), a2, voffA);
            PG8_WAIT_V(8); PG8_WAIT_L(0); PG8_BAR; PG8_MMA(1, 0, At, B0); PG8_MMA(1, 1, At, B1); PG8_BAR; PG8_SCHED;
            PG8_LDB(B0, 1, 0); PG8_LDB(B1, 1, 1); PG8_SCHED; PG8_LDA(At, 1, 0); PG8_STAGE(PG8_SA(0, 1), a2 + hstep, voffA);
            PG8_WAIT_V(8); PG8_WAIT_L(0); PG8_BAR; PG8_MMA(0, 0, At, B0); PG8_MMA(0, 1, At, B1); PG8_BAR; PG8_SCHED;
            PG8_LDA(At, 1, 1); PG8_STAGE(PG8_SB(1, 0), b3, voffB); PG8_STAGE(PG8_SB(1, 1), b3 + hstep, voffB); PG8_STAGE(PG8_SA(1, 0), a3, voffA);
            PG8_WAIT_V(8); PG8_WAIT_L(0); PG8_BAR; PG8_MMA(1, 0, At, B0); PG8_MMA(1, 1, At, B1); PG8_BAR; PG8_SCHED;
            } else {
            PG8_LDB(B0, 0, 0); PG8_SCHED; PG8_LDA(At, 0, 0); PG8_STAGE(PG8_SA(1, 1), a1 + hstep, voffA);
            PG8_WAIT_L(8); PG8_BAR; PG8_WAIT_L(0); PG8_MMA(0, 0, At, B0); PG8_BAR; PG8_SCHED;
            PG8_LDB(B1, 0, 1); PG8_STAGE(PG8_SB(0, 0), b2, voffB);
            PG8_BAR; PG8_WAIT_L(0); PG8_MMA(0, 1, At, B1); PG8_BAR;
            PG8_LDA(At, 0, 1); PG8_STAGE(PG8_SA(0, 0), a2, voffA);
            PG8_BAR; PG8_WAIT_L(0); PG8_MMA(1, 0, At, B0); PG8_BAR; PG8_SCHED;
            PG8_STAGE(PG8_SB(0, 1), b2 + hstep, voffB);
            PG8_WAIT_V(6); PG8_BAR; PG8_MMA(1, 1, At, B1); PG8_BAR;
            PG8_LDB(B0, 1, 0); PG8_SCHED; PG8_LDA(At, 1, 0); PG8_STAGE(PG8_SA(0, 1), a2 + hstep, voffA);
            PG8_WAIT_L(8); PG8_BAR; PG8_WAIT_L(0); PG8_MMA(0, 0, At, B0); PG8_BAR; PG8_SCHED;
            PG8_LDB(B1, 1, 1); PG8_STAGE(PG8_SB(1, 0), b3, voffB);
            PG8_BAR; PG8_WAIT_L(0); PG8_MMA(0, 1, At, B1); PG8_BAR;
            PG8_LDA(At, 1, 1); PG8_STAGE(PG8_SA(1, 0), a3, voffA);
            PG8_BAR; PG8_WAIT_L(0); PG8_MMA(1, 0, At, B0); PG8_BAR; PG8_SCHED;
            PG8_STAGE(PG8_SB(1, 1), b3 + hstep, voffB);
            PG8_WAIT_V(6); PG8_BAR; PG8_MMA(1, 1, At, B1); PG8_BAR;
            }
        }
        if constexpr (ALIGN_EPI) { if (wr == 0) PG8_BAR; }
        if constexpr (FP8) asm volatile("s_nop 15\n\ts_nop 15\n\ts_nop 7" ::: "memory");
        if constexpr (!Epi::AFTER_DRAIN) { E(acc, cur, wr, wc, fr, fq); S.done(cur); }
        if (!has_next) break;
#pragma unroll
        for (int a = 0; a < 2; ++a)
#pragma unroll
            for (int b = 0; b < 2; ++b)
#pragma unroll
                for (int m = 0; m < 4; ++m)
#pragma unroll
                    for (int n = 0; n < 2; ++n) { acc[a][b][m][n] = (f32x4){0.f, 0.f, 0.f, 0.f}; if constexpr (FP8) asm volatile("" : "+v"(acc[a][b][m][n])); }
        cur = nxt; cA = nA; cB = nB; ++ui;
        if constexpr (ALIGN_EPI) { if (wr == 1) PG8_BAR; }
    }
    PG8_WAIT_V(0);
    if constexpr (!ALIGN_EPI) { if (wr == 0) PG8_BAR; }
    PG8_BAR;
    if constexpr (Epi::AFTER_DRAIN) { E.fused(acc, cur, wr, wc, fr, fq, lds, wid, lane); S.done(cur); }
#undef PG8_SA
#undef PG8_SB
#undef PG8_STAGE
#undef PG8_LDA
#undef PG8_LDB
#undef PG8_MMA
#undef PG8_LD8
#undef PG8_WAIT_V
#undef PG8_WAIT_L
#undef PG8_BAR
#undef PG8_SCHED
}
}
#ifndef PEER_FP8
#define PEER_FP8 3
#endif
#define PEER_FP8_P0 (PEER_FP8 != 0)
namespace mk {
typedef unsigned short bf16;
typedef unsigned v4u __attribute__((ext_vector_type(4)));
typedef float f32x4 __attribute__((ext_vector_type(4)));
typedef float f32x2 __attribute__((ext_vector_type(2)));
#define LAS __attribute__((address_space(3)))
constexpr int T = 8192, DM = 2048, SEQ = 4096, NPROJ = 11776, NEXP = 16384, NWAVES = 8;
constexpr int C_QA = 0, C_KA = 1024, C_VA = 1280, C_QR = 1536, C_KR = 2560, C_VR = 3584, C_GR = 5632, C_GA = 7680, C_GT = 9728;
constexpr float EPS = 1e-6f, LOG2E = 1.4426950408889634f;
constexpr size_t MiB = 1u << 20;
constexpr size_t WS_CTL = 0, CTL_BYTES = 1 * MiB;
constexpr size_t WS_SSQ = 512 * 1024, WS_R1 = 768 * 1024;
constexpr size_t WS_ROPE = 1 * MiB;
constexpr size_t WS_SK = 3 * MiB;
constexpr size_t WS_WIN = 4 * MiB;
constexpr size_t WS_WA = 50 * MiB, WS_WR = 54 * MiB, WS_WO = 62 * MiB, WS_WQ = 70 * MiB;
constexpr size_t WS_ED = 78 * MiB, WS_EU = 142 * MiB;
constexpr size_t WS_XB = 206 * MiB;
constexpr size_t WS_PROJ = 238 * MiB;
constexpr size_t WS_AO = 422 * MiB, WS_RO = 438 * MiB;
constexpr size_t WS_IDX = 470 * MiB, WS_GATE = 474 * MiB, WS_END = 478 * MiB;
constexpr size_t WS_G8 = 104 * MiB;
constexpr int LDS_BYTES = 156672;
__constant__ float INV_FREQ[64] = {
1.000000000e+00f, 8.659643531e-01f, 7.498942018e-01f, 6.493816376e-01f, 5.623413324e-01f, 4.869675338e-01f, 4.216965139e-01f, 3.651741147e-01f, 3.162277639e-01f, 2.738419771e-01f, 2.371373922e-01f, 2.053525001e-01f, 1.778279394e-01f, 1.539926529e-01f, 1.333521456e-01f, 1.154782027e-01f, 1.000000015e-01f, 8.659642935e-02f, 7.498941571e-02f, 6.493816525e-02f, 5.623412877e-02f, 4.869675264e-02f, 4.216964915e-02f, 3.651741147e-02f, 3.162277862e-02f, 2.738419734e-02f, 2.371373586e-02f, 2.053524926e-02f, 1.778279431e-02f, 1.539926510e-02f, 1.333521493e-02f, 1.154781971e-02f, 9.999999776e-03f, 8.659643121e-03f, 7.498942316e-03f, 6.493816618e-03f, 5.623413250e-03f, 4.869675264e-03f, 4.216964822e-03f, 3.651741426e-03f, 3.162277862e-03f, 2.738419687e-03f, 2.371373819e-03f, 2.053525066e-03f, 1.778279431e-03f, 1.539926627e-03f, 1.333521446e-03f, 1.154781901e-03f, 1.000000047e-03f, 8.659643354e-04f, 7.498941850e-04f, 6.493816618e-04f, 5.623413017e-04f, 4.869675031e-04f, 4.216965463e-04f, 3.651741135e-04f, 3.162277862e-04f, 2.738419571e-04f, 2.371373848e-04f, 2.053525241e-04f, 1.778279402e-04f, 1.539926452e-04f, 1.333521504e-04f, 1.154782076e-04f};
__constant__ float LOG2G[8] = {-4.58036896131247886e-02f, -2.27200765000835289e-02f, -1.13153132278341461e-02f, -5.64656314114206272e-03f, -2.82051906237866263e-03f, -1.40957025467135363e-03f, -7.04612976589372706e-04f, -3.52263471629021385e-04f};

__device__ __forceinline__ unsigned f2bf(float f) { unsigned u = __builtin_bit_cast(unsigned, f); return (u + 0x7fffu + ((u >> 16) & 1u)) >> 16; }
__device__ __forceinline__ unsigned pk2(float lo, float hi) { return f2bf(lo) | (f2bf(hi) << 16); }
__device__ __forceinline__ float bflo(unsigned u) { return __uint_as_float(u << 16); }
__device__ __forceinline__ float bfhi(unsigned u) { return __uint_as_float(u & 0xffff0000u); }
__device__ __forceinline__ float bf2f(bf16 b) { return __uint_as_float((unsigned)b << 16); }
typedef __bf16 bf16x2_t __attribute__((ext_vector_type(2)));
__device__ __forceinline__ float dot2(unsigned a, unsigned b, float c) { return __builtin_amdgcn_fdot2_f32_bf16(__builtin_bit_cast(bf16x2_t, a), __builtin_bit_cast(bf16x2_t, b), c, false); }
__device__ __forceinline__ float dot8(v4u a, v4u b, float c) { c = dot2(a.x, b.x, c); c = dot2(a.y, b.y, c); c = dot2(a.z, b.z, c); c = dot2(a.w, b.w, c); return c; }
__device__ __forceinline__ float wave_sum(float v) {
#pragma unroll
    for (int o = 1; o < 64; o <<= 1) v += __shfl_xor(v, o);
    return v;
}
__device__ __forceinline__ float wave_max(float v) {
#pragma unroll
    for (int o = 1; o < 64; o <<= 1) v = fmaxf(v, __shfl_xor(v, o));
    return v;
}
__device__ __forceinline__ int wave_min_i(int v) {
#pragma unroll
    for (int o = 1; o < 64; o <<= 1) { const int w = __shfl_xor(v, o); v = w < v ? w : v; }
    return v;
}
__device__ __forceinline__ float rdlane(float v, int l) { return __uint_as_float((unsigned)__builtin_amdgcn_readlane((int)__float_as_uint(v), l)); }
__device__ __forceinline__ int rdlane_i(int v, int l) { return __builtin_amdgcn_readlane(v, l); }
#define LDS_WAIT() asm volatile("s_waitcnt lgkmcnt(0)" ::: "memory")

__device__ __forceinline__ int opq(int v) { asm volatile("" : "+v"(v)); return v; }
struct Frame {
    LAS unsigned char* lds; int tid, lane, wave, G, bid, gw, NGW;
    const float *x, *attn_norm, *w_in, *sinks, *w_attn, *w_ret, *w_out, *ffn_norm, *w_q, *sub_keys, *e_down, *e_up, *final_norm;
    float* out; unsigned char* ws;
};
__device__ __forceinline__ int proj_dst_col(int n) {
    const bool rope = (n < 1280) || (n >= 1536 && n < 3584);
    if (!rope) return n;
    const int hb = n & ~127, d = n & 127;
    return hb + ((d & 63) << 1) + (d >> 6);
}
__device__ __forceinline__ void p0_transpose_item(const float* W, int K, int N, const float* g, bf16* WT, bool perm, LAS float* scr, int item, int lane) {
    const int nblk = N / 64, kb = item / nblk, nb = item % nblk, k0 = 64 * kb, n0 = 64 * nb;
    const int lr = lane >> 4, lc = (lane & 15) * 4;
#pragma unroll 4
    for (int i = 0; i < 16; ++i) { const int kk = 4 * i + lr; f32x4 w = __builtin_nontemporal_load((const f32x4*)(W + (size_t)(k0 + kk) * N + n0 + lc)); if (g) w = w * g[k0 + kk];
        LAS float* d = scr + kk * 65 + lc; d[0] = w[0]; d[1] = w[1]; d[2] = w[2]; d[3] = w[3]; }
    LDS_WAIT(); asm volatile("" ::: "memory");
    const int c = lane & 7;
#pragma unroll
    for (int j = 0; j < 8; ++j) { const int n = (lane >> 3) + 8 * j; const LAS float* s = scr + (8 * c) * 65 + n;
        v4u o; o.x = pk2(s[0 * 65], s[1 * 65]); o.y = pk2(s[2 * 65], s[3 * 65]); o.z = pk2(s[4 * 65], s[5 * 65]); o.w = pk2(s[6 * 65], s[7 * 65]);
        int nd = n0 + n; if (perm) nd = proj_dst_col(nd);
        *(v4u*)(WT + (size_t)nd * K + k0 + 8 * c) = o; }
    LDS_WAIT(); asm volatile("" ::: "memory");
}
#ifndef GEMM1_FP8
#define GEMM1_FP8 1
#endif
#ifndef P3_FP8
#define P3_FP8 1
#endif
#ifndef P4_FP8
#define P4_FP8 1
#endif
constexpr float P3_AS = 16.0f;
constexpr float G1_XS = 16.0f, G1_WS = 1024.0f;
__device__ __forceinline__ unsigned pk4_fp8(float a, float b, float c, float d) {
    a = fminf(fmaxf(a, -448.f), 448.f); b = fminf(fmaxf(b, -448.f), 448.f); c = fminf(fmaxf(c, -448.f), 448.f); d = fminf(fmaxf(d, -448.f), 448.f);
    int pw = 0; pw = __builtin_amdgcn_cvt_pk_fp8_f32(a, b, pw, false); pw = __builtin_amdgcn_cvt_pk_fp8_f32(c, d, pw, true); return (unsigned)pw;
}
__device__ __forceinline__ void p0_transpose_item_fp8(const float* W, int K, int N, const float* g, float scale, unsigned char* WT, bool perm, LAS float* scr, int item, int lane) {
    const int nblk = N / 64, kb = item / nblk, nb = item % nblk, k0 = 64 * kb, n0 = 64 * nb;
    const int lr = lane >> 4, lc = (lane & 15) * 4;
#pragma unroll 4
    for (int i = 0; i < 16; ++i) { const int kk = 4 * i + lr; f32x4 w = __builtin_nontemporal_load((const f32x4*)(W + (size_t)(k0 + kk) * N + n0 + lc)); w = w * ((g ? g[k0 + kk] : 1.0f) * scale);
        LAS float* d = scr + kk * 65 + lc; d[0] = w[0]; d[1] = w[1]; d[2] = w[2]; d[3] = w[3]; }
    LDS_WAIT(); asm volatile("" ::: "memory");
    const int c = lane & 7;
#pragma unroll
    for (int j = 0; j < 8; ++j) { const int n = (lane >> 3) + 8 * j; const LAS float* s = scr + (8 * c) * 65 + n;
        f32x2 o; o.x = __uint_as_float(pk4_fp8(s[0 * 65], s[1 * 65], s[2 * 65], s[3 * 65])); o.y = __uint_as_float(pk4_fp8(s[4 * 65], s[5 * 65], s[6 * 65], s[7 * 65]));
        int nd = n0 + n; if (perm) nd = proj_dst_col(nd);
        *(f32x2*)(WT + (size_t)nd * K + k0 + 8 * c) = o; }
    LDS_WAIT(); asm volatile("" ::: "memory");
}
__device__ __forceinline__ void sincos_acc(float xf, float& sn, float& cs) {
    const double x = (double)xf;
    const double q = __builtin_rint(x * 0.63661977236758134308);
    const double r = __builtin_fma(-q, 1.57079632679489661923, x) - q * 6.123233995736766e-17;
    const double r2 = r * r;
    double s = -1.0 / 6227020800.0; s = s * r2 + 1.0 / 39916800.0; s = -s; s = s * r2 + 1.0 / 362880.0; s = -s;
    double ps = 1.0 / 6227020800.0;
    ps = ps * r2 - 1.0 / 39916800.0; ps = ps * r2 + 1.0 / 362880.0; ps = ps * r2 - 1.0 / 5040.0; ps = ps * r2 + 1.0 / 120.0; ps = ps * r2 - 1.0 / 6.0; ps = ps * r2 + 1.0;
    const double sv = ps * r;
    double pc = -1.0 / 87178291200.0;
    pc = pc * r2 + 1.0 / 479001600.0; pc = pc * r2 - 1.0 / 3628800.0; pc = pc * r2 + 1.0 / 40320.0; pc = pc * r2 - 1.0 / 720.0; pc = pc * r2 + 1.0 / 24.0; pc = pc * r2 - 0.5; pc = pc * r2 + 1.0;
    (void)s;
    const int qi = ((int)q) & 3;
    const double so = (qi == 0) ? sv : (qi == 1) ? pc : (qi == 2) ? -sv : -pc;
    const double co = (qi == 0) ? pc : (qi == 1) ? -sv : (qi == 2) ? -pc : sv;
    sn = (float)so; cs = (float)co;
}
__device__ __forceinline__ v4u pack8(f32x4 a, f32x4 b) { v4u o; o.x = pk2(a[0], a[1]); o.y = pk2(a[2], a[3]); o.z = pk2(b[0], b[1]); o.w = pk2(b[2], b[3]); return o; }

__device__ __forceinline__ void p0_prologue(Frame& F) {
    LAS float* scr = (LAS float*)(F.lds + F.wave * 16640);
    unsigned char* ws = F.ws;
    const int lane = opq(F.lane);
    constexpr int I_IN = (DM / 64) * (NPROJ / 64), I_A = (1024 / 64) * (DM / 64), I_S = (DM / 64) * (DM / 64);
    constexpr int NITEMS = I_IN + I_A + 3 * I_S;
    for (int it = F.gw; it < NITEMS; it += F.NGW) {
        int r = it;
        if (r < I_IN) { if (GEMM1_FP8) p0_transpose_item_fp8(F.w_in, DM, NPROJ, F.attn_norm, G1_WS, ws + WS_WIN, true, scr, r, lane);
                        else p0_transpose_item(F.w_in, DM, NPROJ, F.attn_norm, (bf16*)(ws + WS_WIN), true, scr, r, lane); continue; } r -= I_IN;
        if (r < I_A) { if (P3_FP8) p0_transpose_item_fp8(F.w_attn, 1024, DM, nullptr, G1_WS, ws + WS_WA, false, scr, r, lane); else p0_transpose_item(F.w_attn, 1024, DM, nullptr, (bf16*)(ws + WS_WA), false, scr, r, lane); continue; } r -= I_A;
        if (r < I_S) { if (P3_FP8) p0_transpose_item_fp8(F.w_ret, DM, DM, nullptr, G1_WS, ws + WS_WR, false, scr, r, lane); else p0_transpose_item(F.w_ret, DM, DM, nullptr, (bf16*)(ws + WS_WR), false, scr, r, lane); continue; } r -= I_S;
        if (r < I_S) { if (P4_FP8) p0_transpose_item_fp8(F.w_out, DM, DM, nullptr, G1_WS, ws + WS_WO, false, scr, r, lane); else p0_transpose_item(F.w_out, DM, DM, nullptr, (bf16*)(ws + WS_WO), false, scr, r, lane); continue; } r -= I_S;
        p0_transpose_item(F.w_q, DM, DM, F.ffn_norm, (bf16*)(ws + WS_WQ), false, scr, r, lane);
    }
    for (int row = F.gw; row < (PEER_FP8_P0 ? 0 : 2 * NEXP); row += F.NGW) {
        const float* src = (row < NEXP) ? F.e_down + (size_t)row * DM : F.e_up + (size_t)(row - NEXP) * DM;
        bf16* dst = (row < NEXP) ? (bf16*)(ws + WS_ED) + (size_t)row * DM : (bf16*)(ws + WS_EU) + (size_t)(row - NEXP) * DM;
        const f32x4* s4 = (const f32x4*)src;
#pragma unroll
        for (int j = 0; j < 4; ++j) { const f32x4 a = s4[128 * j + 2 * lane], b = s4[128 * j + 2 * lane + 1]; *(v4u*)(dst + 512 * j + 8 * lane) = pack8(a, b); }
    }
    for (int m = F.gw; m < T; m += F.NGW) {
        const f32x4* s4 = (const f32x4*)(F.x + (size_t)m * DM); float ss = 0.f; f32x4 xa[4], xb[4];
#pragma unroll
        for (int j = 0; j < 4; ++j) { const f32x4 a = __builtin_nontemporal_load(s4 + 128 * j + 2 * lane), b = __builtin_nontemporal_load(s4 + 128 * j + 2 * lane + 1); xa[j] = a; xb[j] = b;
            ss += (a[0] * a[0] + a[1] * a[1]) + (a[2] * a[2] + a[3] * a[3]) + (b[0] * b[0] + b[1] * b[1]) + (b[2] * b[2] + b[3] * b[3]); }
        ss = wave_sum(ss);
        const float r1v = 1.0f / sqrtf(ss * (1.0f / DM) + EPS);
        if (lane == 0) ((float*)(ws + WS_R1))[m] = r1v;
        if (GEMM1_FP8) { unsigned char* dst = ws + WS_XB + (size_t)m * DM; const float sc = r1v * G1_XS;
#pragma unroll
            for (int j = 0; j < 4; ++j) { const f32x4 a = xa[j] * sc, b = xb[j] * sc; f32x2 o; o.x = __uint_as_float(pk4_fp8(a[0], a[1], a[2], a[3])); o.y = __uint_as_float(pk4_fp8(b[0], b[1], b[2], b[3]));
                *(f32x2*)(dst + 512 * j + 8 * lane) = o; }
        } else { bf16* dst = (bf16*)(ws + WS_XB) + (size_t)m * DM;
#pragma unroll
            for (int j = 0; j < 4; ++j) *(v4u*)(dst + 512 * j + 8 * lane) = pack8(xa[j], xb[j]); }
    }
    for (int c = F.gw; c < 2 * 8 * 128 * 128 / 512; c += F.NGW) {
        const f32x4* s4 = (const f32x4*)(F.sub_keys + (size_t)c * 512); const f32x4 a = s4[2 * lane], b = s4[2 * lane + 1];
        *(v4u*)((bf16*)(ws + WS_SK) + (size_t)c * 512 + 8 * lane) = pack8(a, b);
    }
    for (int c = F.gw; c < SEQ * 64 / 64; c += F.NGW) {
        const int e = c * 64 + lane, pos = e >> 6, i = e & 63; const float ang = (float)pos * INV_FREQ[i];
        float sn, cs; sincos_acc(ang, sn, cs);
        ((f32x2*)(ws + WS_ROPE))[e] = (f32x2){cs, sn};
    }
}

__device__ __forceinline__ void p2_attn_naive(Frame& F) {
    const bf16* PROJ = (const bf16*)(F.ws + WS_PROJ); bf16* AO = (bf16*)(F.ws + WS_AO); const int lane = F.lane;
    for (int it = F.gw; it < T * 8; it += F.NGW) {
        const int t = it >> 3, h = it & 7, pos = t & 4095, kvh = h >> 2;
        const v4u* qr = (const v4u*)(PROJ + (size_t)t * NPROJ + C_QA + h * 128);
        v4u q[16];
#pragma unroll
        for (int i = 0; i < 16; ++i) q[i] = qr[i];
        float s[2];
#pragma unroll
        for (int half = 0; half < 2; ++half) {
            const int sp = pos - 127 + lane + 64 * half; float acc = -1e30f;
            if (sp >= 0) { const v4u* kr = (const v4u*)(PROJ + (size_t)(t - pos + sp) * NPROJ + C_KA + kvh * 128); acc = 0.f;
#pragma unroll
                for (int i = 0; i < 16; ++i) acc = dot8(q[i], kr[i], acc); }
            s[half] = acc;
        }
        const float sink = F.sinks[h] * LOG2E;
        const float m = wave_max(fmaxf(fmaxf(s[0], s[1]), sink));
        const float p0 = exp2f(s[0] - m), p1 = exp2f(s[1] - m);
        const float l = wave_sum(p0 + p1) + exp2f(sink - m);
        float o0 = 0.f, o1 = 0.f;
        for (int j = 0; j < 128; ++j) {
            const int sp = pos - 127 + j; if (sp < 0) continue;
            const float pj = rdlane(j < 64 ? p0 : p1, j & 63);
            const unsigned vv = *(const unsigned*)(PROJ + (size_t)(t - pos + sp) * NPROJ + C_VA + kvh * 128 + 2 * lane);
            o0 += pj * bflo(vv); o1 += pj * bfhi(vv);
        }
        const float inv = 1.0f / l;
        *(unsigned*)(AO + (size_t)t * 1024 + h * 128 + 2 * lane) = pk2(o0 * inv, o1 * inv);
    }
}
__device__ __forceinline__ void p2_kv_naive(Frame& F, float* KV) {
    const bf16* PROJ = (const bf16*)(F.ws + WS_PROJ);
    for (int u = F.bid; u < 512; u += F.G) {
        const int b = u >> 8, h = (u >> 5) & 7, n = u & 31; const size_t t0 = (size_t)b * SEQ + n * 128; const float l2g = LOG2G[h];
        for (int de = F.tid; de < 32768; de += 512) {
            const int d = de >> 8, e = de & 255; float acc = 0.f;
            for (int k = 0; k < 128; ++k) {
                const float kk = bf2f(PROJ[(t0 + k) * NPROJ + C_KR + h * 128 + d]) * exp2f((float)(127 - k) * l2g);
                acc += kk * bf2f(PROJ[(t0 + k) * NPROJ + C_VR + h * 256 + e]);
            }
            KV[((size_t)u * 128 + d) * 256 + e] = acc;
        }
    }
}
__device__ __forceinline__ void p2_scan(Frame& F, float* KV) {
    bf16* S = (bf16*)KV;
    for (int c = F.bid * 512 + F.tid; c < 16 * 32768 / 4; c += F.G * 512) {
        const int bh = c >> 13, de = (c & 8191) * 4; const float cd = exp2f(128.0f * LOG2G[bh & 7]); float s0 = 0.f, s1 = 0.f, s2 = 0.f, s3 = 0.f;
        for (int n = 0; n < 32; ++n) { unsigned long long* p = (unsigned long long*)(S + ((size_t)(bh * 32 + n) * 32768 + de)); const unsigned long long v = *p; const unsigned lo = (unsigned)v, hi = (unsigned)(v >> 32);
            *p = (unsigned long long)pk2(s0, s1) | ((unsigned long long)pk2(s2, s3) << 32);
            s0 = s0 * cd + bflo(lo); s1 = s1 * cd + bfhi(lo); s2 = s2 * cd + bflo(hi); s3 = s3 * cd + bfhi(hi); }
    }
}
__device__ __forceinline__ void p2_retout_naive(Frame& F, const float* KV) {
    const bf16* PROJ = (const bf16*)(F.ws + WS_PROJ); bf16* RO = (bf16*)(F.ws + WS_RO); const int lane = F.lane;
    for (int it = F.gw; it < T * 8; it += F.NGW) {
        const int t = it >> 3, h = it & 7, c = t & 127, t0 = t - c, b = t >> 12, n = (t & 4095) >> 7, u = (b * 8 + h) * 32 + n; const float l2g = LOG2G[h];
        const v4u* qr = (const v4u*)(PROJ + (size_t)t * NPROJ + C_QR + h * 128);
        v4u q[16];
#pragma unroll
        for (int i = 0; i < 16; ++i) q[i] = qr[i];
        float s[2];
#pragma unroll
        for (int half = 0; half < 2; ++half) {
            const int k = lane + 64 * half; float acc = 0.f;
            if (k <= c) { const v4u* kr = (const v4u*)(PROJ + (size_t)(t0 + k) * NPROJ + C_KR + h * 128);
#pragma unroll
                for (int i = 0; i < 16; ++i) acc = dot8(q[i], kr[i], acc);
                acc *= exp2f((float)(c - k) * l2g); }
            s[half] = acc;
        }
        float o[4] = {0.f, 0.f, 0.f, 0.f};
        for (int k = 0; k <= c; ++k) {
            const float sk = rdlane(k < 64 ? s[0] : s[1], k & 63); const bf16* vr = PROJ + (size_t)(t0 + k) * NPROJ + C_VR + h * 256 + lane;
#pragma unroll
            for (int j = 0; j < 4; ++j) o[j] += sk * bf2f(vr[64 * j]);
        }
        float oc[4] = {0.f, 0.f, 0.f, 0.f};
        const float* st = KV + (size_t)u * 32768 + lane;
#pragma unroll
        for (int i = 0; i < 16; ++i) {
            const unsigned w[4] = {q[i].x, q[i].y, q[i].z, q[i].w};
#pragma unroll
            for (int jj = 0; jj < 4; ++jj) {
                const float qlo = bflo(w[jj]), qhi = bfhi(w[jj]); const int d = 8 * i + 2 * jj;
#pragma unroll
                for (int j = 0; j < 4; ++j) { oc[j] += qlo * st[(size_t)d * 256 + 64 * j]; oc[j] += qhi * st[(size_t)(d + 1) * 256 + 64 * j]; }
            }
        }
        const float qd = exp2f((float)(c + 1) * l2g);
#pragma unroll
        for (int j = 0; j < 4; ++j) o[j] += qd * oc[j];
        const float mu = wave_sum((o[0] + o[1]) + (o[2] + o[3])) * (1.0f / 256.0f);
        float vs = 0.f;
#pragma unroll
        for (int j = 0; j < 4; ++j) { o[j] -= mu; vs += o[j] * o[j]; }
        const float rs = 1.0f / sqrtf(wave_sum(vs) * (1.0f / 256.0f) + EPS);
        const bf16* gr = PROJ + (size_t)t * NPROJ + C_GR + h * 256 + lane; bf16* orow = RO + (size_t)t * DM + h * 256 + lane;
#pragma unroll
        for (int j = 0; j < 4; ++j) orow[64 * j] = (bf16)f2bf(o[j] * rs * bf2f(gr[64 * j]));
    }
}
typedef short bf16x8 __attribute__((ext_vector_type(8)));
typedef short s16x4 __attribute__((ext_vector_type(4)));
#define MFMA16(a, b, c) __builtin_amdgcn_mfma_f32_16x16x32_bf16((a), (b), (c), 0, 0, 0)
__device__ __forceinline__ s16x4 tr16(const LAS unsigned char* p) { return __builtin_amdgcn_ds_read_tr16_b64_v4i16((LAS s16x4*)p); }
__device__ __forceinline__ bf16x8 cat8(s16x4 a, s16x4 b) { return (bf16x8){a[0], a[1], a[2], a[3], b[0], b[1], b[2], b[3]}; }
__device__ __forceinline__ v4u scale8(v4u v, float s) { v4u o; o.x = pk2(bflo(v.x) * s, bfhi(v.x) * s); o.y = pk2(bflo(v.y) * s, bfhi(v.y) * s); o.z = pk2(bflo(v.z) * s, bfhi(v.z) * s); o.w = pk2(bflo(v.w) * s, bfhi(v.w) * s); return o; }

__device__ __forceinline__ void p2_kv_mfma(Frame& F, float* KV) {
    const bf16* PROJ = (const bf16*)(F.ws + WS_PROJ);
    const int tid = opq(F.tid), lane = tid & 63, w = F.wave, g = lane >> 4, fr = lane & 15, q = fr >> 2, p = fr & 3;
    constexpr int PV = 528, PK = 272, VS = 0, KS = 128 * 528;
    LAS unsigned char* lds = F.lds;
    for (int u = F.bid; u < 512; u += F.G) {
        const int b = u >> 8, h = (u >> 5) & 7, n = u & 31; const size_t t0 = (size_t)b * SEQ + n * 128; const float l2g = LOG2G[h];
#pragma unroll
        for (int i = 0; i < 8; ++i) { const int c = tid + 512 * i, row = c >> 5, ch = c & 31;
            const v4u v = *(const v4u*)(PROJ + (t0 + row) * NPROJ + C_VR + h * 256 + ch * 8); *(LAS v4u*)(lds + VS + row * PV + ch * 16) = v; }
#pragma unroll
        for (int i = 0; i < 4; ++i) { const int c = tid + 512 * i, row = c >> 4, ch = c & 15;
            const v4u v = *(const v4u*)(PROJ + (t0 + row) * NPROJ + C_KR + h * 128 + ch * 8);
            *(LAS v4u*)(lds + KS + row * PK + ch * 16) = scale8(v, exp2f((float)(127 - row) * l2g)); }
        __syncthreads();
        f32x4 acc[8][2];
#pragma unroll
        for (int dt = 0; dt < 8; ++dt) { acc[dt][0] = (f32x4){0.f, 0.f, 0.f, 0.f}; acc[dt][1] = (f32x4){0.f, 0.f, 0.f, 0.f}; }
#pragma unroll
        for (int ks = 0; ks < 4; ++ks) {
            bf16x8 Bf[2];
#pragma unroll
            for (int ei = 0; ei < 2; ++ei) { const LAS unsigned char* ap = lds + VS + (32 * ks + 8 * g + q) * PV + (16 * (2 * w + ei) + 4 * p) * 2; Bf[ei] = cat8(tr16(ap), tr16(ap + 4 * PV)); }
#pragma unroll
            for (int dt = 0; dt < 8; ++dt) { const LAS unsigned char* ap = lds + KS + (32 * ks + 8 * g + q) * PK + (16 * dt + 4 * p) * 2; const bf16x8 Af = cat8(tr16(ap), tr16(ap + 4 * PK));
                acc[dt][0] = MFMA16(Af, Bf[0], acc[dt][0]); acc[dt][1] = MFMA16(Af, Bf[1], acc[dt][1]); }
        }
#pragma unroll
        for (int dt = 0; dt < 8; ++dt)
#pragma unroll
            for (int ei = 0; ei < 2; ++ei) { const int e = 16 * (2 * w + ei) + fr; const f32x4 a = acc[dt][ei];
                *(unsigned long long*)((bf16*)KV + ((size_t)u * 256 + e) * 128 + 16 * dt + 4 * g) = (unsigned long long)pk2(a[0], a[1]) | ((unsigned long long)pk2(a[2], a[3]) << 32); }
        __syncthreads();
    }
}
__device__ __forceinline__ void p2_retout_mfma(Frame& F, const float* KV) {
    const bf16* PROJ = (const bf16*)(F.ws + WS_PROJ); bf16* RO = (bf16*)(F.ws + WS_RO);
    const int tid = opq(F.tid), lane = tid & 63, w = F.wave, g = lane >> 4, fr = lane & 15, q = fr >> 2, p = fr & 3;
    constexpr int P1 = 272, PV = 528, KS = 0, VS = 128 * 272, STS = 0;
    LAS unsigned char* lds = F.lds;
    for (int u = F.bid; u < 512; u += F.G) {
        const int b = u >> 8, h = (u >> 5) & 7, n = u & 31; const size_t t0 = (size_t)b * SEQ + n * 128; const float l2g = LOG2G[h];
        v4u kreg[4], vreg[8];
#pragma unroll
        for (int i = 0; i < 4; ++i) { const int c = tid + 512 * i, row = c >> 4, ch = c & 15; kreg[i] = *(const v4u*)(PROJ + (t0 + row) * NPROJ + C_KR + h * 128 + ch * 8); }
#pragma unroll
        for (int i = 0; i < 8; ++i) { const int c = tid + 512 * i, row = c >> 5, ch = c & 31; vreg[i] = *(const v4u*)(PROJ + (t0 + row) * NPROJ + C_VR + h * 256 + ch * 8); }
#pragma unroll
        for (int i = 0; i < 8; ++i) { const int c = tid + 512 * i, row = c >> 4, ch = c & 15;
            *(LAS v4u*)(lds + STS + row * P1 + ch * 16) = *(const v4u*)((const bf16*)KV + ((size_t)u * 256 + row) * 128 + ch * 8); }
        bf16x8 qf[4];
#pragma unroll
        for (int ds = 0; ds < 4; ++ds) qf[ds] = *(const bf16x8*)(PROJ + (t0 + 16 * w + fr) * NPROJ + C_QR + h * 128 + 32 * ds + 8 * g);
        __syncthreads();
        f32x4 acc[16];
#pragma unroll
        for (int et = 0; et < 16; ++et) { acc[et] = (f32x4){0.f, 0.f, 0.f, 0.f};
#pragma unroll
            for (int ds = 0; ds < 4; ++ds) { const bf16x8 A = *(const LAS bf16x8*)(lds + STS + (16 * et + fr) * P1 + (32 * ds + 8 * g) * 2); acc[et] = MFMA16(A, qf[ds], acc[et]); } }
        const int c = 16 * w + fr; const float qd = exp2f((float)(c + 1) * l2g);
#pragma unroll
        for (int et = 0; et < 16; ++et) acc[et] = acc[et] * qd;
        __syncthreads();
#pragma unroll
        for (int i = 0; i < 4; ++i) { const int cc = tid + 512 * i, row = cc >> 4, ch = cc & 15; *(LAS v4u*)(lds + KS + row * P1 + ch * 16) = kreg[i]; }
#pragma unroll
        for (int i = 0; i < 8; ++i) { const int cc = tid + 512 * i, row = cc >> 5, ch = cc & 31; *(LAS v4u*)(lds + VS + row * PV + ch * 16) = vreg[i]; }
        __syncthreads();
        float dq[4]; bool mk[4];
#pragma unroll
        for (int r = 0; r < 4; ++r) { dq[r] = exp2f((float)(fr - 4 * g - r) * l2g); mk[r] = (fr - 4 * g - r) >= 0; }
#pragma unroll 1
        for (int i2 = 0; 2 * i2 <= w; ++i2) {
            const int k0 = 2 * i2, k1 = 2 * i2 + 1;
            f32x4 s0 = {0.f, 0.f, 0.f, 0.f}, s1 = {0.f, 0.f, 0.f, 0.f};
#pragma unroll
            for (int ds = 0; ds < 4; ++ds) { const bf16x8 A0 = *(const LAS bf16x8*)(lds + KS + (16 * k0 + fr) * P1 + (32 * ds + 8 * g) * 2); s0 = MFMA16(A0, qf[ds], s0); }
            if (k1 <= w) {
#pragma unroll
                for (int ds = 0; ds < 4; ++ds) { const bf16x8 A1 = *(const LAS bf16x8*)(lds + KS + (16 * k1 + fr) * P1 + (32 * ds + 8 * g) * 2); s1 = MFMA16(A1, qf[ds], s1); } }
            const float tf0 = exp2f((float)(16 * (w - k0)) * l2g), tf1 = (k1 <= w) ? exp2f((float)(16 * (w - k1)) * l2g) : 0.f;
            const bool d0 = (k0 == w), d1 = (k1 == w);
#pragma unroll
            for (int r = 0; r < 4; ++r) { s0[r] = (!d0 || mk[r]) ? s0[r] * (dq[r] * tf0) : 0.f; s1[r] = (!d1 || mk[r]) ? s1[r] * (dq[r] * tf1) : 0.f; }
            v4u bp; bp.x = pk2(s0[0], s0[1]); bp.y = pk2(s0[2], s0[3]); bp.z = pk2(s1[0], s1[1]); bp.w = pk2(s1[2], s1[3]);
            const bf16x8 Bp = __builtin_bit_cast(bf16x8, bp);
            const int k1c = (k1 <= 7) ? k1 : 7;
            const LAS unsigned char* va0 = lds + VS + (16 * k0 + 4 * g + q) * PV + (4 * p) * 2; const LAS unsigned char* va1 = lds + VS + (16 * k1c + 4 * g + q) * PV + (4 * p) * 2;
#pragma unroll
            for (int et = 0; et < 16; ++et) { const s16x4 a0 = tr16(va0 + 32 * et), a1 = tr16(va1 + 32 * et);
                acc[et] = MFMA16(cat8(a0, a1), Bp, acc[et]); }
        }
        float sm = 0.f;
#pragma unroll
        for (int et = 0; et < 16; ++et) sm += (acc[et][0] + acc[et][1]) + (acc[et][2] + acc[et][3]);
        sm += __shfl_xor(sm, 16); sm += __shfl_xor(sm, 32);
        const float mu = sm * (1.0f / 256.0f); float vs = 0.f;
#pragma unroll
        for (int et = 0; et < 16; ++et) { acc[et] = acc[et] - mu; vs += (acc[et][0] * acc[et][0] + acc[et][1] * acc[et][1]) + (acc[et][2] * acc[et][2] + acc[et][3] * acc[et][3]); }
        vs += __shfl_xor(vs, 16); vs += __shfl_xor(vs, 32);
        const float rs = 1.0f / sqrtf(vs * (1.0f / 256.0f) + EPS);
        const size_t t = t0 + c;
#pragma unroll
        for (int et = 0; et < 16; ++et) { const int e0 = 16 * et + 4 * g;
            const unsigned long long gg = *(const unsigned long long*)(PROJ + t * NPROJ + C_GR + h * 256 + e0); const unsigned glo = (unsigned)gg, ghi = (unsigned)(gg >> 32);
            if (P3_FP8) { const float rq = rs * P3_AS; *(unsigned*)((unsigned char*)RO + t * DM + h * 256 + e0) = pk4_fp8(acc[et][0] * rq * bflo(glo), acc[et][1] * rq * bfhi(glo), acc[et][2] * rq * bflo(ghi), acc[et][3] * rq * bfhi(ghi)); }
            else { const unsigned o0 = pk2(acc[et][0] * rs * bflo(glo), acc[et][1] * rs * bfhi(glo)), o1 = pk2(acc[et][2] * rs * bflo(ghi), acc[et][3] * rs * bfhi(ghi));
            *(unsigned long long*)(RO + t * DM + h * 256 + e0) = (unsigned long long)o0 | ((unsigned long long)o1 << 32); } }
        __syncthreads();
    }
}
__device__ __forceinline__ void p2_attn_mfma(Frame& F) {
    const bf16* PROJ = (const bf16*)(F.ws + WS_PROJ); bf16* AO = (bf16*)(F.ws + WS_AO);
    const int tid = opq(F.tid), lane = tid & 63, w = F.wave, g = lane >> 4, fr = lane & 15, q = fr >> 2, p = fr & 3;
    constexpr int PK = 272, KS = 0, VS = 192 * 272;
    LAS unsigned char* lds = F.lds;
    for (int u = F.bid; u < 256; u += F.G) {
        const int b = u >> 7, kvh = (u >> 6) & 1, qb = u & 63, q0 = qb * 64; const size_t tb = (size_t)b * SEQ;
#pragma unroll
        for (int i = 0; i < 6; ++i) { const int c = tid + 512 * i, row = c >> 4, ch = c & 15, kp = q0 - 128 + row;
            v4u kv = {0u, 0u, 0u, 0u}, vv = {0u, 0u, 0u, 0u};
            if (kp >= 0) { kv = *(const v4u*)(PROJ + (tb + kp) * NPROJ + C_KA + kvh * 128 + ch * 8); vv = *(const v4u*)(PROJ + (tb + kp) * NPROJ + C_VA + kvh * 128 + ch * 8); }
            *(LAS v4u*)(lds + KS + row * PK + ch * 16) = kv; *(LAS v4u*)(lds + VS + row * PK + ch * 16) = vv; }
        __syncthreads();
        const int hq = w >> 1, qh = w & 1, h = kvh * 4 + hq; const float sink = F.sinks[h] * LOG2E;
#pragma unroll 1
        for (int qt = 0; qt < 2; ++qt) {
            const int qpos = q0 + 32 * qh + 16 * qt + fr;
            bf16x8 qf[4];
#pragma unroll
            for (int ds = 0; ds < 4; ++ds) qf[ds] = *(const bf16x8*)(PROJ + (tb + qpos) * NPROJ + C_QA + h * 128 + 32 * ds + 8 * g);
            const int rb = 32 * qh + 16 * qt;
            f32x4 s[10]; float m = sink;
#pragma unroll
            for (int j = 0; j < 9; ++j) { s[j] = (f32x4){0.f, 0.f, 0.f, 0.f};
#pragma unroll
                for (int ds = 0; ds < 4; ++ds) { const bf16x8 A = *(const LAS bf16x8*)(lds + KS + (rb + 16 * j + fr) * PK + (32 * ds + 8 * g) * 2); s[j] = MFMA16(A, qf[ds], s[j]); } }
            s[9] = (f32x4){-1e30f, -1e30f, -1e30f, -1e30f};
#pragma unroll
            for (int r = 0; r < 4; ++r) { const int dd = fr - 4 * g - r; s[0][r] = (dd < 0) ? s[0][r] : -1e30f; s[8][r] = (dd >= 0) ? s[8][r] : -1e30f; }
            if (q0 < 128) {
#pragma unroll
                for (int j = 0; j < 9; ++j)
#pragma unroll
                    for (int r = 0; r < 4; ++r) { const int kp = q0 - 128 + rb + 16 * j + 4 * g + r; s[j][r] = (kp >= 0) ? s[j][r] : -1e30f; } }
#pragma unroll
            for (int j = 0; j < 9; ++j) m = fmaxf(m, fmaxf(fmaxf(s[j][0], s[j][1]), fmaxf(s[j][2], s[j][3])));
            m = fmaxf(m, __shfl_xor(m, 16)); m = fmaxf(m, __shfl_xor(m, 32));
            float l = 0.f;
#pragma unroll
            for (int j = 0; j < 10; ++j)
#pragma unroll
                for (int r = 0; r < 4; ++r) { s[j][r] = __builtin_amdgcn_exp2f(s[j][r] - m); l += s[j][r]; }
            l += __shfl_xor(l, 16); l += __shfl_xor(l, 32); l += __builtin_amdgcn_exp2f(sink - m);
            f32x4 o[8];
#pragma unroll
            for (int dt = 0; dt < 8; ++dt) o[dt] = (f32x4){0.f, 0.f, 0.f, 0.f};
#pragma unroll
            for (int st = 0; st < 5; ++st) {
                v4u bp; bp.x = pk2(s[2 * st][0], s[2 * st][1]); bp.y = pk2(s[2 * st][2], s[2 * st][3]); bp.z = pk2(s[2 * st + 1][0], s[2 * st + 1][1]); bp.w = pk2(s[2 * st + 1][2], s[2 * st + 1][3]);
                const bf16x8 Bp = __builtin_bit_cast(bf16x8, bp);
                const LAS unsigned char* va = lds + VS + (rb + 32 * st + 4 * g + q) * PK + (4 * p) * 2;
                const int o1 = (st < 4) ? 16 * PK : 0;
#pragma unroll
                for (int dt = 0; dt < 8; ++dt) { const s16x4 a0 = tr16(va + 32 * dt), a1 = tr16(va + o1 + 32 * dt); o[dt] = MFMA16(cat8(a0, a1), Bp, o[dt]); }
            }
            const float inv = 1.0f / l;
#pragma unroll
            for (int dt = 0; dt < 8; ++dt) {
                if (P3_FP8) { const float is = inv * P3_AS; *(unsigned*)((unsigned char*)AO + (tb + qpos) * 1024 + h * 128 + 16 * dt + 4 * g) = pk4_fp8(o[dt][0] * is, o[dt][1] * is, o[dt][2] * is, o[dt][3] * is); }
                else { const unsigned o0 = pk2(o[dt][0] * inv, o[dt][1] * inv), o1 = pk2(o[dt][2] * inv, o[dt][3] * inv);
                *(unsigned long long*)(AO + (tb + qpos) * 1024 + h * 128 + 16 * dt + 4 * g) = (unsigned long long)o0 | ((unsigned long long)o1 << 32); } }
        }
        __syncthreads();
    }
}
template <int CTRL> __device__ __forceinline__ float dppf(float v) { return __builtin_bit_cast(float, __builtin_amdgcn_update_dpp(0, __builtin_bit_cast(int, v), CTRL, 0xF, 0xF, true)); }
template <int CTRL> __device__ __forceinline__ int dppi(int v) { return __builtin_amdgcn_update_dpp(0, v, CTRL, 0xF, 0xF, true); }
__device__ __forceinline__ float g16_max(float v) { v = fmaxf(v, dppf<0xB1>(v)); v = fmaxf(v, dppf<0x4E>(v)); v = fmaxf(v, dppf<0x141>(v)); v = fmaxf(v, dppf<0x140>(v)); return v; }
__device__ __forceinline__ float g16_sum(float v) { v += dppf<0xB1>(v); v += dppf<0x4E>(v); v += dppf<0x141>(v); v += dppf<0x140>(v); return v; }
__device__ __forceinline__ int g16_min(int v) { v = min(v, dppi<0xB1>(v)); v = min(v, dppi<0x4E>(v)); v = min(v, dppi<0x141>(v)); v = min(v, dppi<0x140>(v)); return v; }
__constant__ unsigned char CAND_SLOT[64] = {
    0, 1, 2, 3, 4, 5, 6, 7, 8, 9, 10, 11, 12, 13, 14, 15,
    16, 17, 18, 19, 20, 21, 22, 23, 32, 33, 34, 35, 36, 48, 49, 50,
    51, 64, 65, 66, 80, 81, 96, 97, 112, 113, 128, 144, 160, 176, 192, 208,
    224, 240, 255, 255, 255, 255, 255, 255, 255, 255, 255, 255, 255, 255, 255, 255};
__device__ __forceinline__ void p5_topk_mfma(Frame& F) {
    const bf16* QRY = (const bf16*)(F.ws + WS_PROJ); const bf16* SK = (const bf16*)(F.ws + WS_SK);
    int* IDX = (int*)(F.ws + WS_IDX); float* GATE = (float*)(F.ws + WS_GATE);
    const int lane = opq(F.lane), w = F.wave, g = lane >> 4, fr = lane & 15;
    LAS unsigned char* lds = F.lds;
    int cslot[4];
#pragma unroll
    for (int s = 0; s < 4; ++s) cslot[s] = CAND_SLOT[16 * s + fr];
    for (int u = F.bid; u < 1024; u += F.G) {
        const int tbk = u >> 3, h = u & 7, pp = w >> 2, tt = w & 3;
        bf16x8 af[4];
#pragma unroll
        for (int ds = 0; ds < 4; ++ds) af[ds] = *(const bf16x8*)(QRY + (size_t)(64 * tbk + 16 * tt + fr) * DM + h * 256 + pp * 128 + 32 * ds + 8 * g);
        f32x4 sc[8];
#pragma unroll
        for (int nt = 0; nt < 8; ++nt) { sc[nt] = (f32x4){0.f, 0.f, 0.f, 0.f};
#pragma unroll
            for (int ds = 0; ds < 4; ++ds) { const bf16x8 Bk = *(const bf16x8*)(SK + (size_t)((pp * 8 + h) * 128 + 16 * nt + fr) * 128 + 32 * ds + 8 * g); sc[nt] = MFMA16(af[ds], Bk, sc[nt]); } }
#pragma unroll
        for (int r = 0; r < 4; ++r) {
            float v[8];
#pragma unroll
            for (int nt = 0; nt < 8; ++nt) v[nt] = sc[nt][r];
            float tv = 0.f; int ti = 0;
#pragma unroll 1
            for (int rd = 0; rd < 16; ++rd) {
                float lm = fmaxf(fmaxf(fmaxf(v[0], v[1]), fmaxf(v[2], v[3])), fmaxf(fmaxf(v[4], v[5]), fmaxf(v[6], v[7])));
                const float mx = g16_max(lm);
                int li = 1 << 20;
#pragma unroll
                for (int nt = 7; nt >= 0; --nt) li = (v[nt] == mx) ? (16 * nt + fr) : li;
                const int wi = g16_min(li);
#pragma unroll
                for (int nt = 0; nt < 8; ++nt) v[nt] = (wi == 16 * nt + fr) ? -INFINITY : v[nt];
                if (fr == rd) { tv = mx; ti = wi; }
            }
            const int tok = 16 * tt + 4 * g + r;
            *(LAS f32x2*)(lds + ((tok * 2 + pp) * 16 + fr) * 8) = (f32x2){tv, __int_as_float(ti)};
        }
        __syncthreads();
#pragma unroll 1
        for (int tk = 0; tk < 2; ++tk) {
            const int tok = 8 * w + 2 * g + tk;
            const LAS f32x2* La = (const LAS f32x2*)(lds + (tok * 2 + 0) * 128); const LAS f32x2* Lb = (const LAS f32x2*)(lds + (tok * 2 + 1) * 128);
            float cv[4];
#pragma unroll
            for (int s = 0; s < 4; ++s) { const int ij = cslot[s]; cv[s] = (ij == 255) ? -INFINITY : La[(ij >> 4) & 15].x + Lb[ij & 15].x; }
            float bs = 0.f, m0 = 0.f; int be = 0;
#pragma unroll 1
            for (int rd = 0; rd < 16; ++rd) {
                const float lm = fmaxf(fmaxf(cv[0], cv[1]), fmaxf(cv[2], cv[3]));
                const float mx = g16_max(lm);
                int li = 1 << 20;
#pragma unroll
                for (int s = 3; s >= 0; --s) li = (cv[s] == mx && cslot[s] < li) ? cslot[s] : li;
                const int wf = g16_min(li);
#pragma unroll
                for (int s = 0; s < 4; ++s) cv[s] = (cslot[s] == wf) ? -INFINITY : cv[s];
                if (rd == 0) m0 = mx;
                if (fr == rd) { bs = mx; be = wf; }
            }
            const int ex_id = __float_as_int(La[(be >> 4) & 15].y) * 128 + __float_as_int(Lb[be & 15].y);
            const float ex = __expf(bs - m0); const float sum = g16_sum(ex);
            const size_t o = (size_t)(64 * tbk + tok) * 128 + h * 16 + fr;
            IDX[o] = ex_id; GATE[o] = ex / sum;
        }
        __syncthreads();
    }
}
__device__ __forceinline__ int f2sort(float f) { const int i = __float_as_int(f); return i ^ ((i >> 31) & 0x7fffffff); }
__device__ __forceinline__ float sort2f(int k) { return __int_as_float(k ^ ((k >> 31) & 0x7fffffff)); }
__device__ __forceinline__ int g16_max_i(int v) { v = max(v, dppi<0xB1>(v)); v = max(v, dppi<0x4E>(v)); v = max(v, dppi<0x141>(v)); v = max(v, dppi<0x140>(v)); return v; }
#define TK_CE(a, b) do { const int hi_ = max((a), (b)), lo_ = min((a), (b)); (a) = hi_; (b) = lo_; } while (0)
__device__ __forceinline__ void p5_topk_v2(Frame& F, int tile_pm = -1, int tile_pn = 0) {
    const bf16* QRY = (const bf16*)(F.ws + WS_PROJ); const bf16* SK = (const bf16*)(F.ws + WS_SK);
    int* IDX = (int*)(F.ws + WS_IDX); float* GATE = (float*)(F.ws + WS_GATE);
    const int lane = opq(F.lane), w = F.wave, g = lane >> 4, fr = lane & 15;
    LAS unsigned char* lds = F.lds + 69632;
    LAS unsigned char* kl = F.lds;
    const bool keys_in_lds = (tile_pm >= 0) || (F.G & 7) == 0;
    if (keys_in_lds) { const int hh = (tile_pm >= 0) ? tile_pn : (F.bid & 7);
#pragma unroll
        for (int i = 0; i < 8; ++i) { const int c = F.tid + 512 * i, row = c >> 4, ch = c & 15, pq = row >> 7, n = row & 127;
            *(LAS v4u*)(kl + row * 272 + ch * 16) = *(const v4u*)(SK + (size_t)((pq * 8 + hh) * 128 + n) * 128 + ch * 8); }
        __syncthreads(); }
    int cslot[4];
#pragma unroll
    for (int s = 0; s < 4; ++s) cslot[s] = CAND_SLOT[16 * s + fr];
    const int u_first = (tile_pm >= 0) ? (32 * tile_pm + tile_pn) : F.bid, u_step = (tile_pm >= 0) ? 8 : F.G, u_end = (tile_pm >= 0) ? (32 * tile_pm + 32) : 1024;
    for (int u = u_first; u < u_end; u += u_step) {
        const int tbk = u >> 3, h = u & 7, pp = w >> 2, tt = w & 3;
        bf16x8 af[4];
#pragma unroll
        for (int ds = 0; ds < 4; ++ds) af[ds] = *(const bf16x8*)(QRY + (size_t)(64 * tbk + 16 * tt + fr) * DM + h * 256 + pp * 128 + 32 * ds + 8 * g);
        f32x4 sc[8];
#pragma unroll
        for (int nt = 0; nt < 8; ++nt) { sc[nt] = (f32x4){0.f, 0.f, 0.f, 0.f};
#pragma unroll
            for (int ds = 0; ds < 4; ++ds) { bf16x8 Bk;
                if (keys_in_lds) Bk = *(const LAS bf16x8*)(kl + (pp * 128 + 16 * nt + fr) * 272 + (32 * ds + 8 * g) * 2);
                else Bk = *(const bf16x8*)(SK + (size_t)((pp * 8 + h) * 128 + 16 * nt + fr) * 128 + 32 * ds + 8 * g);
                sc[nt] = MFMA16(af[ds], Bk, sc[nt]); } }
        int k[4][8];
#pragma unroll
        for (int r = 0; r < 4; ++r) {
#pragma unroll
            for (int nt = 0; nt < 8; ++nt) k[r][nt] = (f2sort(sc[nt][r]) & ~127) | (127 - (16 * nt + fr));
            TK_CE(k[r][0], k[r][1]); TK_CE(k[r][2], k[r][3]); TK_CE(k[r][4], k[r][5]); TK_CE(k[r][6], k[r][7]);
            TK_CE(k[r][0], k[r][2]); TK_CE(k[r][1], k[r][3]); TK_CE(k[r][4], k[r][6]); TK_CE(k[r][5], k[r][7]);
            TK_CE(k[r][1], k[r][2]); TK_CE(k[r][5], k[r][6]);
            TK_CE(k[r][0], k[r][4]); TK_CE(k[r][1], k[r][5]); TK_CE(k[r][2], k[r][6]); TK_CE(k[r][3], k[r][7]);
            TK_CE(k[r][2], k[r][4]); TK_CE(k[r][3], k[r][5]);
            TK_CE(k[r][1], k[r][2]); TK_CE(k[r][3], k[r][4]); TK_CE(k[r][5], k[r][6]);
        }
        int res[4] = {0, 0, 0, 0};
#pragma unroll 1
        for (int rd = 0; rd < 16; ++rd) {
#pragma unroll
            for (int r = 0; r < 4; ++r) {
                const int mx = g16_max_i(k[r][0]); const bool win = (k[r][0] == mx);
#pragma unroll
                for (int i = 0; i < 7; ++i) k[r][i] = win ? k[r][i + 1] : k[r][i];
                k[r][7] = win ? (int)0x80000000 : k[r][7];
                res[r] = (fr == rd) ? mx : res[r];
            }
        }
#pragma unroll
        for (int r = 0; r < 4; ++r) { const int tok = 16 * tt + 4 * g + r;
            *(LAS f32x2*)(lds + ((tok * 2 + pp) * 16 + fr) * 8) = (f32x2){sort2f(res[r] & ~127), __int_as_float(127 - (res[r] & 127))}; }
        __syncthreads();
        int c[2][4];
#pragma unroll
        for (int tk = 0; tk < 2; ++tk) { const int tok = 8 * w + 2 * g + tk;
            const LAS f32x2* La = (const LAS f32x2*)(lds + (tok * 2 + 0) * 128); const LAS f32x2* Lb = (const LAS f32x2*)(lds + (tok * 2 + 1) * 128);
#pragma unroll
            for (int s = 0; s < 4; ++s) { const int ij = cslot[s]; c[tk][s] = (ij == 255) ? (int)0x80000000 : ((f2sort(La[(ij >> 4) & 15].x + Lb[ij & 15].x) & ~255) | (255 - ij)); }
            TK_CE(c[tk][0], c[tk][1]); TK_CE(c[tk][2], c[tk][3]); TK_CE(c[tk][0], c[tk][2]); TK_CE(c[tk][1], c[tk][3]); TK_CE(c[tk][1], c[tk][2]); }
        int rs2[2] = {0, 0}, m0[2] = {0, 0};
#pragma unroll 1
        for (int rd = 0; rd < 16; ++rd) {
#pragma unroll
            for (int tk = 0; tk < 2; ++tk) {
                const int mx = g16_max_i(c[tk][0]); const bool win = (c[tk][0] == mx);
                c[tk][0] = win ? c[tk][1] : c[tk][0]; c[tk][1] = win ? c[tk][2] : c[tk][1]; c[tk][2] = win ? c[tk][3] : c[tk][2]; c[tk][3] = win ? (int)0x80000000 : c[tk][3];
                rs2[tk] = (fr == rd) ? mx : rs2[tk]; m0[tk] = (rd == 0) ? mx : m0[tk];
            }
        }
#pragma unroll
        for (int tk = 0; tk < 2; ++tk) { const int tok = 8 * w + 2 * g + tk;
            const LAS f32x2* La = (const LAS f32x2*)(lds + (tok * 2 + 0) * 128); const LAS f32x2* Lb = (const LAS f32x2*)(lds + (tok * 2 + 1) * 128);
            const int flat = 255 - (rs2[tk] & 255);
            const int ex_id = __float_as_int(La[(flat >> 4) & 15].y) * 128 + __float_as_int(Lb[flat & 15].y);
            const float ex = __expf(sort2f(rs2[tk] & ~255) - sort2f(m0[tk] & ~255)); const float sum = g16_sum(ex);
            const size_t o = (size_t)(64 * tbk + tok) * 128 + h * 16 + fr;
            IDX[o] = ex_id; GATE[o] = ex / sum; }
        __syncthreads();
    }
}
__device__ __forceinline__ void p5_topk_naive(Frame& F) {
    const bf16* QRY = (const bf16*)(F.ws + WS_PROJ); const bf16* SK = (const bf16*)(F.ws + WS_SK);
    int* IDX = (int*)(F.ws + WS_IDX); float* GATE = (float*)(F.ws + WS_GATE); const int lane = F.lane;
    LAS float* wts = (LAS float*)(F.lds + F.wave * 512); LAS int* wti = (LAS int*)(F.lds + F.wave * 512 + 128);
    LAS float* wbs = (LAS float*)(F.lds + F.wave * 512 + 256); LAS int* wbi = (LAS int*)(F.lds + F.wave * 512 + 320);
    for (int it = F.gw; it < T * 8; it += F.NGW) {
        const int t = it >> 3, h = it & 7;
#pragma unroll
        for (int p = 0; p < 2; ++p) {
            const v4u* qr = (const v4u*)(QRY + (size_t)t * DM + h * 256 + p * 128);
            v4u q[16];
#pragma unroll
            for (int i = 0; i < 16; ++i) q[i] = qr[i];
            float v[2];
#pragma unroll
            for (int half = 0; half < 2; ++half) { const v4u* kr = (const v4u*)(SK + ((size_t)((p * 8 + h) * 128 + lane + 64 * half)) * 128); float acc = 0.f;
#pragma unroll
                for (int i = 0; i < 16; ++i) acc = dot8(q[i], kr[i], acc);
                v[half] = acc; }
#pragma unroll
            for (int r = 0; r < 16; ++r) {
                const float bv = fmaxf(v[0], v[1]); const int bi = (v[0] >= v[1]) ? lane : lane + 64;
                const float mx = wave_max(bv);
                const int widx = wave_min_i(bv == mx ? bi : 1 << 20);
                if (lane == 0) { wts[p * 16 + r] = mx; wti[p * 16 + r] = widx; }
                if (lane == (widx & 63)) { if (widx < 64) v[0] = -INFINITY; else v[1] = -INFINITY; }
            }
        }
        LDS_WAIT(); asm volatile("" ::: "memory");
        float cv[4];
        const float tb = wts[16 + (lane & 15)];
#pragma unroll
        for (int qq = 0; qq < 4; ++qq) cv[qq] = wts[(lane >> 4) + 4 * qq] + tb;
#pragma unroll
        for (int r = 0; r < 16; ++r) {
            float bv = cv[0]; int bf = lane;
#pragma unroll
            for (int qq = 1; qq < 4; ++qq) if (cv[qq] > bv) { bv = cv[qq]; bf = lane + 64 * qq; }
            const float mx = wave_max(bv);
            const int fmin = wave_min_i(bv == mx ? bf : 1 << 20);
            if (lane == 0) { wbs[r] = mx; wbi[r] = wti[fmin >> 4] * 128 + wti[16 + (fmin & 15)]; }
            if (lane == (fmin & 63)) {
#pragma unroll
                for (int qq = 0; qq < 4; ++qq) if ((fmin >> 6) == qq) cv[qq] = -INFINITY; }
        }
        LDS_WAIT(); asm volatile("" ::: "memory");
        const float bs = (lane < 16) ? wbs[lane] : -INFINITY; const float bmax = wbs[0];
        const float ex = (lane < 16) ? __expf(bs - bmax) : 0.f; const float sum = wave_sum(ex);
        if (lane < 16) { IDX[(size_t)t * 128 + h * 16 + lane] = wbi[lane]; GATE[(size_t)t * 128 + h * 16 + lane] = ex / sum; }
        LDS_WAIT(); asm volatile("" ::: "memory");
    }
}
__device__ __forceinline__ float gelu_erf(float v) { return 0.5f * v * (1.0f + erff(v * 0.70710678118654752f)); }
__device__ __forceinline__ void p6_peer(Frame& F) {
    const bf16* ED = (const bf16*)(F.ws + WS_ED); const bf16* EU = (const bf16*)(F.ws + WS_EU);
    const int* IDX = (const int*)(F.ws + WS_IDX); const float* GATE = (const float*)(F.ws + WS_GATE); const float* ssq = (const float*)(F.ws + WS_SSQ);
    const int lane = F.lane;
    for (int t = F.gw; t < T; t += F.NGW) {
        float* hrow = F.out + (size_t)t * DM;
        const float r2 = 1.0f / sqrtf(__hip_atomic_load(ssq + t, __ATOMIC_RELAXED, __HIP_MEMORY_SCOPE_AGENT) * (1.0f / DM) + EPS);
        v4u hn[4];
#pragma unroll
        for (int j = 0; j < 4; ++j) { const f32x4 a = ((const f32x4*)hrow)[128 * j + 2 * lane], b = ((const f32x4*)hrow)[128 * j + 2 * lane + 1];
            const f32x4 ga = ((const f32x4*)F.ffn_norm)[128 * j + 2 * lane], gb = ((const f32x4*)F.ffn_norm)[128 * j + 2 * lane + 1];
            hn[j] = pack8(a * r2 * ga, b * r2 * gb); }
        const int id0 = IDX[(size_t)t * 128 + lane], id1 = IDX[(size_t)t * 128 + 64 + lane];
        const float g0 = GATE[(size_t)t * 128 + lane], g1 = GATE[(size_t)t * 128 + 64 + lane];
        float c0 = 0.f, c1 = 0.f;
#pragma unroll 1
        for (int e0 = 0; e0 < 128; e0 += 4) {
            float part[4];
#pragma unroll
            for (int ee = 0; ee < 4; ++ee) { const int e = e0 + ee; const int row = rdlane_i(e < 64 ? id0 : id1, e & 63);
                const v4u* rp = (const v4u*)(ED + (size_t)row * DM) + lane; float acc = 0.f;
#pragma unroll
                for (int j = 0; j < 4; ++j) acc = dot8(hn[j], rp[64 * j], acc);
                part[ee] = acc; }
#pragma unroll
            for (int ee = 0; ee < 4; ++ee) { const int e = e0 + ee; const float uu = wave_sum(part[ee]); const float cc = gelu_erf(uu);
                if (lane == (e & 63)) { if (e < 64) c0 = cc * g0; else c1 = cc * g1; } }
        }
        f32x4 y[8];
#pragma unroll
        for (int j = 0; j < 8; ++j) y[j] = (f32x4){0.f, 0.f, 0.f, 0.f};
#pragma unroll 1
        for (int e0 = 0; e0 < 128; e0 += 4) {
#pragma unroll
            for (int ee = 0; ee < 4; ++ee) { const int e = e0 + ee; const int row = rdlane_i(e < 64 ? id0 : id1, e & 63); const float ce = rdlane(e < 64 ? c0 : c1, e & 63);
                const v4u* rp = (const v4u*)(EU + (size_t)row * DM) + lane;
#pragma unroll
                for (int j = 0; j < 4; ++j) { const v4u w = rp[64 * j];
                    y[2 * j][0] += ce * bflo(w.x); y[2 * j][1] += ce * bfhi(w.x); y[2 * j][2] += ce * bflo(w.y); y[2 * j][3] += ce * bfhi(w.y);
                    y[2 * j + 1][0] += ce * bflo(w.z); y[2 * j + 1][1] += ce * bfhi(w.z); y[2 * j + 1][2] += ce * bflo(w.w); y[2 * j + 1][3] += ce * bfhi(w.w); } }
        }
        float ss = 0.f;
#pragma unroll
        for (int j = 0; j < 4; ++j) { const f32x4 a = ((const f32x4*)hrow)[128 * j + 2 * lane], b = ((const f32x4*)hrow)[128 * j + 2 * lane + 1];
            y[2 * j] += a; y[2 * j + 1] += b;
            const f32x4 u0 = y[2 * j], u1 = y[2 * j + 1];
            ss += (u0[0] * u0[0] + u0[1] * u0[1]) + (u0[2] * u0[2] + u0[3] * u0[3]) + (u1[0] * u1[0] + u1[1] * u1[1]) + (u1[2] * u1[2] + u1[3] * u1[3]); }
        const float rf = 1.0f / sqrtf(wave_sum(ss) * (1.0f / DM) + EPS);
#pragma unroll
        for (int j = 0; j < 4; ++j) { const f32x4 ga = ((const f32x4*)F.final_norm)[128 * j + 2 * lane], gb = ((const f32x4*)F.final_norm)[128 * j + 2 * lane + 1];
            ((f32x4*)hrow)[128 * j + 2 * lane] = y[2 * j] * rf * ga; ((f32x4*)hrow)[128 * j + 2 * lane + 1] = y[2 * j + 1] * rf * gb; }
    }
}

#ifndef PEER_FP8
#define PEER_FP8 1
#endif
constexpr size_t WS_ESC = WS_SK + 512 * 1024;
__device__ __forceinline__ float wave_sum_fast(float v) { v = g16_sum(v); v += __shfl_xor(v, 16); v += __shfl_xor(v, 32); return v; }
template <bool FP8> __device__ __forceinline__ void p6_peer2(Frame& F) {
    constexpr int NCH = FP8 ? 2 : 4, ROWB = FP8 ? 2048 : 4096, NR = FP8 ? 4 : 2;
    const unsigned char* ED = F.ws + WS_ED; const unsigned char* EU = F.ws + WS_EU; const float* ESC = (const float*)(F.ws + WS_ESC);
    const int* IDX = (const int*)(F.ws + WS_IDX); const float* GATE = (const float*)(F.ws + WS_GATE); const float* ssq = (const float*)(F.ws + WS_SSQ);
    const int lane = F.lane;
#define P6_LOAD(BUF, TAB, E0) do { _Pragma("unroll") for (int ee = 0; ee < NR; ++ee) { const int e_ = (E0) + ee; const int row_ = rdlane_i(e_ < 64 ? id0 : id1, e_ & 63); \
        const v4u* rp_ = (const v4u*)((TAB) + (size_t)row_ * ROWB) + lane; _Pragma("unroll") for (int j = 0; j < NCH; ++j) BUF[ee][j] = rp_[64 * j]; } } while (0)
#define P6_DOTS(BUF, E0) do { _Pragma("unroll") for (int ee = 0; ee < NR; ++ee) { const int e_ = (E0) + ee; float part_; \
        if constexpr (FP8) { f32x2 acc_ = {0.f, 0.f}; \
            _Pragma("unroll") for (int j = 0; j < 2; ++j) { const unsigned wd_[4] = {BUF[ee][j].x, BUF[ee][j].y, BUF[ee][j].z, BUF[ee][j].w}; \
                _Pragma("unroll") for (int k = 0; k < 4; ++k) { acc_ = __builtin_elementwise_fma(hf[8 * j + 2 * k], __builtin_amdgcn_cvt_pk_f32_fp8((int)wd_[k], false), acc_); \
                    acc_ = __builtin_elementwise_fma(hf[8 * j + 2 * k + 1], __builtin_amdgcn_cvt_pk_f32_fp8((int)wd_[k], true), acc_); } } \
            part_ = acc_.x + acc_.y; \
        } else { part_ = 0.f; _Pragma("unroll") for (int j = 0; j < NCH; ++j) part_ = dot8(hn[j & 3], BUF[ee][j], part_); } \
        float uu_ = wave_sum_fast(part_); \
        if constexpr (FP8) { const int row_ = rdlane_i(e_ < 64 ? id0 : id1, e_ & 63); uu_ *= ESC[row_]; } \
        const float cc_ = gelu_erf(uu_); \
        if (lane == (e_ & 63)) { if (e_ < 64) c0 = cc_ * g0; else c1 = cc_ * g1; } \
        asm volatile("" ::: "memory"); } } while (0)
#define P6_AXPY(BUF, E0) do { _Pragma("unroll") for (int ee = 0; ee < NR; ++ee) { const int e_ = (E0) + ee; float ce_ = rdlane(e_ < 64 ? c0 : c1, e_ & 63); \
        if constexpr (FP8) { const int row_ = rdlane_i(e_ < 64 ? id0 : id1, e_ & 63); ce_ *= ESC[NEXP + row_]; const f32x2 ce2_ = {ce_, ce_}; \
            _Pragma("unroll") for (int j = 0; j < 2; ++j) { const unsigned wd_[4] = {BUF[ee][j].x, BUF[ee][j].y, BUF[ee][j].z, BUF[ee][j].w}; \
                _Pragma("unroll") for (int k = 0; k < 4; ++k) { f32x2 lo_ = {y[4 * j + k][0], y[4 * j + k][1]}, hi_ = {y[4 * j + k][2], y[4 * j + k][3]}; \
                    lo_ = __builtin_elementwise_fma(ce2_, __builtin_amdgcn_cvt_pk_f32_fp8((int)wd_[k], false), lo_); hi_ = __builtin_elementwise_fma(ce2_, __builtin_amdgcn_cvt_pk_f32_fp8((int)wd_[k], true), hi_); \
                    y[4 * j + k] = (f32x4){lo_.x, lo_.y, hi_.x, hi_.y}; } } \
        } else { _Pragma("unroll") for (int j = 0; j < NCH; ++j) { const v4u w_ = BUF[ee][j]; const int a_ = (2 * j) & 7, b_ = (2 * j + 1) & 7; \
                y[a_][0] += ce_ * bflo(w_.x); y[a_][1] += ce_ * bfhi(w_.x); y[a_][2] += ce_ * bflo(w_.y); y[a_][3] += ce_ * bfhi(w_.y); \
                y[b_][0] += ce_ * bflo(w_.z); y[b_][1] += ce_ * bfhi(w_.z); y[b_][2] += ce_ * bflo(w_.w); y[b_][3] += ce_ * bfhi(w_.w); } } } } while (0)
#pragma unroll 1
    for (int t = F.gw; t < T; t += F.NGW) {
        float* hrow = F.out + (size_t)t * DM;
        const float r2 = 1.0f / sqrtf(__hip_atomic_load(ssq + t, __ATOMIC_RELAXED, __HIP_MEMORY_SCOPE_AGENT) * (1.0f / DM) + EPS);
        v4u hn[4]; f32x2 hf[16];
        if constexpr (FP8) {
#pragma unroll
            for (int j = 0; j < 2; ++j)
#pragma unroll
                for (int k = 0; k < 4; ++k) { const f32x4 a = ((const f32x4*)hrow)[256 * j + 4 * lane + k] * r2 * ((const f32x4*)F.ffn_norm)[256 * j + 4 * lane + k];
                    hf[8 * j + 2 * k] = (f32x2){a[0], a[1]}; hf[8 * j + 2 * k + 1] = (f32x2){a[2], a[3]}; }
        } else {
#pragma unroll
            for (int j = 0; j < 4; ++j) { const f32x4 a = ((const f32x4*)hrow)[128 * j + 2 * lane], b = ((const f32x4*)hrow)[128 * j + 2 * lane + 1];
                const f32x4 ga = ((const f32x4*)F.ffn_norm)[128 * j + 2 * lane], gb = ((const f32x4*)F.ffn_norm)[128 * j + 2 * lane + 1];
                hn[j] = pack8(a * r2 * ga, b * r2 * gb); }
        }
        const int id0 = IDX[(size_t)t * 128 + lane], id1 = IDX[(size_t)t * 128 + 64 + lane];
        const float g0 = GATE[(size_t)t * 128 + lane], g1 = GATE[(size_t)t * 128 + 64 + lane];
        float c0 = 0.f, c1 = 0.f;
        v4u A[NR][NCH], B[NR][NCH];
        P6_LOAD(A, ED, 0);
#pragma unroll 1
        for (int e0 = 0; e0 < 128; e0 += 2 * NR) {
            P6_LOAD(B, ED, e0 + NR);
            P6_DOTS(A, e0);
            if (e0 + 2 * NR < 128) P6_LOAD(A, ED, e0 + 2 * NR);
            P6_DOTS(B, e0 + NR);
        }
        f32x4 y[8];
#pragma unroll
        for (int j = 0; j < 8; ++j) y[j] = (f32x4){0.f, 0.f, 0.f, 0.f};
        P6_LOAD(A, EU, 0);
#pragma unroll 1
        for (int e0 = 0; e0 < 128; e0 += 2 * NR) {
            P6_LOAD(B, EU, e0 + NR);
            P6_AXPY(A, e0);
            if (e0 + 2 * NR < 128) P6_LOAD(A, EU, e0 + 2 * NR);
            P6_AXPY(B, e0 + NR);
        }
        float ss = 0.f;
#pragma unroll
        for (int j = 0; j < 8; ++j) { const int fi = FP8 ? (256 * (j >> 2) + 4 * lane + (j & 3)) : (128 * (j >> 1) + 2 * lane + (j & 1));
            y[j] += ((const f32x4*)hrow)[fi]; ss += (y[j][0] * y[j][0] + y[j][1] * y[j][1]) + (y[j][2] * y[j][2] + y[j][3] * y[j][3]); }
        const float rf = 1.0f / sqrtf(wave_sum(ss) * (1.0f / DM) + EPS);
#pragma unroll
        for (int j = 0; j < 8; ++j) { const int fi = FP8 ? (256 * (j >> 2) + 4 * lane + (j & 3)) : (128 * (j >> 1) + 2 * lane + (j & 1));
            ((f32x4*)hrow)[fi] = y[j] * rf * ((const f32x4*)F.final_norm)[fi]; }
    }
#undef P6_LOAD
#undef P6_DOTS
#undef P6_AXPY
}
__device__ __forceinline__ void p0_experts_fp8(Frame& F) {
    const int lane = F.lane; float* ESC = (float*)(F.ws + WS_ESC);
    for (int row = F.gw; row < 2 * NEXP; row += F.NGW) {
        const float* src = (row < NEXP) ? F.e_down + (size_t)row * DM : F.e_up + (size_t)(row - NEXP) * DM;
        unsigned char* dst = (row < NEXP) ? F.ws + WS_ED + (size_t)row * 2048 : F.ws + WS_EU + (size_t)(row - NEXP) * 2048;
        f32x4 v[8]; float am = 0.f;
#pragma unroll
        for (int j = 0; j < 2; ++j)
#pragma unroll
            for (int k = 0; k < 4; ++k) { const f32x4 a = ((const f32x4*)src)[256 * j + 4 * lane + k]; v[4 * j + k] = a;
                am = fmaxf(am, fmaxf(fmaxf(fabsf(a[0]), fabsf(a[1])), fmaxf(fabsf(a[2]), fabsf(a[3])))); }
        am = wave_max(am); if (!(am > 0.f)) am = 1.0f;
        const float sc = 448.0f / am;
        if (lane == 0) ESC[row] = am * (1.0f / 448.0f);
#pragma unroll
        for (int j = 0; j < 2; ++j) { v4u o;
#pragma unroll
            for (int k = 0; k < 4; ++k) { const f32x4 a = v[4 * j + k] * sc; int pw = 0; pw = __builtin_amdgcn_cvt_pk_fp8_f32(a[0], a[1], pw, false); pw = __builtin_amdgcn_cvt_pk_fp8_f32(a[2], a[3], pw, true);
                if (k == 0) o.x = (unsigned)pw; else if (k == 1) o.y = (unsigned)pw; else if (k == 2) o.z = (unsigned)pw; else o.w = (unsigned)pw; }
            *(v4u*)(dst + 1024 * j + 16 * lane) = o; }
    }
}
typedef float f32x16 __attribute__((ext_vector_type(16)));
typedef float f32x32 __attribute__((ext_vector_type(32)));
typedef unsigned u32x6 __attribute__((ext_vector_type(6)));
typedef unsigned u32x2 __attribute__((ext_vector_type(2)));
struct __attribute__((packed, aligned(4))) U3 { unsigned a, b, c; };
__device__ __forceinline__ void p0_experts_fp6(Frame& F) {
    const int lane = F.lane; float* ESC = (float*)(F.ws + WS_ESC);
    for (int row = F.gw; row < 2 * NEXP; row += F.NGW) {
        const float* src = (row < NEXP) ? F.e_down + (size_t)row * DM : F.e_up + (size_t)(row - NEXP) * DM;
        unsigned char* dst = (row < NEXP) ? F.ws + WS_ED + (size_t)row * 1536 : F.ws + WS_EU + (size_t)(row - NEXP) * 1536;
        f32x4 v[8]; float am = 0.f;
#pragma unroll
        for (int i = 0; i < 8; ++i) { const f32x4 a = ((const f32x4*)src)[64 * i + lane]; v[i] = a;
            am = fmaxf(am, fmaxf(fmaxf(fabsf(a[0]), fabsf(a[1])), fmaxf(fabsf(a[2]), fabsf(a[3])))); }
        am = wave_max(am); if (!(am > 0.f)) am = 1.0f;
        const float sc = 7.5f / am;
        if (lane == 0) ESC[row] = am * (1.0f / 7.5f);
        f32x16 x, y;
#pragma unroll
        for (int k = 0; k < 16; ++k) { x[k] = v[k >> 1][2 * (k & 1)] * sc; y[k] = v[k >> 1][2 * (k & 1) + 1] * sc; }
        const u32x6 p = __builtin_amdgcn_cvt_scalef32_2xpk16_fp6_f32(x, y, 1.0f);
        *(v4u*)(dst + 16 * lane) = (v4u){p[0], p[1], p[2], p[3]};
        *(u32x2*)(dst + 1024 + 8 * lane) = (u32x2){p[4], p[5]};
    }
}
__device__ __forceinline__ void p6_peer_fp6(Frame& F) {
    constexpr int ROWB = 1536, NR = 4;
    const unsigned char* ED = F.ws + WS_ED; const unsigned char* EU = F.ws + WS_EU; const float* ESC = (const float*)(F.ws + WS_ESC);
    const int* IDX = (const int*)(F.ws + WS_IDX); const float* GATE = (const float*)(F.ws + WS_GATE); const float* ssq = (const float*)(F.ws + WS_SSQ);
    const int lane = F.lane;
#define P6F_LOAD(BA, BB, TAB, E0) do { _Pragma("unroll") for (int ee = 0; ee < NR; ++ee) { const int e_ = (E0) + ee; const int row_ = rdlane_i(e_ < 64 ? id0 : id1, e_ & 63); \
        const unsigned char* rp_ = (TAB) + (size_t)row_ * ROWB; BA[ee] = *(const v4u*)(rp_ + 16 * lane); BB[ee] = *(const u32x2*)(rp_ + 1024 + 8 * lane); } } while (0)
#define P6F_DEC(BA, BB, ee) __builtin_amdgcn_cvt_scalef32_pk32_f32_fp6((u32x6){BA[ee].x, BA[ee].y, BA[ee].z, BA[ee].w, BB[ee].x, BB[ee].y}, 1.0f)
#define P6F_DOTS(BA, BB, E0) do { _Pragma("unroll") for (int ee = 0; ee < NR; ++ee) { const int e_ = (E0) + ee; const f32x32 w_ = P6F_DEC(BA, BB, ee); \
        float p0_ = 0.f, p1_ = 0.f; _Pragma("unroll") for (int i = 0; i < 16; ++i) { p0_ += hf[2 * i] * w_[2 * i]; p1_ += hf[2 * i + 1] * w_[2 * i + 1]; } \
        const int row_ = rdlane_i(e_ < 64 ? id0 : id1, e_ & 63); const float uu_ = wave_sum_fast(p0_ + p1_) * ESC[row_]; \
        const float cc_ = gelu_erf(uu_); \
        if (lane == (e_ & 63)) { if (e_ < 64) c0 = cc_ * g0; else c1 = cc_ * g1; } \
        __builtin_amdgcn_sched_barrier(0); } } while (0)
#define P6F_AXPY(BA, BB, E0) do { _Pragma("unroll") for (int ee = 0; ee < NR; ++ee) { const int e_ = (E0) + ee; const int row_ = rdlane_i(e_ < 64 ? id0 : id1, e_ & 63); \
        const float ce_ = rdlane(e_ < 64 ? c0 : c1, e_ & 63) * ESC[NEXP + row_]; const f32x32 w_ = P6F_DEC(BA, BB, ee); \
        _Pragma("unroll") for (int i = 0; i < 32; ++i) y[i] += ce_ * w_[i]; __builtin_amdgcn_sched_barrier(0); } } while (0)
#pragma unroll 1
    for (int t = F.gw; t < T; t += F.NGW) {
        float* hrow = F.out + (size_t)t * DM;
        const float r2 = 1.0f / sqrtf(__hip_atomic_load(ssq + t, __ATOMIC_RELAXED, __HIP_MEMORY_SCOPE_AGENT) * (1.0f / DM) + EPS);
        int ln = lane; asm volatile("" : "+v"(ln));
        float hf[32];
#pragma unroll
        for (int i = 0; i < 8; ++i) { const f32x4 a = ((const f32x4*)hrow)[64 * i + ln] * r2 * ((const f32x4*)F.ffn_norm)[64 * i + ln];
            hf[4 * i] = a[0]; hf[4 * i + 1] = a[1]; hf[4 * i + 2] = a[2]; hf[4 * i + 3] = a[3]; }
        const int id0 = IDX[(size_t)t * 128 + lane], id1 = IDX[(size_t)t * 128 + 64 + lane];
        const float g0 = GATE[(size_t)t * 128 + lane], g1 = GATE[(size_t)t * 128 + 64 + lane];
        float c0 = 0.f, c1 = 0.f;
        v4u A0[NR], B0[NR]; u32x2 A1[NR], B1[NR];
        P6F_LOAD(A0, A1, ED, 0);
#pragma unroll 1
        for (int e0 = 0; e0 < 128; e0 += 2 * NR) {
            P6F_LOAD(B0, B1, ED, e0 + NR);
            P6F_DOTS(A0, A1, e0);
            if (e0 + 2 * NR < 128) P6F_LOAD(A0, A1, ED, e0 + 2 * NR);
            P6F_DOTS(B0, B1, e0 + NR);
        }
        float y[32];
#pragma unroll
        for (int i = 0; i < 32; ++i) y[i] = 0.f;
        P6F_LOAD(A0, A1, EU, 0);
#pragma unroll 1
        for (int e0 = 0; e0 < 128; e0 += 2 * NR) {
            P6F_LOAD(B0, B1, EU, e0 + NR);
            P6F_AXPY(A0, A1, e0);
            if (e0 + 2 * NR < 128) P6F_LOAD(A0, A1, EU, e0 + 2 * NR);
            P6F_AXPY(B0, B1, e0 + NR);
        }
        float ss = 0.f; int l2 = lane; asm volatile("" : "+v"(l2));
#pragma unroll
        for (int i = 0; i < 8; ++i) { const f32x4 a = ((const f32x4*)hrow)[64 * i + l2];
            y[4 * i] += a[0]; y[4 * i + 1] += a[1]; y[4 * i + 2] += a[2]; y[4 * i + 3] += a[3];
            ss += (y[4 * i] * y[4 * i] + y[4 * i + 1] * y[4 * i + 1]) + (y[4 * i + 2] * y[4 * i + 2] + y[4 * i + 3] * y[4 * i + 3]); }
        const float rf = 1.0f / sqrtf(wave_sum(ss) * (1.0f / DM) + EPS);
#pragma unroll
        for (int i = 0; i < 8; ++i) { const f32x4 gf = ((const f32x4*)F.final_norm)[64 * i + l2];
            ((f32x4*)hrow)[64 * i + l2] = (f32x4){y[4 * i] * rf * gf[0], y[4 * i + 1] * rf * gf[1], y[4 * i + 2] * rf * gf[2], y[4 * i + 3] * rf * gf[3]}; }
    }
#undef P6F_LOAD
#undef P6F_DEC
#undef P6F_DOTS
#undef P6F_AXPY
}
constexpr size_t WS_U = WS_XB;
constexpr size_t WS_SSZ = 256 * 1024;
__device__ __forceinline__ void p0_experts_fp6s(Frame& F) {
    const int lane = F.lane; float* ESC = (float*)(F.ws + WS_ESC);
    for (int row = F.gw; row < 2 * NEXP; row += F.NGW) {
        const bool dn = row < NEXP; const int e = dn ? row : row - NEXP;
        const float* src = (dn ? F.e_down : F.e_up) + (size_t)e * DM;
        unsigned char* dst = F.ws + (dn ? WS_ED : WS_EU) + ((size_t)(lane >> 3) * NEXP + e) * 192;
        LAS f32x4* rs = (LAS f32x4*)(F.lds + F.wave * 16640);
#pragma unroll
        for (int i = 0; i < 8; ++i) { const int idx = 64 * i + lane; f32x4 a = __builtin_nontemporal_load((const f32x4*)src + idx); if (dn) a = a * ((const f32x4*)F.ffn_norm)[idx];
            rs[idx + (idx >> 3)] = a; }
        LDS_WAIT(); asm volatile("" ::: "memory");
        f32x4 v[8]; float am = 0.f;
#pragma unroll
        for (int i = 0; i < 8; ++i) { const int idx = 8 * lane + i; const f32x4 a = rs[idx + (idx >> 3)];
            v[i] = a; am = fmaxf(am, fmaxf(fmaxf(fabsf(a[0]), fabsf(a[1])), fmaxf(fabsf(a[2]), fabsf(a[3])))); }
        LDS_WAIT(); asm volatile("" ::: "memory");
        am = wave_max(am); if (!(am > 0.f)) am = 1.0f;
        const float sc = 7.5f / am;
        if (lane == 0) ESC[row] = am * (1.0f / 7.5f);
        f32x16 x, y;
#pragma unroll
        for (int k = 0; k < 16; ++k) { x[k] = v[k >> 1][2 * (k & 1)] * sc; y[k] = v[k >> 1][2 * (k & 1) + 1] * sc; }
        const u32x6 p = __builtin_amdgcn_cvt_scalef32_2xpk16_fp6_f32(x, y, 1.0f);
        const int s = lane & 7;
        *(U3*)(dst + 12 * s) = (U3){p[0], p[1], p[2]};
        *(U3*)(dst + 96 + 12 * s) = (U3){p[3], p[4], p[5]};
    }
}
__device__ __forceinline__ float g8_sum(float v) { v += dppf<0xB1>(v); v += dppf<0x4E>(v); v += dppf<0x141>(v); return v; }
#define P6S_LOADN(BA, BB, N_, TAB, IT0, IDA_, IDB_) do { _Pragma("unroll") for (int q_ = 0; q_ < (N_); ++q_) { const int it_ = (IT0) + q_; const int e_ = __shfl((it_ < 8) ? (IDA_) : (IDB_), gq + 8 * (it_ & 7)); \
        const unsigned char* rp_ = (TAB) + (size_t)e_ * 192; BA[q_] = *(const v4u*)(rp_ + 16 * s); BB[q_] = *(const u32x2*)(rp_ + 128 + 8 * s); } } while (0)
#define P6S_DEC(BA, BB, q_) __builtin_amdgcn_cvt_scalef32_pk32_f32_fp6((u32x6){BA[q_].x, BA[q_].y, BA[q_].z, BA[q_].w, BB[q_].x, BB[q_].y}, 1.0f)
__device__ __forceinline__ void p6a_down(Frame& F) {
    const int lane = F.lane, gq = lane >> 3, s = lane & 7, x = F.bid & 7, wsl = (F.bid >> 3) * NWAVES + F.wave, nws = (F.G >> 3) * NWAVES;
    const unsigned char* TAB = F.ws + WS_ED + (size_t)x * NEXP * 192;
    const int* IDX = (const int*)(F.ws + WS_IDX); const float* ssq = (const float*)(F.ws + WS_SSQ); float* U = (float*)(F.ws + WS_U) + (size_t)x * T * 128;
    int t = wsl; if (t >= T) return;
    f32x4 hc[8], hx[8]; float sq, sqn = 0.f, r2; int idA, idB, idAn = 0, idBn = 0;
#define P6A_FETCH(HH, SQ_, TT, IA_, IB_) do { const float* hr_ = F.out + (size_t)(TT) * DM; _Pragma("unroll") for (int i = 0; i < 8; ++i) HH[i] = ((const f32x4*)hr_)[64 * x + 8 * s + i]; \
        SQ_ = __hip_atomic_load(ssq + (TT), __ATOMIC_RELAXED, __HIP_MEMORY_SCOPE_AGENT); IA_ = IDX[(size_t)(TT) * 128 + lane]; IB_ = IDX[(size_t)(TT) * 128 + 64 + lane]; } while (0)
#define P6S_DOT1(BA, BB, q_, IT_) do { const f32x32 w_ = P6S_DEC(BA, BB, q_); float p0_ = 0.f, p1_ = 0.f; \
        _Pragma("unroll") for (int i = 0; i < 8; ++i) { p0_ += hc[i][0] * w_[4 * i]; p1_ += hc[i][1] * w_[4 * i + 1]; p0_ += hc[i][2] * w_[4 * i + 2]; p1_ += hc[i][3] * w_[4 * i + 3]; } \
        const float d_ = g8_sum(p0_ + p1_) * r2; if (s == 0) U[(size_t)t * 128 + gq + 8 * (IT_)] = d_; \
        __builtin_amdgcn_sched_barrier(0); } while (0)
#define P6S_DOTS(BA, BB, IT0) do { P6S_DOT1(BA, BB, 0, (IT0)); P6S_DOT1(BA, BB, 1, (IT0) + 1); P6S_DOT1(BA, BB, 2, (IT0) + 2); P6S_DOT1(BA, BB, 3, (IT0) + 3); } while (0)
    P6A_FETCH(hc, sq, t, idA, idB); r2 = 1.0f / sqrtf(sq * (1.0f / DM) + EPS);
    int tn = t + nws; if (tn < T) P6A_FETCH(hx, sqn, tn, idAn, idBn);
    v4u A0[4], B0[4]; u32x2 A1[4], B1[4];
    P6S_LOADN(A0, A1, 4, TAB, 0, idA, idB);
#pragma unroll 1
    for (;;) {
        P6S_LOADN(B0, B1, 4, TAB, 4, idA, idB); P6S_DOTS(A0, A1, 0);
        P6S_LOADN(A0, A1, 4, TAB, 8, idA, idB); P6S_DOTS(B0, B1, 4);
        P6S_LOADN(B0, B1, 4, TAB, 12, idA, idB); P6S_DOTS(A0, A1, 8);
        const bool more = tn < T;
        if (more) P6S_LOADN(A0, A1, 4, TAB, 0, idAn, idBn);
        P6S_DOTS(B0, B1, 12);
        if (!more) break;
        t = tn; idA = idAn; idB = idBn; r2 = 1.0f / sqrtf(sqn * (1.0f / DM) + EPS);
#pragma unroll
        for (int i = 0; i < 8; ++i) hc[i] = hx[i];
        tn += nws; if (tn < T) P6A_FETCH(hx, sqn, tn, idAn, idBn);
    }
#undef P6S_DOTS
#undef P6S_DOT1
#undef P6A_FETCH
}
__device__ __forceinline__ void p6b_up(Frame& F) {
    const int lane = F.lane, gq = lane >> 3, s = lane & 7, x = F.bid & 7, wsl = (F.bid >> 3) * NWAVES + F.wave, nws = (F.G >> 3) * NWAVES;
    const unsigned char* TAB = F.ws + WS_EU + (size_t)x * NEXP * 192;
    const int* IDX = (const int*)(F.ws + WS_IDX); const float* GATE = (const float*)(F.ws + WS_GATE); const float* ESC = (const float*)(F.ws + WS_ESC);
    const float* U = (const float*)(F.ws + WS_U); float* ssz = (float*)(F.ws + WS_SSZ);
    int t = wsl; if (t >= T) return;
    int idA, idB, idAn = 0, idBn = 0; float cA, cB, gAn = 0.f, gBn = 0.f, uAn = 0.f, uBn = 0.f, sdA = 0.f, sdB = 0.f, suA = 0.f, suB = 0.f; f32x4 h4, h4n = {0.f, 0.f, 0.f, 0.f};
    const size_t zoff = 256 * x + 32 * s + 4 * gq;
#define P6B_FETCH1(TT) do { idAn = IDX[(size_t)(TT) * 128 + lane]; idBn = IDX[(size_t)(TT) * 128 + 64 + lane]; gAn = GATE[(size_t)(TT) * 128 + lane]; gBn = GATE[(size_t)(TT) * 128 + 64 + lane]; \
        uAn = 0.f; uBn = 0.f; _Pragma("unroll") for (int xx = 0; xx < 8; ++xx) { uAn += U[((size_t)xx * T + (TT)) * 128 + lane]; uBn += U[((size_t)xx * T + (TT)) * 128 + 64 + lane]; } \
        h4n = *(const f32x4*)(F.out + (size_t)(TT) * DM + zoff); } while (0)
#define P6B_FETCH2() do { sdA = ESC[idAn]; sdB = ESC[idBn]; suA = ESC[NEXP + idAn]; suB = ESC[NEXP + idBn]; } while (0)
#define P6B_COEF() do { cA = gAn * gelu_erf(uAn * sdA) * suA; cB = gBn * gelu_erf(uBn * sdB) * suB; } while (0)
#define P6_PIN16(Y, B_) asm volatile("" : "+v"(Y[B_]), "+v"(Y[B_ + 1]), "+v"(Y[B_ + 2]), "+v"(Y[B_ + 3]), "+v"(Y[B_ + 4]), "+v"(Y[B_ + 5]), "+v"(Y[B_ + 6]), "+v"(Y[B_ + 7]), \
        "+v"(Y[B_ + 8]), "+v"(Y[B_ + 9]), "+v"(Y[B_ + 10]), "+v"(Y[B_ + 11]), "+v"(Y[B_ + 12]), "+v"(Y[B_ + 13]), "+v"(Y[B_ + 14]), "+v"(Y[B_ + 15]))
#define P6S_AXPY1(BA, BB, q_, IT_, NXT_) do { const float ce_ = __shfl(((IT_) < 8) ? cA : cB, gq + 8 * ((IT_) & 7)); \
        const f32x32 w_ = P6S_DEC(BA, BB, q_); _Pragma("unroll") for (int i = 0; i < 32; ++i) y[i] += ce_ * w_[i]; \
        P6_PIN16(y, 0); P6_PIN16(y, 16); asm volatile("" : "+v"(NXT_)); } while (0)
#define P6S_AXPY(BA, BB, IT0) do { P6S_AXPY1(BA, BB, 0, (IT0), BA[1].x); P6S_AXPY1(BA, BB, 1, (IT0) + 1, pin_); } while (0)
    P6B_FETCH1(t); P6B_FETCH2(); P6B_COEF(); idA = idAn; idB = idBn; h4 = h4n;
    int tn = t + nws; if (tn < T) P6B_FETCH1(tn);
    v4u A0[2], B0[2]; u32x2 A1[2], B1[2];
    P6S_LOADN(A0, A1, 2, TAB, 0, idA, idB);
    const bool b2 = (gq & 4) != 0, b1 = (gq & 2) != 0, b0 = (gq & 1) != 0; int pin_ = 0;
#pragma unroll 1
    for (;;) {
        float y[32];
#pragma unroll
        for (int i = 0; i < 32; ++i) y[i] = 0.f;
        const bool more = tn < T;
        P6S_LOADN(B0, B1, 2, TAB, 2, idA, idB); P6S_AXPY(A0, A1, 0);
        P6S_LOADN(A0, A1, 2, TAB, 4, idA, idB); P6S_AXPY(B0, B1, 2);
        if (more) P6B_FETCH2();
        P6S_LOADN(B0, B1, 2, TAB, 6, idA, idB); P6S_AXPY(A0, A1, 4);
        P6S_LOADN(A0, A1, 2, TAB, 8, idA, idB); P6S_AXPY(B0, B1, 6);
        P6S_LOADN(B0, B1, 2, TAB, 10, idA, idB); P6S_AXPY(A0, A1, 8);
        P6S_LOADN(A0, A1, 2, TAB, 12, idA, idB); P6S_AXPY(B0, B1, 10);
        P6S_LOADN(B0, B1, 2, TAB, 14, idA, idB); P6S_AXPY(A0, A1, 12);
        if (more) P6S_LOADN(A0, A1, 2, TAB, 0, idAn, idBn);
        P6S_AXPY(B0, B1, 14);
        float k16[16], k8[8], k4[4];
#pragma unroll
        for (int j = 0; j < 16; ++j) { const float keep = b2 ? y[16 + j] : y[j], send = b2 ? y[j] : y[16 + j]; k16[j] = keep + __shfl_xor(send, 32); }
#pragma unroll
        for (int j = 0; j < 8; ++j) { const float keep = b1 ? k16[8 + j] : k16[j], send = b1 ? k16[j] : k16[8 + j]; k8[j] = keep + __shfl_xor(send, 16); }
#pragma unroll
        for (int j = 0; j < 4; ++j) { const float keep = b0 ? k8[4 + j] : k8[j], send = b0 ? k8[j] : k8[4 + j]; k4[j] = keep + __shfl_xor(send, 8); }
        const f32x4 z = {h4[0] + k4[0], h4[1] + k4[1], h4[2] + k4[2], h4[3] + k4[3]};
        *(f32x4*)(F.out + (size_t)t * DM + zoff) = z;
        const float ss = wave_sum((z[0] * z[0] + z[1] * z[1]) + (z[2] * z[2] + z[3] * z[3]));
        if (lane == 0) atomicAdd(ssz + t, ss);
        if (!more) break;
        P6B_COEF(); t = tn; idA = idAn; idB = idBn; h4 = h4n;
        tn += nws; if (tn < T) P6B_FETCH1(tn);
    }
#undef P6B_FETCH1
#undef P6B_FETCH2
#undef P6B_COEF
#undef P6S_AXPY
#undef P6S_AXPY1
#undef P6_PIN16
}
#undef P6S_LOADN
#undef P6S_DEC
__device__ __forceinline__ void p6c_norm(Frame& F) {
    const int lane = F.lane; const float* ssz = (const float*)(F.ws + WS_SSZ);
    for (int t = F.gw; t < T; t += F.NGW) {
        f32x4* row = (f32x4*)(F.out + (size_t)t * DM);
        const float rf = 1.0f / sqrtf(__hip_atomic_load(ssz + t, __ATOMIC_RELAXED, __HIP_MEMORY_SCOPE_AGENT) * (1.0f / DM) + EPS);
#pragma unroll
        for (int i = 0; i < 8; ++i) row[64 * i + lane] = row[64 * i + lane] * rf * ((const f32x4*)F.final_norm)[64 * i + lane];
    }
}
__device__ __forceinline__ void p6_rot(Frame& F) {
    const int lane = opq(F.lane), gq = lane >> 3, s = lane & 7, x0 = F.bid & 7;
    const int* IDX = (const int*)(F.ws + WS_IDX); const float* GATE = (const float*)(F.ws + WS_GATE); const float* ESC = (const float*)(F.ws + WS_ESC); const float* ssq = (const float*)(F.ws + WS_SSQ);
    typedef _Float16 h16x4 __attribute__((ext_vector_type(4)));
    LAS unsigned char* wl = F.lds + F.wave * 19520;
    LAS _Float16* LZ = (LAS _Float16*)wl;
    LAS unsigned short* LID = (LAS unsigned short*)(wl + 16384);
    LAS float* LDOT = (LAS float*)(wl + 17408);
    LAS float* LSS = (LAS float*)(wl + 19456);
    const bf16* HB = (const bf16*)(F.ws + WS_AO);
#pragma unroll 1
    for (int tbase = F.gw; tbase < T; tbase += 4 * F.NGW) {
#pragma unroll
    for (int j = 0; j < 4; ++j) { const int t = tbase + F.NGW * j; const bool ok = t < T;
        LID[j * 128 + lane] = (unsigned short)(ok ? IDX[(size_t)t * 128 + lane] : 0); LID[j * 128 + 64 + lane] = (unsigned short)(ok ? IDX[(size_t)t * 128 + 64 + lane] : 0);
        LDOT[j * 128 + lane] = 0.f; LDOT[j * 128 + 64 + lane] = 0.f; if (lane == 0) LSS[j] = 0.f; }
    LDS_WAIT(); asm volatile("" ::: "memory");
#define P6R_LOAD(BA, BB, TAB, IT0) do { _Pragma("unroll") for (int q_ = 0; q_ < 4; ++q_) { const int it_ = (IT0) + q_; const int e_ = __shfl((it_ < 8) ? idA : idB, gq + 8 * (it_ & 7)); \
        const unsigned char* rp_ = (TAB) + (size_t)e_ * 192; BA[q_] = *(const U3*)(rp_ + 12 * s); BB[q_] = *(const U3*)(rp_ + 96 + 12 * s); } } while (0)
#define P6R_DEC(BA, BB, q_) __builtin_amdgcn_cvt_scalef32_pk32_f32_fp6((u32x6){BA[q_].a, BA[q_].b, BA[q_].c, BB[q_].a, BB[q_].b, BB[q_].c}, 1.0f)
    {
    typedef __bf16 b16x2 __attribute__((ext_vector_type(2)));
    typedef __bf16 b16x32 __attribute__((ext_vector_type(32)));
#pragma unroll 1
    for (int k = 0; k < 8; ++k) {
        const int x = (x0 + k) & 7; const unsigned char* TAB = F.ws + WS_ED + (size_t)x * NEXP * 192;
#pragma unroll 1
        for (int j = 0; j < 4; ++j) {
            const int t = tbase + F.NGW * j; if (t >= T) break;
            const bf16* hrow = HB + (size_t)t * DM + 256 * x + 32 * s;
            unsigned hh[16];
#pragma unroll
            for (int i = 0; i < 4; ++i) { const v4u a = ((const v4u*)hrow)[i]; hh[4 * i] = a.x; hh[4 * i + 1] = a.y; hh[4 * i + 2] = a.z; hh[4 * i + 3] = a.w; }
            const int idA = LID[j * 128 + lane], idB = LID[j * 128 + 64 + lane];
            U3 A0[4], B0[4], A1[4], B1[4];
#define P6R_DOTS(BA, BB, IT0) do { _Pragma("unroll") for (int q_ = 0; q_ < 4; ++q_) { \
        const b16x32 w_ = __builtin_amdgcn_cvt_scalef32_pk32_bf16_fp6((u32x6){BA[q_].a, BA[q_].b, BA[q_].c, BB[q_].a, BB[q_].b, BB[q_].c}, 1.0f); float p0_ = 0.f, p1_ = 0.f; \
        _Pragma("unroll") for (int i = 0; i < 8; ++i) { p0_ = __builtin_amdgcn_fdot2_f32_bf16((b16x2){w_[4 * i], w_[4 * i + 1]}, __builtin_bit_cast(b16x2, hh[2 * i]), p0_, false); p1_ = __builtin_amdgcn_fdot2_f32_bf16((b16x2){w_[4 * i + 2], w_[4 * i + 3]}, __builtin_bit_cast(b16x2, hh[2 * i + 1]), p1_, false); } \
        const float d_ = g8_sum(p0_ + p1_); if (s == 0) { LAS float* dp_ = LDOT + j * 128 + gq + 8 * ((IT0) + q_); *dp_ = *dp_ + d_; } \
        __builtin_amdgcn_sched_barrier(0); } } while (0)
            P6R_LOAD(A0, A1, TAB, 0);
            P6R_LOAD(B0, B1, TAB, 4); P6R_DOTS(A0, A1, 0);
            P6R_LOAD(A0, A1, TAB, 8); P6R_DOTS(B0, B1, 4);
            P6R_LOAD(B0, B1, TAB, 12); P6R_DOTS(A0, A1, 8);
            P6R_DOTS(B0, B1, 12);
#undef P6R_DOTS
        }
    }
    }
    LDS_WAIT(); asm volatile("" ::: "memory");
#pragma unroll 1
    for (int j = 0; j < 4; ++j) {
        const int t = tbase + F.NGW * j; if (t >= T) break;
        const float r2 = 1.0f / sqrtf(__hip_atomic_load(ssq + t, __ATOMIC_RELAXED, __HIP_MEMORY_SCOPE_AGENT) * (1.0f / DM) + EPS);
        const int idA = LID[j * 128 + lane], idB = LID[j * 128 + 64 + lane];
        const float cA = GATE[(size_t)t * 128 + lane] * gelu_erf(LDOT[j * 128 + lane] * r2 * ESC[idA]) * ESC[NEXP + idA];
        const float cB = GATE[(size_t)t * 128 + 64 + lane] * gelu_erf(LDOT[j * 128 + 64 + lane] * r2 * ESC[idB]) * ESC[NEXP + idB];
        LDOT[j * 128 + lane] = cA; LDOT[j * 128 + 64 + lane] = cB;
    }
    LDS_WAIT(); asm volatile("" ::: "memory");
    const bool b0 = (gq & 1) != 0; int pin_ = 0;
#pragma unroll 1
    for (int k = 0; k < 8; ++k) {
        const int x = (x0 + k) & 7; const unsigned char* TAB = F.ws + WS_EU + (size_t)x * NEXP * 192;
#pragma unroll 1
        for (int j = 0; j < 4; ++j) {
            const int t = tbase + F.NGW * j; if (t >= T) break;
            const f32x2 hq = *(const f32x2*)(HB + (size_t)t * DM + 256 * x + 32 * s + 4 * gq); const unsigned hq0 = __float_as_uint(hq.x), hq1 = __float_as_uint(hq.y);
            const f32x4 h4 = {bflo(hq0), bfhi(hq0), bflo(hq1), bfhi(hq1)};
            const int idA = LID[j * 128 + lane], idB = LID[j * 128 + 64 + lane];
            const float cA = LDOT[j * 128 + lane], cB = LDOT[j * 128 + 64 + lane];
            f32x2 y2[16];
#pragma unroll
            for (int i = 0; i < 16; ++i) y2[i] = (f32x2){0.f, 0.f};
            U3 A0[4], B0[4], A1[4], B1[4];
#define P6R_PIN16(Y, B_) asm volatile("" : "+v"(Y[B_]), "+v"(Y[B_ + 1]), "+v"(Y[B_ + 2]), "+v"(Y[B_ + 3]), "+v"(Y[B_ + 4]), "+v"(Y[B_ + 5]), "+v"(Y[B_ + 6]), "+v"(Y[B_ + 7]))
#define P6R_AXPY1(BA, BB, q_, IT_, NXT_) do { const float ce_ = __shfl(((IT_) < 8) ? cA : cB, gq + 8 * ((IT_) & 7)); \
        const f32x32 w_ = P6R_DEC(BA, BB, q_); const f32x2 ce2_ = {ce_, ce_}; _Pragma("unroll") for (int i = 0; i < 16; ++i) y2[i] = __builtin_elementwise_fma((f32x2){w_[2 * i], w_[2 * i + 1]}, ce2_, y2[i]); \
        P6R_PIN16(y2, 0); P6R_PIN16(y2, 8); asm volatile("" : "+v"(NXT_)); } while (0)
#define P6R_AXPY(BA, BB, IT0) do { P6R_AXPY1(BA, BB, 0, (IT0), BA[1].a); P6R_AXPY1(BA, BB, 1, (IT0) + 1, BA[2].a); P6R_AXPY1(BA, BB, 2, (IT0) + 2, BA[3].a); P6R_AXPY1(BA, BB, 3, (IT0) + 3, pin_); } while (0)
            P6R_LOAD(A0, A1, TAB, 0);
            P6R_LOAD(B0, B1, TAB, 4); P6R_AXPY(A0, A1, 0);
            P6R_LOAD(A0, A1, TAB, 8); P6R_AXPY(B0, B1, 4);
            P6R_LOAD(B0, B1, TAB, 12); P6R_AXPY(A0, A1, 8);
            P6R_AXPY(B0, B1, 12);
#undef P6R_AXPY
#undef P6R_AXPY1
#undef P6R_PIN16
            float y[32], k16[16], k8[8], k4[4];
#pragma unroll
            for (int i = 0; i < 16; ++i) { y[2 * i] = y2[i].x; y[2 * i + 1] = y2[i].y; }
#pragma unroll
            for (int i = 0; i < 16; ++i) { const auto r_ = __builtin_amdgcn_permlane32_swap(__float_as_uint(y[i]), __float_as_uint(y[16 + i]), false, false); k16[i] = __uint_as_float(r_[0]) + __uint_as_float(r_[1]); }
#pragma unroll
            for (int i = 0; i < 8; ++i) { const auto r_ = __builtin_amdgcn_permlane16_swap(__float_as_uint(k16[i]), __float_as_uint(k16[8 + i]), false, false); k8[i] = __uint_as_float(r_[0]) + __uint_as_float(r_[1]); }
#pragma unroll
            for (int i = 0; i < 4; ++i) { const float keep = b0 ? k8[4 + i] : k8[i], send = b0 ? k8[i] : k8[4 + i]; k4[i] = keep + dppf<0x128>(send); }
            const f32x4 z = {h4[0] + k4[0], h4[1] + k4[1], h4[2] + k4[2], h4[3] + k4[3]};
            *(LAS h16x4*)(LZ + j * 2048 + 256 * x + 32 * s + 4 * gq) = (h16x4){(_Float16)z[0], (_Float16)z[1], (_Float16)z[2], (_Float16)z[3]};
            const float ss = wave_sum_fast((z[0] * z[0] + z[1] * z[1]) + (z[2] * z[2] + z[3] * z[3]));
            if (lane == 0) LSS[j] = LSS[j] + ss;
        }
    }
#undef P6R_LOAD
#undef P6R_DEC
    LDS_WAIT(); asm volatile("" ::: "memory");
#pragma unroll 1
    for (int j = 0; j < 4; ++j) {
        const int t = tbase + F.NGW * j; if (t >= T) break;
        f32x4* row = (f32x4*)(F.out + (size_t)t * DM);
        const float rf = 1.0f / sqrtf(LSS[j] * (1.0f / DM) + EPS);
#pragma unroll
        for (int i = 0; i < 8; ++i) { const h16x4 zv = *(const LAS h16x4*)(LZ + j * 2048 + 256 * i + 4 * lane); const f32x4 w = ((const f32x4*)F.final_norm)[64 * i + lane];
            row[64 * i + lane] = (f32x4){(float)zv[0] * rf * w[0], (float)zv[1] * rf * w[1], (float)zv[2] * rf * w[2], (float)zv[3] * rf * w[3]}; }
    }
    asm volatile("s_waitcnt vmcnt(0) lgkmcnt(0)" ::: "memory");
    }
}
typedef unsigned gu32;
#define XB_TMO      128
#define XB_XCNT(j)  (256  + 64 * (j))
#define XB_XSUB(j)  (1280 + 64 * (j))
#define XB_XGEN(j)  (2304 + 64 * (j))
#define XB_TOP      3328
#define XB_TOPGEN   3392
#define XCD_BAR_WORDS 3456
#define XB_SPIN_CAP (1u << 18)

__device__ __forceinline__ unsigned xb_ld(unsigned* p)              { return __hip_atomic_load(p, __ATOMIC_RELAXED, __HIP_MEMORY_SCOPE_AGENT); }
__device__ __forceinline__ unsigned xb_add(unsigned* p, unsigned v) { return __hip_atomic_fetch_add(p, v, __ATOMIC_RELAXED, __HIP_MEMORY_SCOPE_AGENT); }
__device__ __forceinline__ unsigned xb_xcc_id() { return (unsigned)__builtin_amdgcn_s_getreg((3 << 11) | 20) & 0xFu; }
#define XB_SPIN(cond, bar) do { unsigned _sp = 0; while (cond) { __builtin_amdgcn_s_sleep(1); \
    if ((++_sp & 255u) == 0u) { if (xb_ld(&(bar)[XB_TMO])) break; if (_sp > XB_SPIN_CAP) { atomicAdd(&(bar)[XB_TMO], 1u); break; } } } } while (0)

struct XcdBarrier {
    unsigned* bar; unsigned x;
    volatile LAS unsigned* st;
};

__device__ __forceinline__ XcdBarrier xcd_barrier_post(unsigned* bar, volatile LAS unsigned* st) {
    XcdBarrier b; b.bar = bar; b.x = xb_xcc_id(); b.st = st;
    if (threadIdx.x == 0) (void)xb_add(&bar[XB_XCNT(b.x)], 1u);
    return b;
}
__device__ __forceinline__ void xcd_barrier_complete(unsigned* bar, unsigned x, unsigned& nloc, unsigned& nx) {
    const unsigned G = gridDim.x * gridDim.y * gridDim.z;
    unsigned sum, cnt, mine, sp = 0u;
    for (;;) {
        sum = 0u; cnt = 0u; mine = 0u;
#pragma unroll
        for (unsigned j = 0; j < 16; ++j) { const unsigned c = xb_ld(&bar[XB_XCNT(j)]); sum += c; cnt += (c > 0u) ? 1u : 0u; mine = (j == x) ? c : mine; }
        if (sum == G) break;
        __builtin_amdgcn_s_sleep(1);
        if ((++sp & 255u) == 0u) { if (xb_ld(&bar[XB_TMO])) break; if (sp > XB_SPIN_CAP) { atomicAdd(&bar[XB_TMO], 1u); break; } }
    }
    nloc = mine > 0u ? mine : 1u; nx = cnt > 0u ? cnt : 1u;
}

__device__ __forceinline__ void xcd_barrier(const XcdBarrier& b) {
    asm volatile("s_waitcnt vmcnt(0)" ::: "memory");
    __syncthreads();
    if (threadIdx.x == 0) {
        unsigned* bar = b.bar;
        __builtin_amdgcn_s_waitcnt(0);
        unsigned nloc = b.st[0], nx = b.st[1];
        if (nloc == 0u) { xcd_barrier_complete(bar, b.x, nloc, nx); b.st[0] = nloc; b.st[1] = nx; }
        const unsigned old = xb_add(&bar[XB_XSUB(b.x)], 1u);
        const unsigned gen = old / nloc;
        if (old + 1u == (gen + 1u) * nloc) {
            __builtin_amdgcn_fence(__ATOMIC_RELEASE, "agent");
            asm volatile("s_waitcnt vmcnt(0)" ::: "memory");
            const unsigned og = xb_add(&bar[XB_TOP], 1u);
            const unsigned tg = og / nx;
            if (og + 1u == (tg + 1u) * nx) xb_add(&bar[XB_TOPGEN], 1u);
            else XB_SPIN(xb_ld(&bar[XB_TOPGEN]) == tg, bar);
            __builtin_amdgcn_fence(__ATOMIC_ACQUIRE, "agent");
            xb_add(&bar[XB_XGEN(b.x)], 1u);
            asm volatile("s_waitcnt vmcnt(0)" ::: "memory");
        } else {
            XB_SPIN(xb_ld(&bar[XB_XGEN(b.x)]) == gen, bar);
            __builtin_amdgcn_fence(__ATOMIC_ACQUIRE, "agent");
            asm volatile("s_waitcnt vmcnt(0)" ::: "memory");
        }
    }
    __syncthreads();
}

constexpr int NPH = 10;
struct Args { const float* in[13]; float* out; unsigned char* ws; int ph_lo, ph_hi; };
__global__ void __launch_bounds__(NWAVES * 64, 2) mk_fwd(Args a) {
    extern __shared__ __attribute__((aligned(16))) unsigned char lds[];
    cg::grid_group grid = cg::this_grid();
    Frame F;
    F.lds = (LAS unsigned char*)lds; F.tid = threadIdx.x; F.lane = F.tid & 63; F.wave = __builtin_amdgcn_readfirstlane(F.tid >> 6);
    F.G = gridDim.x; F.bid = blockIdx.x; F.gw = F.bid * NWAVES + F.wave; F.NGW = F.G * NWAVES;
    F.x = a.in[0]; F.attn_norm = a.in[1]; F.w_in = a.in[2]; F.sinks = a.in[3]; F.w_attn = a.in[4]; F.w_ret = a.in[5]; F.w_out = a.in[6]; F.ffn_norm = a.in[7];
    F.w_q = a.in[8]; F.sub_keys = a.in[9]; F.e_down = a.in[10]; F.e_up = a.in[11]; F.final_norm = a.in[12]; F.out = a.out; F.ws = a.ws;
    unsigned char* ws = a.ws;
    const int lo = a.ph_lo, hi = a.ph_hi;
#define IN(k) (lo <= (k) && (k) < hi)
    volatile LAS unsigned* MISC = (volatile LAS unsigned*)(F.lds + LDS_BYTES - 256);
    if (F.tid < 32) MISC[F.tid] = 0u;
    __syncthreads();
    XcdBarrier xbar = xcd_barrier_post((unsigned*)(ws + 16384), MISC + 8);
#define SEAM(k) do { if (IN(k) && IN((k) + 1)) { if (lo < 0) grid.sync(); else xcd_barrier(xbar); } } while (0)
    pg8::bf16_t* PROJ = (pg8::bf16_t*)(ws + WS_PROJ);
    float* KV = F.out;
    if (IN(0)) { p0_prologue(F); if (PEER_FP8 == 1) p0_experts_fp8(F); if (PEER_FP8 == 2) p0_experts_fp6(F); if (PEER_FP8 == 3) p0_experts_fp6s(F); }
    SEAM(0);
    if (IN(1)) {
        pg8::Gemm g{(const pg8::bf16_t*)(ws + WS_XB), (const pg8::bf16_t*)(ws + WS_WIN), T, NPROJ, GEMM1_FP8 ? DM / 2 : DM}; pg8::StaticOrder S; S.init(T, NPROJ, F.G, F.bid);
        pg8::EpiProj E{PROJ, (const float*)(ws + WS_R1), (const pg8::f32x4*)(ws + WS_ROPE), GEMM1_FP8 ? 1.0f / (G1_XS * G1_WS) : 0.0f, ws + WS_G8};
        pg8::gemm_phase<pg8::EpiProj, pg8::StaticOrder, true, true, (GEMM1_FP8 != 0)>(F.lds, g, S, E);
    }
    SEAM(1);
    if (IN(2)) { p2_attn_mfma(F); p2_kv_mfma(F, KV); }
    SEAM(2);
    if (IN(3)) p2_scan(F, KV);
    SEAM(3);
    if (IN(4)) p2_retout_mfma(F, KV);
    SEAM(4);
    if (IN(5)) {
        constexpr float p3fix = P3_FP8 ? 1.0f / (P3_AS * G1_WS) : 1.0f;
        { pg8::Gemm g{(const pg8::bf16_t*)(ws + WS_AO), (const pg8::bf16_t*)(ws + WS_WA), T, DM, P3_FP8 ? 512 : 1024}; pg8::StaticOrder S; S.init(T, DM, F.G, F.bid);
          pg8::EpiGate1 E{(pg8::bf16_t*)F.out, ws + WS_G8, C_GA - 7680, p3fix};
          pg8::gemm_phase<pg8::EpiGate1, pg8::StaticOrder, true, true, (P3_FP8 != 0)>(F.lds, g, S, E); }
        { pg8::Gemm g{(const pg8::bf16_t*)(ws + WS_RO), (const pg8::bf16_t*)(ws + WS_WR), T, DM, P3_FP8 ? DM / 2 : DM}; pg8::StaticOrder S; S.init(T, DM, F.G, F.bid);
          pg8::EpiGate2 E{(const pg8::bf16_t*)F.out, ws + WS_G8, C_GT - 7680, (pg8::bf16_t*)(ws + WS_XB), p3fix, P4_FP8 ? P3_AS : 0.0f};
          pg8::gemm_phase<pg8::EpiGate2, pg8::StaticOrder, true, true, (P3_FP8 != 0)>(F.lds, g, S, E); }
    }
    SEAM(5);
    if (IN(6)) {
        pg8::Gemm g{(const pg8::bf16_t*)(ws + WS_XB), (const pg8::bf16_t*)(ws + WS_WO), T, DM, P4_FP8 ? DM / 2 : DM}; pg8::StaticOrder S; S.init(T, DM, F.G, F.bid);
        pg8::EpiHres E{F.x, (pg8::bf16_t*)(ws + WS_AO), (float*)(ws + WS_SSQ), P4_FP8 ? 1.0f / (P3_AS * G1_WS) : 1.0f};
        pg8::gemm_phase<pg8::EpiHres, pg8::StaticOrder, true, true, (P4_FP8 != 0)>(F.lds, g, S, E);
    }
    SEAM(6);
    if (IN(7)) {
        pg8::Gemm g{(const pg8::bf16_t*)(ws + WS_AO), (const pg8::bf16_t*)(ws + WS_WQ), T, DM, DM}; pg8::StaticOrder S; S.init(T, DM, F.G, F.bid);
        pg8::EpiQry E{PROJ, (const float*)(ws + WS_SSQ)};
        pg8::gemm_phase<pg8::EpiQry, pg8::StaticOrder, true, true>(F.lds, g, S, E);
        asm volatile("s_waitcnt vmcnt(0)" ::: "memory"); __syncthreads();
        __builtin_amdgcn_fence(__ATOMIC_ACQUIRE, "agent"); asm volatile("s_waitcnt vmcnt(0)" ::: "memory"); __syncthreads();
        pg8::Unit uu; for (int i = 0; S.next(i, uu); ++i) p5_topk_v2(F, uu.pm, uu.pn);
    }
    SEAM(8);
    if (PEER_FP8 == 3) {
        if (IN(9)) p6_rot(F);
    } else {
        if (IN(9)) { if (PEER_FP8 == 2) p6_peer_fp6(F); else p6_peer2<(PEER_FP8 == 1)>(F); }
    }
#undef IN
#undef SEAM
}
}

#ifndef MK_N_LAUNCHES
#define MK_N_LAUNCHES 1
#endif
extern "C" void kernel_launch(void* const* d_in, const int* in_sizes, int n_in, void* d_out, int out_size, void* d_ws, size_t ws_size, hipStream_t stream) {
    using namespace mk;
    static int grid = 0;
    if (grid == 0) {
        if (n_in != 13 || out_size != T * DM || ws_size < WS_END) { fprintf(stderr, "kernel_launch: unexpected problem (n_in %d, out %d, ws %zu)\n", n_in, out_size, ws_size); grid = -1; return; }
        int dev = 0, cus = 0, per_cu = 0;
        if (hipGetDevice(&dev) != hipSuccess || hipDeviceGetAttribute(&cus, hipDeviceAttributeMultiprocessorCount, dev) != hipSuccess) { grid = -1; return; }
        if (hipFuncSetAttribute((const void*)mk_fwd, hipFuncAttributeMaxDynamicSharedMemorySize, LDS_BYTES) != hipSuccess) { fprintf(stderr, "kernel_launch: hipFuncSetAttribute failed\n"); grid = -1; return; }
        if (hipOccupancyMaxActiveBlocksPerMultiprocessor(&per_cu, (const void*)mk_fwd, NWAVES * 64, LDS_BYTES) != hipSuccess || per_cu < 1) { fprintf(stderr, "kernel_launch: occupancy query says %d\n", per_cu); per_cu = 1; }
        (void)hipGetLastError();
        grid = cus * (per_cu < 1 ? 1 : per_cu);
        if (grid > 256) grid = 256;
    }
    if (grid < 0) return;
    (void)hipMemsetAsync((char*)d_ws + WS_CTL, 0, CTL_BYTES, stream);
    Args a{};
    for (int i = 0; i < 13; ++i) a.in[i] = (const float*)d_in[i];
    a.out = (float*)d_out; a.ws = (unsigned char*)d_ws;
#if MK_N_LAUNCHES == 1
    a.ph_lo = 0; a.ph_hi = NPH;
    void* args[] = {&a};
    hipError_t e = hipLaunchCooperativeKernel((const void*)mk_fwd, dim3(grid), dim3(NWAVES * 64), args, LDS_BYTES, stream);
    if (e != hipSuccess) fprintf(stderr, "kernel_launch: cooperative launch failed: %s (grid %d)\n", hipGetErrorString(e), grid);
#else
    for (int ph = 0; ph < NPH; ++ph) { a.ph_lo = ph; a.ph_hi = ph + 1; hipLaunchKernelGGL(mk_fwd, dim3(grid), dim3(NWAVES * 64), LDS_BYTES, stream, a); }
#endif
}
```

```cpp
#include <hip/hip_runtime.h>
#include <hip/hip_cooperative_groups.h>
#include <cstdio>
#include <cstdint>
namespace cg = cooperative_groups;
namespace pg8 {
#define PG8_LAS __attribute__((address_space(3)))
typedef unsigned short bf16_t;
typedef short bf16x8 __attribute__((ext_vector_type(8)));
typedef float f32x4 __attribute__((ext_vector_type(4)));
typedef unsigned u32x4 __attribute__((ext_vector_type(4)));
typedef int i32x4_t __attribute__((ext_vector_type(4)));
typedef int i32x8_t __attribute__((ext_vector_type(8)));
constexpr int BM = 256, BK = 64, HALF = 128, HTB = HALF * BK * 2  , STAGE_BYTES = 8 * HTB, NXCD = 8, WGM = 8;

__host__ __device__ __forceinline__ int lds_byte(int r, int c) { const int st = (r >> 4) * 2 + (c >> 5), rr = r & 15, cc = c & 31, ob = rr * 64 + cc * 2; return st * 1024 + (ob ^ (((ob >> 9) & 1) << 5)); }
__host__ __device__ __forceinline__ void stage_rc(int b, int& R, int& C) { const int st = b / 1024, sb = b % 1024, swz = sb ^ (((sb >> 9) & 1) << 5); R = (st >> 1) * 16 + swz / 64; C = (st & 1) * 32 + (swz % 64) / 2; }
__host__ __device__ __forceinline__ int perm32(int rho) { const int n = rho >> 4, i = rho & 15; return 8 * (i >> 2) + 4 * n + (i & 3); }

struct Unit { int pm, pn; };
struct Gemm { const bf16_t* A; const bf16_t* Bt; int M, N, K; };

struct StaticOrder {
    int nM, nN, nwg, G, c;
    __host__ __device__ void init(int M, int N, int G_, int c_) { nM = M / BM; nN = N / BM; nwg = nM * nN; G = G_; c = c_; }
    __host__ __device__ bool next(int i, Unit& u) const {
        const long L = (long)i * G + c; if (L >= nwg) return false;
        int wgid = (int)L; { const int q = nwg / NXCD, r = nwg % NXCD, xcd = wgid % NXCD, off = wgid / NXCD; wgid = (xcd < r ? xcd * (q + 1) : r * (q + 1) + (xcd - r) * q) + off; }
        const int nig = WGM * nN, gid = wgid / nig, fm = gid * WGM, gsz = (nM - fm) < WGM ? (nM - fm) : WGM;
        u.pm = fm + ((wgid % nig) % gsz); u.pn = (wgid % nig) / gsz; return true;
    }
    __device__ __forceinline__ void a_ready(const Unit&) const {}
    __device__ __forceinline__ void done(const Unit&) const {}
};

__device__ __forceinline__ unsigned cvt_pk_bf16(float lo, float hi) { unsigned r; asm volatile("v_cvt_pk_bf16_f32 %0, %1, %2" : "=v"(r) : "v"(lo), "v"(hi)); return r; }
typedef float f32x2 __attribute__((ext_vector_type(2)));
__device__ __forceinline__ f32x2 gelu_pk(f32x2 v) {
    const f32x2 av = __builtin_elementwise_abs(v), d = av * 0.2316418882f + 1.0f;
    f32x2 t; t.x = __builtin_amdgcn_rcpf(d.x); t.y = __builtin_amdgcn_rcpf(d.y);
    f32x2 q = t * 0.5307027145f + (-0.7265760135f); q = q * t + 0.7107068705f; q = q * t + (-0.142248368f); q = q * t + 0.127414796f; q = q * t;
    const f32x2 s = (v * v) * (-0.72134752044f);
    f32x2 e; e.x = __builtin_amdgcn_exp2f(s.x); e.y = __builtin_amdgcn_exp2f(s.y);
    const f32x2 m = v * (q * e), r = v - m;
    f32x2 o; o.x = v.x < 0.f ? m.x : r.x; o.y = v.y < 0.f ? m.y : r.y; return o;
}

constexpr float QA_SCALE = 0.08838834764831845f * 1.4426950408889634f;
constexpr float KR_SCALE = 0.08838834764831845f;
constexpr int NPROJ = 11776;
__device__ __forceinline__ f32x4 rope4(f32x4 v, f32x4 cs) {
    f32x4 o; o[0] = v[0] * cs[0] - v[1] * cs[1]; o[1] = v[1] * cs[0] + v[0] * cs[1]; o[2] = v[2] * cs[2] - v[3] * cs[3]; o[3] = v[3] * cs[2] + v[2] * cs[3]; return o;
}
__device__ __forceinline__ float sigm(float x) { return __builtin_amdgcn_rcpf(1.0f + __builtin_amdgcn_exp2f(x * -1.4426950408889634f)); }
struct EpiProj {
    static constexpr bool PERM = true, AFTER_DRAIN = false;
    bf16_t* O; const float* r1; const f32x4* rope; float fixed;
    __device__ __forceinline__ void operator()(const f32x4 (&acc)[2][2][4][2], const Unit& u, int wr, int wc, int fr, int fq) const {
        asm volatile("" : "+v"(fr), "+v"(fq));
        const int colt = u.pn * BM;
        int mode; float sc = 1.f;
        if (colt < 1024) { mode = 1; sc = QA_SCALE; } else if (colt < 1280) mode = 1; else if (colt < 1536) mode = 0;
        else if (colt < 2560) mode = 1; else if (colt < 3584) { mode = 1; sc = KR_SCALE; } else if (colt < 5632) mode = 0;
        else if (colt < 7680) mode = 2; else mode = 3;
        const int row0 = u.pm * BM + wr * 64 + fr, col0 = colt + wc * 32 + 8 * fq;
        float rsv[2][4];
#pragma unroll
        for (int ai = 0; ai < 2; ++ai)
#pragma unroll
            for (int m = 0; m < 4; ++m) rsv[ai][m] = (fixed != 0.f) ? fixed : r1[row0 + ai * HALF + m * 16];
#pragma unroll
        for (int ai = 0; ai < 2; ++ai)
#pragma unroll
            for (int m = 0; m < 4; ++m) {
                const int row = row0 + ai * HALF + m * 16; const float rs = rsv[ai][m] * sc;
                bf16_t* rowp = O + (size_t)row * NPROJ + col0;
                f32x4 cs0 = {1.f, 0.f, 1.f, 0.f}, cs1 = {1.f, 0.f, 1.f, 0.f};
                if (mode == 1) { const f32x4* rp = rope + (size_t)(row & 4095) * 32 + 8 * wc + 2 * fq; cs0 = rp[0]; cs1 = rp[1]; }
#pragma unroll
                for (int bj = 0; bj < 2; ++bj) {
                    f32x4 v0 = acc[ai][bj][m][0] * rs, v1 = acc[ai][bj][m][1] * rs;
                    if (mode == 1) { v0 = rope4(v0, cs0); v1 = rope4(v1, cs1); }
                    else if (mode == 2) {
#pragma unroll
                        for (int i = 0; i < 4; ++i) { v0[i] = v0[i] * sigm(v0[i]); v1[i] = v1[i] * sigm(v1[i]); } }
                    u32x4 w; w.x = cvt_pk_bf16(v0[0], v0[1]); w.y = cvt_pk_bf16(v0[2], v0[3]); w.z = cvt_pk_bf16(v1[0], v1[1]); w.w = cvt_pk_bf16(v1[2], v1[3]);
                    *(u32x4*)(rowp + bj * HALF) = w; }
            }
    }
};
__device__ __forceinline__ float bf_lo(unsigned u) { return __uint_as_float(u << 16); }
__device__ __forceinline__ float bf_hi(unsigned u) { return __uint_as_float(u & 0xffff0000u); }
struct EpiGate1 {
    static constexpr bool PERM = true, AFTER_DRAIN = false;
    bf16_t* TMP; const bf16_t* G; int gcol; float fixed;
    __device__ __forceinline__ void operator()(const f32x4 (&acc)[2][2][4][2], const Unit& u, int wr, int wc, int fr, int fq) const {
        const int row0 = u.pm * BM + wr * 64 + fr, col0 = u.pn * BM + wc * 32 + 8 * fq;
#pragma unroll
        for (int ai = 0; ai < 2; ++ai)
#pragma unroll
            for (int m = 0; m < 4; ++m) { const int row = row0 + ai * HALF + m * 16;
#pragma unroll
                for (int bj = 0; bj < 2; ++bj) { const int col = col0 + bj * HALF;
                    const u32x4 g = *(const u32x4*)(G + (size_t)row * NPROJ + gcol + col);
                    f32x4 v0 = acc[ai][bj][m][0] * fixed, v1 = acc[ai][bj][m][1] * fixed;
                    v0[0] *= sigm(bf_lo(g.x)); v0[1] *= sigm(bf_hi(g.x)); v0[2] *= sigm(bf_lo(g.y)); v0[3] *= sigm(bf_hi(g.y));
                    v1[0] *= sigm(bf_lo(g.z)); v1[1] *= sigm(bf_hi(g.z)); v1[2] *= sigm(bf_lo(g.w)); v1[3] *= sigm(bf_hi(g.w));
                    u32x4 w; w.x = cvt_pk_bf16(v0[0], v0[1]); w.y = cvt_pk_bf16(v0[2], v0[3]); w.z = cvt_pk_bf16(v1[0], v1[1]); w.w = cvt_pk_bf16(v1[2], v1[3]);
                    *(u32x4*)(TMP + (size_t)row * 2048 + col) = w; } }
    }
};
struct EpiGate2 {
    static constexpr bool PERM = true, AFTER_DRAIN = false;
    const bf16_t* TMP; const bf16_t* G; int gcol; bf16_t* MG; float fixed; float out8;
    __device__ __forceinline__ void operator()(const f32x4 (&acc)[2][2][4][2], const Unit& u, int wr, int wc, int fr, int fq) const {
        const int row0 = u.pm * BM + wr * 64 + fr, col0 = u.pn * BM + wc * 32 + 8 * fq;
#pragma unroll
        for (int ai = 0; ai < 2; ++ai)
#pragma unroll
            for (int m = 0; m < 4; ++m) { const int row = row0 + ai * HALF + m * 16;
#pragma unroll
                for (int bj = 0; bj < 2; ++bj) { const int col = col0 + bj * HALF;
                    const u32x4 g = *(const u32x4*)(G + (size_t)row * NPROJ + gcol + col);
                    const u32x4 tq = *(const u32x4*)(TMP + (size_t)row * 2048 + col); const f32x4 t0 = {bf_lo(tq.x), bf_hi(tq.x), bf_lo(tq.y), bf_hi(tq.y)}, t1 = {bf_lo(tq.z), bf_hi(tq.z), bf_lo(tq.w), bf_hi(tq.w)};
                    f32x4 v0 = acc[ai][bj][m][0] * fixed, v1 = acc[ai][bj][m][1] * fixed;
                    v0[0] = t0[0] + v0[0] * sigm(bf_lo(g.x)); v0[1] = t0[1] + v0[1] * sigm(bf_hi(g.x)); v0[2] = t0[2] + v0[2] * sigm(bf_lo(g.y)); v0[3] = t0[3] + v0[3] * sigm(bf_hi(g.y));
                    v1[0] = t1[0] + v1[0] * sigm(bf_lo(g.z)); v1[1] = t1[1] + v1[1] * sigm(bf_hi(g.z)); v1[2] = t1[2] + v1[2] * sigm(bf_lo(g.w)); v1[3] = t1[3] + v1[3] * sigm(bf_hi(g.w));
                    if (out8 != 0.f) { v0 = v0 * out8; v1 = v1 * out8;
#pragma unroll
                        for (int i = 0; i < 4; ++i) { v0[i] = fminf(fmaxf(v0[i], -448.f), 448.f); v1[i] = fminf(fmaxf(v1[i], -448.f), 448.f); }
                        int p0 = 0, p1 = 0; p0 = __builtin_amdgcn_cvt_pk_fp8_f32(v0[0], v0[1], p0, false); p0 = __builtin_amdgcn_cvt_pk_fp8_f32(v0[2], v0[3], p0, true);
                        p1 = __builtin_amdgcn_cvt_pk_fp8_f32(v1[0], v1[1], p1, false); p1 = __builtin_amdgcn_cvt_pk_fp8_f32(v1[2], v1[3], p1, true);
                        f32x2 o; o.x = __builtin_bit_cast(float, p0); o.y = __builtin_bit_cast(float, p1); *(f32x2*)((unsigned char*)MG + (size_t)row * 2048 + col) = o; }
                    else { u32x4 w; w.x = cvt_pk_bf16(v0[0], v0[1]); w.y = cvt_pk_bf16(v0[2], v0[3]); w.z = cvt_pk_bf16(v1[0], v1[1]); w.w = cvt_pk_bf16(v1[2], v1[3]);
                    *(u32x4*)(MG + (size_t)row * 2048 + col) = w; } } }
    }
};
struct EpiHres {
    static constexpr bool PERM = true, AFTER_DRAIN = false;
    const float* X; bf16_t* Hb; float* ssq; float fixed;
    __device__ __forceinline__ void operator()(const f32x4 (&acc)[2][2][4][2], const Unit& u, int wr, int wc, int fr, int fq) const {
        const int row0 = u.pm * BM + wr * 64 + fr, col0 = u.pn * BM + wc * 32 + 8 * fq;
#pragma unroll
        for (int ai = 0; ai < 2; ++ai)
#pragma unroll
            for (int m = 0; m < 4; ++m) { const int row = row0 + ai * HALF + m * 16; float ss = 0.f;
#pragma unroll
                for (int bj = 0; bj < 2; ++bj) { const size_t off = (size_t)row * 2048 + col0 + bj * HALF;
                    const f32x4 x0 = *(const f32x4*)(X + off), x1 = *(const f32x4*)(X + off + 4);
                    const f32x4 v0 = acc[ai][bj][m][0] * fixed + x0, v1 = acc[ai][bj][m][1] * fixed + x1;
                    u32x4 w; w.x = cvt_pk_bf16(v0[0], v0[1]); w.y = cvt_pk_bf16(v0[2], v0[3]); w.z = cvt_pk_bf16(v1[0], v1[1]); w.w = cvt_pk_bf16(v1[2], v1[3]);
                    *(u32x4*)(Hb + off) = w;
                    ss += (v0[0] * v0[0] + v0[1] * v0[1]) + (v0[2] * v0[2] + v0[3] * v0[3]) + (v1[0] * v1[0] + v1[1] * v1[1]) + (v1[2] * v1[2] + v1[3] * v1[3]); }
                ss += __shfl_xor(ss, 16); ss += __shfl_xor(ss, 32);
                if (fq == 0) atomicAdd(ssq + row, ss); }
    }
};
struct EpiQry {
    static constexpr bool PERM = true, AFTER_DRAIN = false;
    bf16_t* Q; const float* ssq;
    __device__ __forceinline__ void operator()(const f32x4 (&acc)[2][2][4][2], const Unit& u, int wr, int wc, int fr, int fq) const {
        const int row0 = u.pm * BM + wr * 64 + fr, col0 = u.pn * BM + wc * 32 + 8 * fq;
#pragma unroll
        for (int ai = 0; ai < 2; ++ai)
#pragma unroll
            for (int m = 0; m < 4; ++m) { const int row = row0 + ai * HALF + m * 16;
                const float rs = 1.0f / sqrtf(__hip_atomic_load(ssq + row, __ATOMIC_RELAXED, __HIP_MEMORY_SCOPE_AGENT) * (1.0f / 2048.0f) + 1e-6f);
#pragma unroll
                for (int bj = 0; bj < 2; ++bj) { const f32x4 v0 = acc[ai][bj][m][0] * rs, v1 = acc[ai][bj][m][1] * rs;
                    u32x4 w; w.x = cvt_pk_bf16(v0[0], v0[1]); w.y = cvt_pk_bf16(v0[2], v0[3]); w.z = cvt_pk_bf16(v1[0], v1[1]); w.w = cvt_pk_bf16(v1[2], v1[3]);
                    *(u32x4*)(Q + (size_t)row * 2048 + col0 + bj * HALF) = w; } }
    }
};

template <class Epi, class Sched, bool ALIGN_EPI = false, bool SP2 = false, bool FP8 = false>
__device__ __forceinline__ void gemm_phase(PG8_LAS unsigned char* lds, const Gemm g, const Sched& S, const Epi& E) {
    const int tid = threadIdx.x, wid = __builtin_amdgcn_readfirstlane(tid >> 6), lane = tid & 63, wr = wid >> 2, wc = wid & 3, fr = lane & 15, fq = lane >> 4;
    const int K = g.K, nt = K / BK;
    unsigned voffA[2], voffB[2];
#pragma unroll
    for (int i = 0; i < 2; ++i) { int R, C; stage_rc(tid * 16 + i * 8192, R, C); const int Rb = Epi::PERM ? ((R & ~31) + perm32(R & 31)) : R;
        voffA[i] = (unsigned)(R * K + C) * 2u; voffB[i] = (unsigned)(Rb * K + C) * 2u; }
    const size_t kstep = (size_t)(BK * 2);
    const size_t hstep = (size_t)HALF * K * 2;
    const size_t tstep = 2 * hstep;
    const unsigned ldsw = (unsigned)wid * 1024u;
    const int aoff = lds_byte(wr * 64 + fr, fq * 8), boff = lds_byte(wc * 32 + fr, fq * 8);
#define PG8_SA(b, h) (((b) * 2 + (h)) * HTB)
#define PG8_SB(b, h) ((4 + (b) * 2 + (h)) * HTB)
#define PG8_STAGE(bufoff, gbase, voff) do { _Pragma("unroll") for (int _i = 0; _i < 2; ++_i) \
        __builtin_amdgcn_global_load_lds((const unsigned*)((const char*)(gbase) + (voff)[_i]), (PG8_LAS unsigned*)(lds + (bufoff) + ldsw + _i * 8192), 16, 0, 0); } while (0)
#define PG8_LD8(p_) ({ const i32x4_t lo_ = *(const PG8_LAS i32x4_t*)(p_), hi_ = *(const PG8_LAS i32x4_t*)((p_) + 1024); (i32x8_t){lo_[0], lo_[1], lo_[2], lo_[3], hi_[0], hi_[1], hi_[2], hi_[3]}; })
#define PG8_LDA(dst, b, h) do { if constexpr (FP8) { _Pragma("unroll") for (int m = 0; m < 4; ++m) dst##8[m] = PG8_LD8(lds + PG8_SA(b, h) + aoff + m * 2048); } \
        else { _Pragma("unroll") for (int m = 0; m < 4; ++m) _Pragma("unroll") for (int k = 0; k < 2; ++k) dst[m][k] = *(const PG8_LAS bf16x8*)(lds + PG8_SA(b, h) + aoff + m * 2048 + k * 1024); } } while (0)
#define PG8_LDB(dst, b, h) do { if constexpr (FP8) { _Pragma("unroll") for (int n = 0; n < 2; ++n) dst##8[n] = PG8_LD8(lds + PG8_SB(b, h) + boff + n * 2048); } \
        else { _Pragma("unroll") for (int n = 0; n < 2; ++n) _Pragma("unroll") for (int k = 0; k < 2; ++k) dst[n][k] = *(const PG8_LAS bf16x8*)(lds + PG8_SB(b, h) + boff + n * 2048 + k * 1024); } } while (0)
#define PG8_MMA(ai, bj, At, Bt) do { __builtin_amdgcn_s_setprio(1); \
        if constexpr (FP8) { _Pragma("unroll") for (int m = 0; m < 4; ++m) _Pragma("unroll") for (int n = 0; n < 2; ++n) \
            asm volatile("v_mfma_scale_f32_16x16x128_f8f6f4 %0, %1, %2, %0, %3, %3 op_sel_hi:[0,0,0]" : "+v"(acc[ai][bj][m][n]) : "v"(Bt##8[n]), "v"(At##8[m]), "v"(one_scale)); } \
              \
        else { _Pragma("unroll") for (int m = 0; m < 4; ++m) _Pragma("unroll") for (int n = 0; n < 2; ++n) _Pragma("unroll") for (int k = 0; k < 2; ++k) \
            acc[ai][bj][m][n] = __builtin_amdgcn_mfma_f32_16x16x32_bf16(Bt[n][k], At[m][k], acc[ai][bj][m][n], 0, 0, 0); } \
        __builtin_amdgcn_s_setprio(0); } while (0)
#define PG8_WAIT_V(n) asm volatile("s_waitcnt vmcnt(" #n ")" ::: "memory")
#define PG8_WAIT_L(n) asm volatile("s_waitcnt lgkmcnt(" #n ")" ::: "memory")
#define PG8_BAR __builtin_amdgcn_s_barrier()
#define PG8_SCHED __builtin_amdgcn_sched_barrier(0)
    Unit cur, nxt; int ui = 0;
    if (!S.next(0, cur)) return;
    f32x4 acc[2][2][4][2];
#pragma unroll
    for (int a = 0; a < 2; ++a)
#pragma unroll
        for (int b = 0; b < 2; ++b)
#pragma unroll
            for (int m = 0; m < 4; ++m)
#pragma unroll
                for (int n = 0; n < 2; ++n) acc[a][b][m][n] = (f32x4){0.f, 0.f, 0.f, 0.f};
    int one_scale = 0x7f7f7f7f; asm volatile("" : "+v"(one_scale));
    bf16x8 At[4][2], B0[2][2], B1[2][2]; i32x8_t At8[4], B08[2], B18[2];
    const char* cA = (const char*)g.A + (size_t)cur.pm * tstep; const char* cB = (const char*)g.Bt + (size_t)cur.pn * tstep;
    S.a_ready(cur);
    if constexpr (SP2) {
        PG8_STAGE(PG8_SB(0, 0), cB, voffB); PG8_STAGE(PG8_SB(0, 1), cB + hstep, voffB); PG8_STAGE(PG8_SA(0, 0), cA, voffA); PG8_STAGE(PG8_SA(0, 1), cA + hstep, voffA);
        if (wr == 1) PG8_BAR;
        PG8_WAIT_V(2); PG8_BAR;
        PG8_STAGE(PG8_SB(1, 0), cB + kstep, voffB); PG8_STAGE(PG8_SA(1, 0), cA + kstep, voffA); PG8_STAGE(PG8_SB(1, 1), cB + hstep + kstep, voffB);
        PG8_WAIT_V(6); PG8_BAR;
    } else {
        PG8_STAGE(PG8_SB(0, 0), cB, voffB); PG8_STAGE(PG8_SA(0, 0), cA, voffA); PG8_STAGE(PG8_SB(0, 1), cB + hstep, voffB); PG8_STAGE(PG8_SA(0, 1), cA + hstep, voffA);
        if (wr == 1) PG8_BAR;
        PG8_WAIT_V(4); PG8_BAR;
        PG8_STAGE(PG8_SB(1, 0), cB + kstep, voffB); PG8_STAGE(PG8_SA(1, 0), cA + kstep, voffA); PG8_STAGE(PG8_SB(1, 1), cB + hstep + kstep, voffB);
        PG8_WAIT_V(6); PG8_BAR;
    }
    for (;;) {
        const bool has_next = S.next(ui + 1, nxt);
        const char* nA = has_next ? (const char*)g.A + (size_t)nxt.pm * tstep : cA; const char* nB = has_next ? (const char*)g.Bt + (size_t)nxt.pn * tstep : cB;
        for (int t = 0; t < nt; t += 2) {
            const bool last = (t == nt - 2);
            const char* a1 = cA + (size_t)(t + 1) * kstep;
            const char* a2 = last ? nA : cA + (size_t)(t + 2) * kstep; const char* b2 = last ? nB : cB + (size_t)(t + 2) * kstep;
            const char* a3 = a2 + kstep; const char* b3 = b2 + kstep;
            if (last && has_next) S.a_ready(nxt);
            if constexpr (SP2) {
            PG8_LDB(B0, 0, 0); PG8_LDB(B1, 0, 1); PG8_SCHED; PG8_LDA(At, 0, 0); PG8_STAGE(PG8_SA(1, 1), a1 + hstep, voffA);
            PG8_WAIT_V(8); PG8_WAIT_L(0); PG8_BAR; PG8_MMA(0, 0, At, B0); PG8_MMA(0, 1, At, B1); PG8_BAR; PG8_SCHED;
            PG8_LDA(At, 0, 1); PG8_STAGE(PG8_SB(0, 0), b2, voffB); PG8_STAGE(PG8_SB(0, 1), b2 + hstep, voffB); PG8_STAGE(PG8_SA(0, 0), a2, voffA);
            PG8_WAIT_V(8); PG8_WAIT_L(0); PG8_BAR; PG8_MMA(1, 0, At, B0); PG8_MMA(1, 1, At, B1); PG8_BAR; PG8_SCHED;
            PG8_LDB(B0, 1, 0); PG8_LDB(B1, 1, 1); PG8_SCHED; PG8_LDA(At, 1, 0); PG8_STAGE(PG8_SA(0, 1), a2 + hstep, voffA);
            PG8_WAIT_V(8); PG8_WAIT_L(0); PG8_BAR; PG8_MMA(0, 0, At, B0); PG8_MMA(0, 1, At, B1); PG8_BAR; PG8_SCHED;
            PG8_LDA(At, 1, 1); PG8_STAGE(PG8_SB(1, 0), b3, voffB); PG8_STAGE(PG8_SB(1, 1), b3 + hstep, voffB); PG8_STAGE(PG8_SA(1, 0), a3, voffA);
            PG8_WAIT_V(8); PG8_WAIT_L(0); PG8_BAR; PG8_MMA(1, 0, At, B0); PG8_MMA(1, 1, At, B1); PG8_BAR; PG8_SCHED;
            } else {
            PG8_LDB(B0, 0, 0); PG8_SCHED; PG8_LDA(At, 0, 0); PG8_STAGE(PG8_SA(1, 1), a1 + hstep, voffA);
            PG8_WAIT_L(8); PG8_BAR; PG8_WAIT_L(0); PG8_MMA(0, 0, At, B0); PG8_BAR; PG8_SCHED;
            PG8_LDB(B1, 0, 1); PG8_STAGE(PG8_SB(0, 0), b2, voffB);
            PG8_BAR; PG8_WAIT_L(0); PG8_MMA(0, 1, At, B1); PG8_BAR;
            PG8_LDA(At, 0, 1); PG8_STAGE(PG8_SA(0, 0), a2, voffA);
            PG8_BAR; PG8_WAIT_L(0); PG8_MMA(1, 0, At, B0); PG8_BAR; PG8_SCHED;
            PG8_STAGE(PG8_SB(0, 1), b2 + hstep, voffB);
            PG8_WAIT_V(6); PG8_BAR; PG8_MMA(1, 1, At, B1); PG8_BAR;
            PG8_LDB(B0, 1, 0); PG8_SCHED; PG8_LDA(At, 1, 0); PG8_STAGE(PG8_SA(0, 1), a2 + hstep, voffA);
            PG8_WAIT_L(8); PG8_BAR; PG8_WAIT_L(0); PG8_MMA(0, 0, At, B0); PG8_BAR; PG8_SCHED;
            PG8_LDB(B1, 1, 1); PG8_STAGE(PG8_SB(1, 0), b3, voffB);
            PG8_BAR; PG8_WAIT_L(0); PG8_MMA(0, 1, At, B1); PG8_BAR;
            PG8_LDA(At, 1, 1); PG8_STAGE(PG8_SA(1, 0), a3, voffA);
            PG8_BAR; PG8_WAIT_L(0); PG8_MMA(1, 0, At, B0); PG8_BAR; PG8_SCHED;
            PG8_STAGE(PG8_SB(1, 1), b3 + hstep, voffB);
            PG8_WAIT_V(6); PG8_BAR; PG8_MMA(1, 1, At, B1); PG8_BAR;
            }
        }
        if constexpr (ALIGN_EPI) { if (wr == 0) PG8_BAR; }
        if constexpr (FP8) asm volatile("s_nop 15\n\ts_nop 15\n\ts_nop 7" ::: "memory");
        if constexpr (!Epi::AFTER_DRAIN) { E(acc, cur, wr, wc, fr, fq); S.done(cur); }
        if (!has_next) break;
#pragma unroll
        for (int a = 0; a < 2; ++a)
#pragma unroll
            for (int b = 0; b < 2; ++b)
#pragma unroll
                for (int m = 0; m < 4; ++m)
#pragma unroll
                    for (int n = 0; n < 2; ++n) { acc[a][b][m][n] = (f32x4){0.f, 0.f, 0.f, 0.f}; if constexpr (FP8) asm volatile("" : "+v"(acc[a][b][m][n])); }
        cur = nxt; cA = nA; cB = nB; ++ui;
        if constexpr (ALIGN_EPI) { if (wr == 1) PG8_BAR; }
    }
    PG8_WAIT_V(0);
    if constexpr (!ALIGN_EPI) { if (wr == 0) PG8_BAR; }
    PG8_BAR;
    if constexpr (Epi::AFTER_DRAIN) { E.fused(acc, cur, wr, wc, fr, fq, lds, wid, lane); S.done(cur); }
#undef PG8_SA
#undef PG8_SB
#undef PG8_STAGE
#undef PG8_LDA
#undef PG8_LDB
#undef PG8_MMA
#undef PG8_LD8
#undef PG8_WAIT_V
#undef PG8_WAIT_L
#undef PG8_BAR
#undef PG8_SCHED
}
}
#ifndef PEER_FP8
#define PEER_FP8 3
#endif
#define PEER_FP8_P0 (PEER_FP8 != 0)
namespace mk {
typedef unsigned short bf16;
typedef unsigned v4u __attribute__((ext_vector_type(4)));
typedef float f32x4 __attribute__((ext_vector_type(4)));
typedef float f32x2 __attribute__((ext_vector_type(2)));
#define LAS __attribute__((address_space(3)))
constexpr int T = 8192, DM = 2048, SEQ = 4096, NPROJ = 11776, NEXP = 16384, NWAVES = 8;
constexpr int C_QA = 0, C_KA = 1024, C_VA = 1280, C_QR = 1536, C_KR = 2560, C_VR = 3584, C_GR = 5632, C_GA = 7680, C_GT = 9728;
constexpr float EPS = 1e-6f, LOG2E = 1.4426950408889634f;
constexpr size_t MiB = 1u << 20;
constexpr size_t WS_CTL = 0, CTL_BYTES = 1 * MiB;
constexpr size_t WS_SSQ = 512 * 1024, WS_R1 = 768 * 1024;
constexpr size_t WS_ROPE = 1 * MiB;
constexpr size_t WS_SK = 3 * MiB;
constexpr size_t WS_WIN = 4 * MiB;
constexpr size_t WS_WA = 50 * MiB, WS_WR = 54 * MiB, WS_WO = 62 * MiB, WS_WQ = 70 * MiB;
constexpr size_t WS_ED = 78 * MiB, WS_EU = 142 * MiB;
constexpr size_t WS_XB = 206 * MiB;
constexpr size_t WS_PROJ = 238 * MiB;
constexpr size_t WS_AO = 422 * MiB, WS_RO = 438 * MiB;
constexpr size_t WS_IDX = 470 * MiB, WS_GATE = 474 * MiB, WS_END = 478 * MiB;
constexpr int LDS_BYTES = 156672;
__constant__ float INV_FREQ[64] = {
1.000000000e+00f, 8.659643531e-01f, 7.498942018e-01f, 6.493816376e-01f, 5.623413324e-01f, 4.869675338e-01f, 4.216965139e-01f, 3.651741147e-01f, 3.162277639e-01f, 2.738419771e-01f, 2.371373922e-01f, 2.053525001e-01f, 1.778279394e-01f, 1.539926529e-01f, 1.333521456e-01f, 1.154782027e-01f, 1.000000015e-01f, 8.659642935e-02f, 7.498941571e-02f, 6.493816525e-02f, 5.623412877e-02f, 4.869675264e-02f, 4.216964915e-02f, 3.651741147e-02f, 3.162277862e-02f, 2.738419734e-02f, 2.371373586e-02f, 2.053524926e-02f, 1.778279431e-02f, 1.539926510e-02f, 1.333521493e-02f, 1.154781971e-02f, 9.999999776e-03f, 8.659643121e-03f, 7.498942316e-03f, 6.493816618e-03f, 5.623413250e-03f, 4.869675264e-03f, 4.216964822e-03f, 3.651741426e-03f, 3.162277862e-03f, 2.738419687e-03f, 2.371373819e-03f, 2.053525066e-03f, 1.778279431e-03f, 1.539926627e-03f, 1.333521446e-03f, 1.154781901e-03f, 1.000000047e-03f, 8.659643354e-04f, 7.498941850e-04f, 6.493816618e-04f, 5.623413017e-04f, 4.869675031e-04f, 4.216965463e-04f, 3.651741135e-04f, 3.162277862e-04f, 2.738419571e-04f, 2.371373848e-04f, 2.053525241e-04f, 1.778279402e-04f, 1.539926452e-04f, 1.333521504e-04f, 1.154782076e-04f};
__constant__ float LOG2G[8] = {-4.58036896131247886e-02f, -2.27200765000835289e-02f, -1.13153132278341461e-02f, -5.64656314114206272e-03f, -2.82051906237866263e-03f, -1.40957025467135363e-03f, -7.04612976589372706e-04f, -3.52263471629021385e-04f};

__device__ __forceinline__ unsigned f2bf(float f) { unsigned u = __builtin_bit_cast(unsigned, f); return (u + 0x7fffu + ((u >> 16) & 1u)) >> 16; }
__device__ __forceinline__ unsigned pk2(float lo, float hi) { return f2bf(lo) | (f2bf(hi) << 16); }
__device__ __forceinline__ float bflo(unsigned u) { return __uint_as_float(u << 16); }
__device__ __forceinline__ float bfhi(unsigned u) { return __uint_as_float(u & 0xffff0000u); }
__device__ __forceinline__ float bf2f(bf16 b) { return __uint_as_float((unsigned)b << 16); }
typedef __bf16 bf16x2_t __attribute__((ext_vector_type(2)));
__device__ __forceinline__ float dot2(unsigned a, unsigned b, float c) { return __builtin_amdgcn_fdot2_f32_bf16(__builtin_bit_cast(bf16x2_t, a), __builtin_bit_cast(bf16x2_t, b), c, false); }
__device__ __forceinline__ float dot8(v4u a, v4u b, float c) { c = dot2(a.x, b.x, c); c = dot2(a.y, b.y, c); c = dot2(a.z, b.z, c); c = dot2(a.w, b.w, c); return c; }
__device__ __forceinline__ float wave_sum(float v) {
#pragma unroll
    for (int o = 1; o < 64; o <<= 1) v += __shfl_xor(v, o);
    return v;
}
__device__ __forceinline__ float wave_max(float v) {
#pragma unroll
    for (int o = 1; o < 64; o <<= 1) v = fmaxf(v, __shfl_xor(v, o));
    return v;
}
__device__ __forceinline__ int wave_min_i(int v) {
#pragma unroll
    for (int o = 1; o < 64; o <<= 1) { const int w = __shfl_xor(v, o); v = w < v ? w : v; }
    return v;
}
__device__ __forceinline__ float rdlane(float v, int l) { return __uint_as_float((unsigned)__builtin_amdgcn_readlane((int)__float_as_uint(v), l)); }
__device__ __forceinline__ int rdlane_i(int v, int l) { return __builtin_amdgcn_readlane(v, l); }
#define LDS_WAIT() asm volatile("s_waitcnt lgkmcnt(0)" ::: "memory")

__device__ __forceinline__ int opq(int v) { asm volatile("" : "+v"(v)); return v; }
struct Frame {
    LAS unsigned char* lds; int tid, lane, wave, G, bid, gw, NGW;
    const float *x, *attn_norm, *w_in, *sinks, *w_attn, *w_ret, *w_out, *ffn_norm, *w_q, *sub_keys, *e_down, *e_up, *final_norm;
    float* out; unsigned char* ws;
};
__device__ __forceinline__ int proj_dst_col(int n) {
    const bool rope = (n < 1280) || (n >= 1536 && n < 3584);
    if (!rope) return n;
    const int hb = n & ~127, d = n & 127;
    return hb + ((d & 63) << 1) + (d >> 6);
}
__device__ __forceinline__ void p0_transpose_item(const float* W, int K, int N, const float* g, bf16* WT, bool perm, LAS float* scr, int item, int lane) {
    const int nblk = N / 64, kb = item / nblk, nb = item % nblk, k0 = 64 * kb, n0 = 64 * nb;
    const int lr = lane >> 4, lc = (lane & 15) * 4;
#pragma unroll 4
    for (int i = 0; i < 16; ++i) { const int kk = 4 * i + lr; f32x4 w = __builtin_nontemporal_load((const f32x4*)(W + (size_t)(k0 + kk) * N + n0 + lc)); if (g) w = w * g[k0 + kk];
        LAS float* d = scr + kk * 65 + lc; d[0] = w[0]; d[1] = w[1]; d[2] = w[2]; d[3] = w[3]; }
    LDS_WAIT(); asm volatile("" ::: "memory");
    const int c = lane & 7;
#pragma unroll
    for (int j = 0; j < 8; ++j) { const int n = (lane >> 3) + 8 * j; const LAS float* s = scr + (8 * c) * 65 + n;
        v4u o; o.x = pk2(s[0 * 65], s[1 * 65]); o.y = pk2(s[2 * 65], s[3 * 65]); o.z = pk2(s[4 * 65], s[5 * 65]); o.w = pk2(s[6 * 65], s[7 * 65]);
        int nd = n0 + n; if (perm) nd = proj_dst_col(nd);
        *(v4u*)(WT + (size_t)nd * K + k0 + 8 * c) = o; }
    LDS_WAIT(); asm volatile("" ::: "memory");
}
#ifndef GEMM1_FP8
#define GEMM1_FP8 1
#endif
#ifndef P3_FP8
#define P3_FP8 1
#endif
#ifndef P4_FP8
#define P4_FP8 1
#endif
constexpr float P3_AS = 16.0f;
constexpr float G1_XS = 16.0f, G1_WS = 1024.0f;
__device__ __forceinline__ unsigned pk4_fp8(float a, float b, float c, float d) {
    a = fminf(fmaxf(a, -448.f), 448.f); b = fminf(fmaxf(b, -448.f), 448.f); c = fminf(fmaxf(c, -448.f), 448.f); d = fminf(fmaxf(d, -448.f), 448.f);
    int pw = 0; pw = __builtin_amdgcn_cvt_pk_fp8_f32(a, b, pw, false); pw = __builtin_amdgcn_cvt_pk_fp8_f32(c, d, pw, true); return (unsigned)pw;
}
__device__ __forceinline__ void p0_transpose_item_fp8(const float* W, int K, int N, const float* g, float scale, unsigned char* WT, bool perm, LAS float* scr, int item, int lane) {
    const int nblk = N / 64, kb = item / nblk, nb = item % nblk, k0 = 64 * kb, n0 = 64 * nb;
    const int lr = lane >> 4, lc = (lane & 15) * 4;
#pragma unroll 4
    for (int i = 0; i < 16; ++i) { const int kk = 4 * i + lr; f32x4 w = __builtin_nontemporal_load((const f32x4*)(W + (size_t)(k0 + kk) * N + n0 + lc)); w = w * ((g ? g[k0 + kk] : 1.0f) * scale);
        LAS float* d = scr + kk * 65 + lc; d[0] = w[0]; d[1] = w[1]; d[2] = w[2]; d[3] = w[3]; }
    LDS_WAIT(); asm volatile("" ::: "memory");
    const int c = lane & 7;
#pragma unroll
    for (int j = 0; j < 8; ++j) { const int n = (lane >> 3) + 8 * j; const LAS float* s = scr + (8 * c) * 65 + n;
        f32x2 o; o.x = __uint_as_float(pk4_fp8(s[0 * 65], s[1 * 65], s[2 * 65], s[3 * 65])); o.y = __uint_as_float(pk4_fp8(s[4 * 65], s[5 * 65], s[6 * 65], s[7 * 65]));
        int nd = n0 + n; if (perm) nd = proj_dst_col(nd);
        *(f32x2*)(WT + (size_t)nd * K + k0 + 8 * c) = o; }
    LDS_WAIT(); asm volatile("" ::: "memory");
}
__device__ __forceinline__ void sincos_acc(float xf, float& sn, float& cs) {
    const double x = (double)xf;
    const double q = __builtin_rint(x * 0.63661977236758134308);
    const double r = __builtin_fma(-q, 1.57079632679489661923, x) - q * 6.123233995736766e-17;
    const double r2 = r * r;
    double s = -1.0 / 6227020800.0; s = s * r2 + 1.0 / 39916800.0; s = -s; s = s * r2 + 1.0 / 362880.0; s = -s;
    double ps = 1.0 / 6227020800.0;
    ps = ps * r2 - 1.0 / 39916800.0; ps = ps * r2 + 1.0 / 362880.0; ps = ps * r2 - 1.0 / 5040.0; ps = ps * r2 + 1.0 / 120.0; ps = ps * r2 - 1.0 / 6.0; ps = ps * r2 + 1.0;
    const double sv = ps * r;
    double pc = -1.0 / 87178291200.0;
    pc = pc * r2 + 1.0 / 479001600.0; pc = pc * r2 - 1.0 / 3628800.0; pc = pc * r2 + 1.0 / 40320.0; pc = pc * r2 - 1.0 / 720.0; pc = pc * r2 + 1.0 / 24.0; pc = pc * r2 - 0.5; pc = pc * r2 + 1.0;
    (void)s;
    const int qi = ((int)q) & 3;
    const double so = (qi == 0) ? sv : (qi == 1) ? pc : (qi == 2) ? -sv : -pc;
    const double co = (qi == 0) ? pc : (qi == 1) ? -sv : (qi == 2) ? -pc : sv;
    sn = (float)so; cs = (float)co;
}
__device__ __forceinline__ v4u pack8(f32x4 a, f32x4 b) { v4u o; o.x = pk2(a[0], a[1]); o.y = pk2(a[2], a[3]); o.z = pk2(b[0], b[1]); o.w = pk2(b[2], b[3]); return o; }

__device__ __forceinline__ void p0_prologue(Frame& F) {
    LAS float* scr = (LAS float*)(F.lds + F.wave * 16640);
    unsigned char* ws = F.ws;
    const int lane = opq(F.lane);
    constexpr int I_IN = (DM / 64) * (NPROJ / 64), I_A = (1024 / 64) * (DM / 64), I_S = (DM / 64) * (DM / 64);
    constexpr int NITEMS = I_IN + I_A + 3 * I_S;
    for (int it = F.gw; it < NITEMS; it += F.NGW) {
        int r = it;
        if (r < I_IN) { if (GEMM1_FP8) p0_transpose_item_fp8(F.w_in, DM, NPROJ, F.attn_norm, G1_WS, ws + WS_WIN, true, scr, r, lane);
                        else p0_transpose_item(F.w_in, DM, NPROJ, F.attn_norm, (bf16*)(ws + WS_WIN), true, scr, r, lane); continue; } r -= I_IN;
        if (r < I_A) { if (P3_FP8) p0_transpose_item_fp8(F.w_attn, 1024, DM, nullptr, G1_WS, ws + WS_WA, false, scr, r, lane); else p0_transpose_item(F.w_attn, 1024, DM, nullptr, (bf16*)(ws + WS_WA), false, scr, r, lane); continue; } r -= I_A;
        if (r < I_S) { if (P3_FP8) p0_transpose_item_fp8(F.w_ret, DM, DM, nullptr, G1_WS, ws + WS_WR, false, scr, r, lane); else p0_transpose_item(F.w_ret, DM, DM, nullptr, (bf16*)(ws + WS_WR), false, scr, r, lane); continue; } r -= I_S;
        if (r < I_S) { if (P4_FP8) p0_transpose_item_fp8(F.w_out, DM, DM, nullptr, G1_WS, ws + WS_WO, false, scr, r, lane); else p0_transpose_item(F.w_out, DM, DM, nullptr, (bf16*)(ws + WS_WO), false, scr, r, lane); continue; } r -= I_S;
        p0_transpose_item(F.w_q, DM, DM, F.ffn_norm, (bf16*)(ws + WS_WQ), false, scr, r, lane);
    }
    for (int row = F.gw; row < (PEER_FP8_P0 ? 0 : 2 * NEXP); row += F.NGW) {
        const float* src = (row < NEXP) ? F.e_down + (size_t)row * DM : F.e_up + (size_t)(row - NEXP) * DM;
        bf16* dst = (row < NEXP) ? (bf16*)(ws + WS_ED) + (size_t)row * DM : (bf16*)(ws + WS_EU) + (size_t)(row - NEXP) * DM;
        const f32x4* s4 = (const f32x4*)src;
#pragma unroll
        for (int j = 0; j < 4; ++j) { const f32x4 a = s4[128 * j + 2 * lane], b = s4[128 * j + 2 * lane + 1]; *(v4u*)(dst + 512 * j + 8 * lane) = pack8(a, b); }
    }
    for (int m = F.gw; m < T; m += F.NGW) {
        const f32x4* s4 = (const f32x4*)(F.x + (size_t)m * DM); float ss = 0.f; f32x4 xa[4], xb[4];
#pragma unroll
        for (int j = 0; j < 4; ++j) { const f32x4 a = __builtin_nontemporal_load(s4 + 128 * j + 2 * lane), b = __builtin_nontemporal_load(s4 + 128 * j + 2 * lane + 1); xa[j] = a; xb[j] = b;
            ss += (a[0] * a[0] + a[1] * a[1]) + (a[2] * a[2] + a[3] * a[3]) + (b[0] * b[0] + b[1] * b[1]) + (b[2] * b[2] + b[3] * b[3]); }
        ss = wave_sum(ss);
        const float r1v = 1.0f / sqrtf(ss * (1.0f / DM) + EPS);
        if (lane == 0) ((float*)(ws + WS_R1))[m] = r1v;
        if (GEMM1_FP8) { unsigned char* dst = ws + WS_XB + (size_t)m * DM; const float sc = r1v * G1_XS;
#pragma unroll
            for (int j = 0; j < 4; ++j) { const f32x4 a = xa[j] * sc, b = xb[j] * sc; f32x2 o; o.x = __uint_as_float(pk4_fp8(a[0], a[1], a[2], a[3])); o.y = __uint_as_float(pk4_fp8(b[0], b[1], b[2], b[3]));
                *(f32x2*)(dst + 512 * j + 8 * lane) = o; }
        } else { bf16* dst = (bf16*)(ws + WS_XB) + (size_t)m * DM;
#pragma unroll
            for (int j = 0; j < 4; ++j) *(v4u*)(dst + 512 * j + 8 * lane) = pack8(xa[j], xb[j]); }
    }
    for (int c = F.gw; c < 2 * 8 * 128 * 128 / 512; c += F.NGW) {
        const f32x4* s4 = (const f32x4*)(F.sub_keys + (size_t)c * 512); const f32x4 a = s4[2 * lane], b = s4[2 * lane + 1];
        *(v4u*)((bf16*)(ws + WS_SK) + (size_t)c * 512 + 8 * lane) = pack8(a, b);
    }
    for (int c = F.gw; c < SEQ * 64 / 64; c += F.NGW) {
        const int e = c * 64 + lane, pos = e >> 6, i = e & 63; const float ang = (float)pos * INV_FREQ[i];
        float sn, cs; sincos_acc(ang, sn, cs);
        ((f32x2*)(ws + WS_ROPE))[e] = (f32x2){cs, sn};
    }
}

__device__ __forceinline__ void p2_attn_naive(Frame& F) {
    const bf16* PROJ = (const bf16*)(F.ws + WS_PROJ); bf16* AO = (bf16*)(F.ws + WS_AO); const int lane = F.lane;
    for (int it = F.gw; it < T * 8; it += F.NGW) {
        const int t = it >> 3, h = it & 7, pos = t & 4095, kvh = h >> 2;
        const v4u* qr = (const v4u*)(PROJ + (size_t)t * NPROJ + C_QA + h * 128);
        v4u q[16];
#pragma unroll
        for (int i = 0; i < 16; ++i) q[i] = qr[i];
        float s[2];
#pragma unroll
        for (int half = 0; half < 2; ++half) {
            const int sp = pos - 127 + lane + 64 * half; float acc = -1e30f;
            if (sp >= 0) { const v4u* kr = (const v4u*)(PROJ + (size_t)(t - pos + sp) * NPROJ + C_KA + kvh * 128); acc = 0.f;
#pragma unroll
                for (int i = 0; i < 16; ++i) acc = dot8(q[i], kr[i], acc); }
            s[half] = acc;
        }
        const float sink = F.sinks[h] * LOG2E;
        const float m = wave_max(fmaxf(fmaxf(s[0], s[1]), sink));
        const float p0 = exp2f(s[0] - m), p1 = exp2f(s[1] - m);
        const float l = wave_sum(p0 + p1) + exp2f(sink - m);
        float o0 = 0.f, o1 = 0.f;
        for (int j = 0; j < 128; ++j) {
            const int sp = pos - 127 + j; if (sp < 0) continue;
            const float pj = rdlane(j < 64 ? p0 : p1, j & 63);
            const unsigned vv = *(const unsigned*)(PROJ + (size_t)(t - pos + sp) * NPROJ + C_VA + kvh * 128 + 2 * lane);
            o0 += pj * bflo(vv); o1 += pj * bfhi(vv);
        }
        const float inv = 1.0f / l;
        *(unsigned*)(AO + (size_t)t * 1024 + h * 128 + 2 * lane) = pk2(o0 * inv, o1 * inv);
    }
}
__device__ __forceinline__ void p2_kv_naive(Frame& F, float* KV) {
    const bf16* PROJ = (const bf16*)(F.ws + WS_PROJ);
    for (int u = F.bid; u < 512; u += F.G) {
        const int b = u >> 8, h = (u >> 5) & 7, n = u & 31; const size_t t0 = (size_t)b * SEQ + n * 128; const float l2g = LOG2G[h];
        for (int de = F.tid; de < 32768; de += 512) {
            const int d = de >> 8, e = de & 255; float acc = 0.f;
            for (int k = 0; k < 128; ++k) {
                const float kk = bf2f(PROJ[(t0 + k) * NPROJ + C_KR + h * 128 + d]) * exp2f((float)(127 - k) * l2g);
                acc += kk * bf2f(PROJ[(t0 + k) * NPROJ + C_VR + h * 256 + e]);
            }
            KV[((size_t)u * 128 + d) * 256 + e] = acc;
        }
    }
}
__device__ __forceinline__ void p2_scan(Frame& F, float* KV) {
    bf16* S = (bf16*)KV;
    for (int c = F.bid * 512 + F.tid; c < 16 * 32768 / 4; c += F.G * 512) {
        const int bh = c >> 13, de = (c & 8191) * 4; const float cd = exp2f(128.0f * LOG2G[bh & 7]); float s0 = 0.f, s1 = 0.f, s2 = 0.f, s3 = 0.f;
        for (int n = 0; n < 32; ++n) { unsigned long long* p = (unsigned long long*)(S + ((size_t)(bh * 32 + n) * 32768 + de)); const unsigned long long v = *p; const unsigned lo = (unsigned)v, hi = (unsigned)(v >> 32);
            *p = (unsigned long long)pk2(s0, s1) | ((unsigned long long)pk2(s2, s3) << 32);
            s0 = s0 * cd + bflo(lo); s1 = s1 * cd + bfhi(lo); s2 = s2 * cd + bflo(hi); s3 = s3 * cd + bfhi(hi); }
    }
}
__device__ __forceinline__ void p2_retout_naive(Frame& F, const float* KV) {
    const bf16* PROJ = (const bf16*)(F.ws + WS_PROJ); bf16* RO = (bf16*)(F.ws + WS_RO); const int lane = F.lane;
    for (int it = F.gw; it < T * 8; it += F.NGW) {
        const int t = it >> 3, h = it & 7, c = t & 127, t0 = t - c, b = t >> 12, n = (t & 4095) >> 7, u = (b * 8 + h) * 32 + n; const float l2g = LOG2G[h];
        const v4u* qr = (const v4u*)(PROJ + (size_t)t * NPROJ + C_QR + h * 128);
        v4u q[16];
#pragma unroll
        for (int i = 0; i < 16; ++i) q[i] = qr[i];
        float s[2];
#pragma unroll
        for (int half = 0; half < 2; ++half) {
            const int k = lane + 64 * half; float acc = 0.f;
            if (k <= c) { const v4u* kr = (const v4u*)(PROJ + (size_t)(t0 + k) * NPROJ + C_KR + h * 128);
#pragma unroll
                for (int i = 0; i < 16; ++i) acc = dot8(q[i], kr[i], acc);
                acc *= exp2f((float)(c - k) * l2g); }
            s[half] = acc;
        }
        float o[4] = {0.f, 0.f, 0.f, 0.f};
        for (int k = 0; k <= c; ++k) {
            const float sk = rdlane(k < 64 ? s[0] : s[1], k & 63); const bf16* vr = PROJ + (size_t)(t0 + k) * NPROJ + C_VR + h * 256 + lane;
#pragma unroll
            for (int j = 0; j < 4; ++j) o[j] += sk * bf2f(vr[64 * j]);
        }
        float oc[4] = {0.f, 0.f, 0.f, 0.f};
        const float* st = KV + (size_t)u * 32768 + lane;
#pragma unroll
        for (int i = 0; i < 16; ++i) {
            const unsigned w[4] = {q[i].x, q[i].y, q[i].z, q[i].w};
#pragma unroll
            for (int jj = 0; jj < 4; ++jj) {
                const float qlo = bflo(w[jj]), qhi = bfhi(w[jj]); const int d = 8 * i + 2 * jj;
#pragma unroll
                for (int j = 0; j < 4; ++j) { oc[j] += qlo * st[(size_t)d * 256 + 64 * j]; oc[j] += qhi * st[(size_t)(d + 1) * 256 + 64 * j]; }
            }
        }
        const float qd = exp2f((float)(c + 1) * l2g);
#pragma unroll
        for (int j = 0; j < 4; ++j) o[j] += qd * oc[j];
        const float mu = wave_sum((o[0] + o[1]) + (o[2] + o[3])) * (1.0f / 256.0f);
        float vs = 0.f;
#pragma unroll
        for (int j = 0; j < 4; ++j) { o[j] -= mu; vs += o[j] * o[j]; }
        const float rs = 1.0f / sqrtf(wave_sum(vs) * (1.0f / 256.0f) + EPS);
        const bf16* gr = PROJ + (size_t)t * NPROJ + C_GR + h * 256 + lane; bf16* orow = RO + (size_t)t * DM + h * 256 + lane;
#pragma unroll
        for (int j = 0; j < 4; ++j) orow[64 * j] = (bf16)f2bf(o[j] * rs * bf2f(gr[64 * j]));
    }
}
typedef short bf16x8 __attribute__((ext_vector_type(8)));
typedef short s16x4 __attribute__((ext_vector_type(4)));
#define MFMA16(a, b, c) __builtin_amdgcn_mfma_f32_16x16x32_bf16((a), (b), (c), 0, 0, 0)
__device__ __forceinline__ s16x4 tr16(const LAS unsigned char* p) { return __builtin_amdgcn_ds_read_tr16_b64_v4i16((LAS s16x4*)p); }
__device__ __forceinline__ bf16x8 cat8(s16x4 a, s16x4 b) { return (bf16x8){a[0], a[1], a[2], a[3], b[0], b[1], b[2], b[3]}; }
__device__ __forceinline__ v4u scale8(v4u v, float s) { v4u o; o.x = pk2(bflo(v.x) * s, bfhi(v.x) * s); o.y = pk2(bflo(v.y) * s, bfhi(v.y) * s); o.z = pk2(bflo(v.z) * s, bfhi(v.z) * s); o.w = pk2(bflo(v.w) * s, bfhi(v.w) * s); return o; }

__device__ __forceinline__ void p2_kv_mfma(Frame& F, float* KV) {
    const bf16* PROJ = (const bf16*)(F.ws + WS_PROJ);
    const int tid = opq(F.tid), lane = tid & 63, w = F.wave, g = lane >> 4, fr = lane & 15, q = fr >> 2, p = fr & 3;
    constexpr int PV = 528, PK = 272, VS = 0, KS = 128 * 528;
    LAS unsigned char* lds = F.lds;
    for (int u = F.bid; u < 512; u += F.G) {
        const int b = u >> 8, h = (u >> 5) & 7, n = u & 31; const size_t t0 = (size_t)b * SEQ + n * 128; const float l2g = LOG2G[h];
#pragma unroll
        for (int i = 0; i < 8; ++i) { const int c = tid + 512 * i, row = c >> 5, ch = c & 31;
            const v4u v = *(const v4u*)(PROJ + (t0 + row) * NPROJ + C_VR + h * 256 + ch * 8); *(LAS v4u*)(lds + VS + row * PV + ch * 16) = v; }
#pragma unroll
        for (int i = 0; i < 4; ++i) { const int c = tid + 512 * i, row = c >> 4, ch = c & 15;
            const v4u v = *(const v4u*)(PROJ + (t0 + row) * NPROJ + C_KR + h * 128 + ch * 8);
            *(LAS v4u*)(lds + KS + row * PK + ch * 16) = scale8(v, exp2f((float)(127 - row) * l2g)); }
        __syncthreads();
        f32x4 acc[8][2];
#pragma unroll
        for (int dt = 0; dt < 8; ++dt) { acc[dt][0] = (f32x4){0.f, 0.f, 0.f, 0.f}; acc[dt][1] = (f32x4){0.f, 0.f, 0.f, 0.f}; }
#pragma unroll
        for (int ks = 0; ks < 4; ++ks) {
            bf16x8 Bf[2];
#pragma unroll
            for (int ei = 0; ei < 2; ++ei) { const LAS unsigned char* ap = lds + VS + (32 * ks + 8 * g + q) * PV + (16 * (2 * w + ei) + 4 * p) * 2; Bf[ei] = cat8(tr16(ap), tr16(ap + 4 * PV)); }
#pragma unroll
            for (int dt = 0; dt < 8; ++dt) { const LAS unsigned char* ap = lds + KS + (32 * ks + 8 * g + q) * PK + (16 * dt + 4 * p) * 2; const bf16x8 Af = cat8(tr16(ap), tr16(ap + 4 * PK));
                acc[dt][0] = MFMA16(Af, Bf[0], acc[dt][0]); acc[dt][1] = MFMA16(Af, Bf[1], acc[dt][1]); }
        }
#pragma unroll
        for (int dt = 0; dt < 8; ++dt)
#pragma unroll
            for (int ei = 0; ei < 2; ++ei) { const int e = 16 * (2 * w + ei) + fr; const f32x4 a = acc[dt][ei];
                *(unsigned long long*)((bf16*)KV + ((size_t)u * 256 + e) * 128 + 16 * dt + 4 * g) = (unsigned long long)pk2(a[0], a[1]) | ((unsigned long long)pk2(a[2], a[3]) << 32); }
        __syncthreads();
    }
}
__device__ __forceinline__ void p2_retout_mfma(Frame& F, const float* KV) {
    const bf16* PROJ = (const bf16*)(F.ws + WS_PROJ); bf16* RO = (bf16*)(F.ws + WS_RO);
    const int tid = opq(F.tid), lane = tid & 63, w = F.wave, g = lane >> 4, fr = lane & 15, q = fr >> 2, p = fr & 3;
    constexpr int P1 = 272, PV = 528, KS = 0, VS = 128 * 272, STS = 0;
    LAS unsigned char* lds = F.lds;
    for (int u = F.bid; u < 512; u += F.G) {
        const int b = u >> 8, h = (u >> 5) & 7, n = u & 31; const size_t t0 = (size_t)b * SEQ + n * 128; const float l2g = LOG2G[h];
        v4u kreg[4], vreg[8];
#pragma unroll
        for (int i = 0; i < 4; ++i) { const int c = tid + 512 * i, row = c >> 4, ch = c & 15; kreg[i] = *(const v4u*)(PROJ + (t0 + row) * NPROJ + C_KR + h * 128 + ch * 8); }
#pragma unroll
        for (int i = 0; i < 8; ++i) { const int c = tid + 512 * i, row = c >> 5, ch = c & 31; vreg[i] = *(const v4u*)(PROJ + (t0 + row) * NPROJ + C_VR + h * 256 + ch * 8); }
#pragma unroll
        for (int i = 0; i < 8; ++i) { const int c = tid + 512 * i, row = c >> 4, ch = c & 15;
            *(LAS v4u*)(lds + STS + row * P1 + ch * 16) = *(const v4u*)((const bf16*)KV + ((size_t)u * 256 + row) * 128 + ch * 8); }
        bf16x8 qf[4];
#pragma unroll
        for (int ds = 0; ds < 4; ++ds) qf[ds] = *(const bf16x8*)(PROJ + (t0 + 16 * w + fr) * NPROJ + C_QR + h * 128 + 32 * ds + 8 * g);
        __syncthreads();
        f32x4 acc[16];
#pragma unroll
        for (int et = 0; et < 16; ++et) { acc[et] = (f32x4){0.f, 0.f, 0.f, 0.f};
#pragma unroll
            for (int ds = 0; ds < 4; ++ds) { const bf16x8 A = *(const LAS bf16x8*)(lds + STS + (16 * et + fr) * P1 + (32 * ds + 8 * g) * 2); acc[et] = MFMA16(A, qf[ds], acc[et]); } }
        const int c = 16 * w + fr; const float qd = exp2f((float)(c + 1) * l2g);
#pragma unroll
        for (int et = 0; et < 16; ++et) acc[et] = acc[et] * qd;
        __syncthreads();
#pragma unroll
        for (int i = 0; i < 4; ++i) { const int cc = tid + 512 * i, row = cc >> 4, ch = cc & 15; *(LAS v4u*)(lds + KS + row * P1 + ch * 16) = kreg[i]; }
#pragma unroll
        for (int i = 0; i < 8; ++i) { const int cc = tid + 512 * i, row = cc >> 5, ch = cc & 31; *(LAS v4u*)(lds + VS + row * PV + ch * 16) = vreg[i]; }
        __syncthreads();
        float dq[4]; bool mk[4];
#pragma unroll
        for (int r = 0; r < 4; ++r) { dq[r] = exp2f((float)(fr - 4 * g - r) * l2g); mk[r] = (fr - 4 * g - r) >= 0; }
#pragma unroll 1
        for (int i2 = 0; 2 * i2 <= w; ++i2) {
            const int k0 = 2 * i2, k1 = 2 * i2 + 1;
            f32x4 s0 = {0.f, 0.f, 0.f, 0.f}, s1 = {0.f, 0.f, 0.f, 0.f};
#pragma unroll
            for (int ds = 0; ds < 4; ++ds) { const bf16x8 A0 = *(const LAS bf16x8*)(lds + KS + (16 * k0 + fr) * P1 + (32 * ds + 8 * g) * 2); s0 = MFMA16(A0, qf[ds], s0); }
            if (k1 <= w) {
#pragma unroll
                for (int ds = 0; ds < 4; ++ds) { const bf16x8 A1 = *(const LAS bf16x8*)(lds + KS + (16 * k1 + fr) * P1 + (32 * ds + 8 * g) * 2); s1 = MFMA16(A1, qf[ds], s1); } }
            const float tf0 = exp2f((float)(16 * (w - k0)) * l2g), tf1 = (k1 <= w) ? exp2f((float)(16 * (w - k1)) * l2g) : 0.f;
            const bool d0 = (k0 == w), d1 = (k1 == w);
#pragma unroll
            for (int r = 0; r < 4; ++r) { s0[r] = (!d0 || mk[r]) ? s0[r] * (dq[r] * tf0) : 0.f; s1[r] = (!d1 || mk[r]) ? s1[r] * (dq[r] * tf1) : 0.f; }
            v4u bp; bp.x = pk2(s0[0], s0[1]); bp.y = pk2(s0[2], s0[3]); bp.z = pk2(s1[0], s1[1]); bp.w = pk2(s1[2], s1[3]);
            const bf16x8 Bp = __builtin_bit_cast(bf16x8, bp);
            const int k1c = (k1 <= 7) ? k1 : 7;
            const LAS unsigned char* va0 = lds + VS + (16 * k0 + 4 * g + q) * PV + (4 * p) * 2; const LAS unsigned char* va1 = lds + VS + (16 * k1c + 4 * g + q) * PV + (4 * p) * 2;
#pragma unroll
            for (int et = 0; et < 16; ++et) { const s16x4 a0 = tr16(va0 + 32 * et), a1 = tr16(va1 + 32 * et);
                acc[et] = MFMA16(cat8(a0, a1), Bp, acc[et]); }
        }
        float sm = 0.f;
#pragma unroll
        for (int et = 0; et < 16; ++et) sm += (acc[et][0] + acc[et][1]) + (acc[et][2] + acc[et][3]);
        sm += __shfl_xor(sm, 16); sm += __shfl_xor(sm, 32);
        const float mu = sm * (1.0f / 256.0f); float vs = 0.f;
#pragma unroll
        for (int et = 0; et < 16; ++et) { acc[et] = acc[et] - mu; vs += (acc[et][0] * acc[et][0] + acc[et][1] * acc[et][1]) + (acc[et][2] * acc[et][2] + acc[et][3] * acc[et][3]); }
        vs += __shfl_xor(vs, 16); vs += __shfl_xor(vs, 32);
        const float rs = 1.0f / sqrtf(vs * (1.0f / 256.0f) + EPS);
        const size_t t = t0 + c;
#pragma unroll
        for (int et = 0; et < 16; ++et) { const int e0 = 16 * et + 4 * g;
            const unsigned long long gg = *(const unsigned long long*)(PROJ + t * NPROJ + C_GR + h * 256 + e0); const unsigned glo = (unsigned)gg, ghi = (unsigned)(gg >> 32);
            if (P3_FP8) { const float rq = rs * P3_AS; *(unsigned*)((unsigned char*)RO + t * DM + h * 256 + e0) = pk4_fp8(acc[et][0] * rq * bflo(glo), acc[et][1] * rq * bfhi(glo), acc[et][2] * rq * bflo(ghi), acc[et][3] * rq * bfhi(ghi)); }
            else { const unsigned o0 = pk2(acc[et][0] * rs * bflo(glo), acc[et][1] * rs * bfhi(glo)), o1 = pk2(acc[et][2] * rs * bflo(ghi), acc[et][3] * rs * bfhi(ghi));
            *(unsigned long long*)(RO + t * DM + h * 256 + e0) = (unsigned long long)o0 | ((unsigned long long)o1 << 32); } }
        __syncthreads();
    }
}
__device__ __forceinline__ void p2_attn_mfma(Frame& F) {
    const bf16* PROJ = (const bf16*)(F.ws + WS_PROJ); bf16* AO = (bf16*)(F.ws + WS_AO);
    const int tid = opq(F.tid), lane = tid & 63, w = F.wave, g = lane >> 4, fr = lane & 15, q = fr >> 2, p = fr & 3;
    constexpr int PK = 272, KS = 0, VS = 192 * 272;
    LAS unsigned char* lds = F.lds;
    for (int u = F.bid; u < 256; u += F.G) {
        const int b = u >> 7, kvh = (u >> 6) & 1, qb = u & 63, q0 = qb * 64; const size_t tb = (size_t)b * SEQ;
#pragma unroll
        for (int i = 0; i < 6; ++i) { const int c = tid + 512 * i, row = c >> 4, ch = c & 15, kp = q0 - 128 + row;
            v4u kv = {0u, 0u, 0u, 0u}, vv = {0u, 0u, 0u, 0u};
            if (kp >= 0) { kv = *(const v4u*)(PROJ + (tb + kp) * NPROJ + C_KA + kvh * 128 + ch * 8); vv = *(const v4u*)(PROJ + (tb + kp) * NPROJ + C_VA + kvh * 128 + ch * 8); }
            *(LAS v4u*)(lds + KS + row * PK + ch * 16) = kv; *(LAS v4u*)(lds + VS + row * PK + ch * 16) = vv; }
        __syncthreads();
        const int hq = w >> 1, qh = w & 1, h = kvh * 4 + hq; const float sink = F.sinks[h] * LOG2E;
#pragma unroll 1
        for (int qt = 0; qt < 2; ++qt) {
            const int qpos = q0 + 32 * qh + 16 * qt + fr;
            bf16x8 qf[4];
#pragma unroll
            for (int ds = 0; ds < 4; ++ds) qf[ds] = *(const bf16x8*)(PROJ + (tb + qpos) * NPROJ + C_QA + h * 128 + 32 * ds + 8 * g);
            const int rb = 32 * qh + 16 * qt;
            f32x4 s[10]; float m = sink;
#pragma unroll
            for (int j = 0; j < 9; ++j) { s[j] = (f32x4){0.f, 0.f, 0.f, 0.f};
#pragma unroll
                for (int ds = 0; ds < 4; ++ds) { const bf16x8 A = *(const LAS bf16x8*)(lds + KS + (rb + 16 * j + fr) * PK + (32 * ds + 8 * g) * 2); s[j] = MFMA16(A, qf[ds], s[j]); } }
            s[9] = (f32x4){-1e30f, -1e30f, -1e30f, -1e30f};
#pragma unroll
            for (int r = 0; r < 4; ++r) { const int dd = fr - 4 * g - r; s[0][r] = (dd < 0) ? s[0][r] : -1e30f; s[8][r] = (dd >= 0) ? s[8][r] : -1e30f; }
            if (q0 < 128) {
#pragma unroll
                for (int j = 0; j < 9; ++j)
#pragma unroll
                    for (int r = 0; r < 4; ++r) { const int kp = q0 - 128 + rb + 16 * j + 4 * g + r; s[j][r] = (kp >= 0) ? s[j][r] : -1e30f; } }
#pragma unroll
            for (int j = 0; j < 9; ++j) m = fmaxf(m, fmaxf(fmaxf(s[j][0], s[j][1]), fmaxf(s[j][2], s[j][3])));
            m = fmaxf(m, __shfl_xor(m, 16)); m = fmaxf(m, __shfl_xor(m, 32));
            float l = 0.f;
#pragma unroll
            for (int j = 0; j < 10; ++j)
#pragma unroll
                for (int r = 0; r < 4; ++r) { s[j][r] = __builtin_amdgcn_exp2f(s[j][r] - m); l += s[j][r]; }
            l += __shfl_xor(l, 16); l += __shfl_xor(l, 32); l += __builtin_amdgcn_exp2f(sink - m);
            f32x4 o[8];
#pragma unroll
            for (int dt = 0; dt < 8; ++dt) o[dt] = (f32x4){0.f, 0.f, 0.f, 0.f};
#pragma unroll
            for (int st = 0; st < 5; ++st) {
                v4u bp; bp.x = pk2(s[2 * st][0], s[2 * st][1]); bp.y = pk2(s[2 * st][2], s[2 * st][3]); bp.z = pk2(s[2 * st + 1][0], s[2 * st + 1][1]); bp.w = pk2(s[2 * st + 1][2], s[2 * st + 1][3]);
                const bf16x8 Bp = __builtin_bit_cast(bf16x8, bp);
                const LAS unsigned char* va = lds + VS + (rb + 32 * st + 4 * g + q) * PK + (4 * p) * 2;
                const int o1 = (st < 4) ? 16 * PK : 0;
#pragma unroll
                for (int dt = 0; dt < 8; ++dt) { const s16x4 a0 = tr16(va + 32 * dt), a1 = tr16(va + o1 + 32 * dt); o[dt] = MFMA16(cat8(a0, a1), Bp, o[dt]); }
            }
            const float inv = 1.0f / l;
#pragma unroll
            for (int dt = 0; dt < 8; ++dt) {
                if (P3_FP8) { const float is = inv * P3_AS; *(unsigned*)((unsigned char*)AO + (tb + qpos) * 1024 + h * 128 + 16 * dt + 4 * g) = pk4_fp8(o[dt][0] * is, o[dt][1] * is, o[dt][2] * is, o[dt][3] * is); }
                else { const unsigned o0 = pk2(o[dt][0] * inv, o[dt][1] * inv), o1 = pk2(o[dt][2] * inv, o[dt][3] * inv);
                *(unsigned long long*)(AO + (tb + qpos) * 1024 + h * 128 + 16 * dt + 4 * g) = (unsigned long long)o0 | ((unsigned long long)o1 << 32); } }
        }
        __syncthreads();
    }
}
template <int CTRL> __device__ __forceinline__ float dppf(float v) { return __builtin_bit_cast(float, __builtin_amdgcn_update_dpp(0, __builtin_bit_cast(int, v), CTRL, 0xF, 0xF, true)); }
template <int CTRL> __device__ __forceinline__ int dppi(int v) { return __builtin_amdgcn_update_dpp(0, v, CTRL, 0xF, 0xF, true); }
__device__ __forceinline__ float g16_max(float v) { v = fmaxf(v, dppf<0xB1>(v)); v = fmaxf(v, dppf<0x4E>(v)); v = fmaxf(v, dppf<0x141>(v)); v = fmaxf(v, dppf<0x140>(v)); return v; }
__device__ __forceinline__ float g16_sum(float v) { v += dppf<0xB1>(v); v += dppf<0x4E>(v); v += dppf<0x141>(v); v += dppf<0x140>(v); return v; }
__device__ __forceinline__ int g16_min(int v) { v = min(v, dppi<0xB1>(v)); v = min(v, dppi<0x4E>(v)); v = min(v, dppi<0x141>(v)); v = min(v, dppi<0x140>(v)); return v; }
__constant__ unsigned char CAND_SLOT[64] = {
    0, 1, 2, 3, 4, 5, 6, 7, 8, 9, 10, 11, 12, 13, 14, 15,
    16, 17, 18, 19, 20, 21, 22, 23, 32, 33, 34, 35, 36, 48, 49, 50,
    51, 64, 65, 66, 80, 81, 96, 97, 112, 113, 128, 144, 160, 176, 192, 208,
    224, 240, 255, 255, 255, 255, 255, 255, 255, 255, 255, 255, 255, 255, 255, 255};
__device__ __forceinline__ void p5_topk_mfma(Frame& F) {
    const bf16* QRY = (const bf16*)(F.ws + WS_PROJ); const bf16* SK = (const bf16*)(F.ws + WS_SK);
    int* IDX = (int*)(F.ws + WS_IDX); float* GATE = (float*)(F.ws + WS_GATE);
    const int lane = opq(F.lane), w = F.wave, g = lane >> 4, fr = lane & 15;
    LAS unsigned char* lds = F.lds;
    int cslot[4];
#pragma unroll
    for (int s = 0; s < 4; ++s) cslot[s] = CAND_SLOT[16 * s + fr];
    for (int u = F.bid; u < 1024; u += F.G) {
        const int tbk = u >> 3, h = u & 7, pp = w >> 2, tt = w & 3;
        bf16x8 af[4];
#pragma unroll
        for (int ds = 0; ds < 4; ++ds) af[ds] = *(const bf16x8*)(QRY + (size_t)(64 * tbk + 16 * tt + fr) * DM + h * 256 + pp * 128 + 32 * ds + 8 * g);
        f32x4 sc[8];
#pragma unroll
        for (int nt = 0; nt < 8; ++nt) { sc[nt] = (f32x4){0.f, 0.f, 0.f, 0.f};
#pragma unroll
            for (int ds = 0; ds < 4; ++ds) { const bf16x8 Bk = *(const bf16x8*)(SK + (size_t)((pp * 8 + h) * 128 + 16 * nt + fr) * 128 + 32 * ds + 8 * g); sc[nt] = MFMA16(af[ds], Bk, sc[nt]); } }
#pragma unroll
        for (int r = 0; r < 4; ++r) {
            float v[8];
#pragma unroll
            for (int nt = 0; nt < 8; ++nt) v[nt] = sc[nt][r];
            float tv = 0.f; int ti = 0;
#pragma unroll 1
            for (int rd = 0; rd < 16; ++rd) {
                float lm = fmaxf(fmaxf(fmaxf(v[0], v[1]), fmaxf(v[2], v[3])), fmaxf(fmaxf(v[4], v[5]), fmaxf(v[6], v[7])));
                const float mx = g16_max(lm);
                int li = 1 << 20;
#pragma unroll
                for (int nt = 7; nt >= 0; --nt) li = (v[nt] == mx) ? (16 * nt + fr) : li;
                const int wi = g16_min(li);
#pragma unroll
                for (int nt = 0; nt < 8; ++nt) v[nt] = (wi == 16 * nt + fr) ? -INFINITY : v[nt];
                if (fr == rd) { tv = mx; ti = wi; }
            }
            const int tok = 16 * tt + 4 * g + r;
            *(LAS f32x2*)(lds + ((tok * 2 + pp) * 16 + fr) * 8) = (f32x2){tv, __int_as_float(ti)};
        }
        __syncthreads();
#pragma unroll 1
        for (int tk = 0; tk < 2; ++tk) {
            const int tok = 8 * w + 2 * g + tk;
            const LAS f32x2* La = (const LAS f32x2*)(lds + (tok * 2 + 0) * 128); const LAS f32x2* Lb = (const LAS f32x2*)(lds + (tok * 2 + 1) * 128);
            float cv[4];
#pragma unroll
            for (int s = 0; s < 4; ++s) { const int ij = cslot[s]; cv[s] = (ij == 255) ? -INFINITY : La[(ij >> 4) & 15].x + Lb[ij & 15].x; }
            float bs = 0.f, m0 = 0.f; int be = 0;
#pragma unroll 1
            for (int rd = 0; rd < 16; ++rd) {
                const float lm = fmaxf(fmaxf(cv[0], cv[1]), fmaxf(cv[2], cv[3]));
                const float mx = g16_max(lm);
                int li = 1 << 20;
#pragma unroll
                for (int s = 3; s >= 0; --s) li = (cv[s] == mx && cslot[s] < li) ? cslot[s] : li;
                const int wf = g16_min(li);
#pragma unroll
                for (int s = 0; s < 4; ++s) cv[s] = (cslot[s] == wf) ? -INFINITY : cv[s];
                if (rd == 0) m0 = mx;
                if (fr == rd) { bs = mx; be = wf; }
            }
            const int ex_id = __float_as_int(La[(be >> 4) & 15].y) * 128 + __float_as_int(Lb[be & 15].y);
            const float ex = __expf(bs - m0); const float sum = g16_sum(ex);
            const size_t o = (size_t)(64 * tbk + tok) * 128 + h * 16 + fr;
            IDX[o] = ex_id; GATE[o] = ex / sum;
        }
        __syncthreads();
    }
}
__device__ __forceinline__ int f2sort(float f) { const int i = __float_as_int(f); return i ^ ((i >> 31) & 0x7fffffff); }
__device__ __forceinline__ float sort2f(int k) { return __int_as_float(k ^ ((k >> 31) & 0x7fffffff)); }
__device__ __forceinline__ int g16_max_i(int v) { v = max(v, dppi<0xB1>(v)); v = max(v, dppi<0x4E>(v)); v = max(v, dppi<0x141>(v)); v = max(v, dppi<0x140>(v)); return v; }
#define TK_CE(a, b) do { const int hi_ = max((a), (b)), lo_ = min((a), (b)); (a) = hi_; (b) = lo_; } while (0)
__device__ __forceinline__ void p5_topk_v2(Frame& F, int tile_pm = -1, int tile_pn = 0) {
    const bf16* QRY = (const bf16*)(F.ws + WS_PROJ); const bf16* SK = (const bf16*)(F.ws + WS_SK);
    int* IDX = (int*)(F.ws + WS_IDX); float* GATE = (float*)(F.ws + WS_GATE);
    const int lane = opq(F.lane), w = F.wave, g = lane >> 4, fr = lane & 15;
    LAS unsigned char* lds = F.lds + 69632;
    LAS unsigned char* kl = F.lds;
    const bool keys_in_lds = (tile_pm >= 0) || (F.G & 7) == 0;
    if (keys_in_lds) { const int hh = (tile_pm >= 0) ? tile_pn : (F.bid & 7);
#pragma unroll
        for (int i = 0; i < 8; ++i) { const int c = F.tid + 512 * i, row = c >> 4, ch = c & 15, pq = row >> 7, n = row & 127;
            *(LAS v4u*)(kl + row * 272 + ch * 16) = *(const v4u*)(SK + (size_t)((pq * 8 + hh) * 128 + n) * 128 + ch * 8); }
        __syncthreads(); }
    int cslot[4];
#pragma unroll
    for (int s = 0; s < 4; ++s) cslot[s] = CAND_SLOT[16 * s + fr];
    const int u_first = (tile_pm >= 0) ? (32 * tile_pm + tile_pn) : F.bid, u_step = (tile_pm >= 0) ? 8 : F.G, u_end = (tile_pm >= 0) ? (32 * tile_pm + 32) : 1024;
    for (int u = u_first; u < u_end; u += u_step) {
        const int tbk = u >> 3, h = u & 7, pp = w >> 2, tt = w & 3;
        bf16x8 af[4];
#pragma unroll
        for (int ds = 0; ds < 4; ++ds) af[ds] = *(const bf16x8*)(QRY + (size_t)(64 * tbk + 16 * tt + fr) * DM + h * 256 + pp * 128 + 32 * ds + 8 * g);
        f32x4 sc[8];
#pragma unroll
        for (int nt = 0; nt < 8; ++nt) { sc[nt] = (f32x4){0.f, 0.f, 0.f, 0.f};
#pragma unroll
            for (int ds = 0; ds < 4; ++ds) { bf16x8 Bk;
                if (keys_in_lds) Bk = *(const LAS bf16x8*)(kl + (pp * 128 + 16 * nt + fr) * 272 + (32 * ds + 8 * g) * 2);
                else Bk = *(const bf16x8*)(SK + (size_t)((pp * 8 + h) * 128 + 16 * nt + fr) * 128 + 32 * ds + 8 * g);
                sc[nt] = MFMA16(af[ds], Bk, sc[nt]); } }
        int k[4][8];
#pragma unroll
        for (int r = 0; r < 4; ++r) {
#pragma unroll
            for (int nt = 0; nt < 8; ++nt) k[r][nt] = (f2sort(sc[nt][r]) & ~127) | (127 - (16 * nt + fr));
            TK_CE(k[r][0], k[r][1]); TK_CE(k[r][2], k[r][3]); TK_CE(k[r][4], k[r][5]); TK_CE(k[r][6], k[r][7]);
            TK_CE(k[r][0], k[r][2]); TK_CE(k[r][1], k[r][3]); TK_CE(k[r][4], k[r][6]); TK_CE(k[r][5], k[r][7]);
            TK_CE(k[r][1], k[r][2]); TK_CE(k[r][5], k[r][6]);
            TK_CE(k[r][0], k[r][4]); TK_CE(k[r][1], k[r][5]); TK_CE(k[r][2], k[r][6]); TK_CE(k[r][3], k[r][7]);
            TK_CE(k[r][2], k[r][4]); TK_CE(k[r][3], k[r][5]);
            TK_CE(k[r][1], k[r][2]); TK_CE(k[r][3], k[r][4]); TK_CE(k[r][5], k[r][6]);
        }
        int res[4] = {0, 0, 0, 0};
#pragma unroll 1
        for (int rd = 0; rd < 16; ++rd) {
#pragma unroll
            for (int r = 0; r < 4; ++r) {
                const int mx = g16_max_i(k[r][0]); const bool win = (k[r][0] == mx);
#pragma unroll
                for (int i = 0; i < 7; ++i) k[r][i] = win ? k[r][i + 1] : k[r][i];
                k[r][7] = win ? (int)0x80000000 : k[r][7];
                res[r] = (fr == rd) ? mx : res[r];
            }
        }
#pragma unroll
        for (int r = 0; r < 4; ++r) { const int tok = 16 * tt + 4 * g + r;
            *(LAS f32x2*)(lds + ((tok * 2 + pp) * 16 + fr) * 8) = (f32x2){sort2f(res[r] & ~127), __int_as_float(127 - (res[r] & 127))}; }
        __syncthreads();
        int c[2][4];
#pragma unroll
        for (int tk = 0; tk < 2; ++tk) { const int tok = 8 * w + 2 * g + tk;
            const LAS f32x2* La = (const LAS f32x2*)(lds + (tok * 2 + 0) * 128); const LAS f32x2* Lb = (const LAS f32x2*)(lds + (tok * 2 + 1) * 128);
#pragma unroll
            for (int s = 0; s < 4; ++s) { const int ij = cslot[s]; c[tk][s] = (ij == 255) ? (int)0x80000000 : ((f2sort(La[(ij >> 4) & 15].x + Lb[ij & 15].x) & ~255) | (255 - ij)); }
            TK_CE(c[tk][0], c[tk][1]); TK_CE(c[tk][2], c[tk][3]); TK_CE(c[tk][0], c[tk][2]); TK_CE(c[tk][1], c[tk][3]); TK_CE(c[tk][1], c[tk][2]); }
        int rs2[2] = {0, 0}, m0[2] = {0, 0};
#pragma unroll 1
        for (int rd = 0; rd < 16; ++rd) {
#pragma unroll
            for (int tk = 0; tk < 2; ++tk) {
                const int mx = g16_max_i(c[tk][0]); const bool win = (c[tk][0] == mx);
                c[tk][0] = win ? c[tk][1] : c[tk][0]; c[tk][1] = win ? c[tk][2] : c[tk][1]; c[tk][2] = win ? c[tk][3] : c[tk][2]; c[tk][3] = win ? (int)0x80000000 : c[tk][3];
                rs2[tk] = (fr == rd) ? mx : rs2[tk]; m0[tk] = (rd == 0) ? mx : m0[tk];
            }
        }
#pragma unroll
        for (int tk = 0; tk < 2; ++tk) { const int tok = 8 * w + 2 * g + tk;
            const LAS f32x2* La = (const LAS f32x2*)(lds + (tok * 2 + 0) * 128); const LAS f32x2* Lb = (const LAS f32x2*)(lds + (tok * 2 + 1) * 128);
            const int flat = 255 - (rs2[tk] & 255);
            const int ex_id = __float_as_int(La[(flat >> 4) & 15].y) * 128 + __float_as_int(Lb[flat & 15].y);
            const float ex = __expf(sort2f(rs2[tk] & ~255) - sort2f(m0[tk] & ~255)); const float sum = g16_sum(ex);
            const size_t o = (size_t)(64 * tbk + tok) * 128 + h * 16 + fr;
            IDX[o] = ex_id; GATE[o] = ex / sum; }
        __syncthreads();
    }
}
__device__ __forceinline__ void p5_topk_naive(Frame& F) {
    const bf16* QRY = (const bf16*)(F.ws + WS_PROJ); const bf16* SK = (const bf16*)(F.ws + WS_SK);
    int* IDX = (int*)(F.ws + WS_IDX); float* GATE = (float*)(F.ws + WS_GATE); const int lane = F.lane;
    LAS float* wts = (LAS float*)(F.lds + F.wave * 512); LAS int* wti = (LAS int*)(F.lds + F.wave * 512 + 128);
    LAS float* wbs = (LAS float*)(F.lds + F.wave * 512 + 256); LAS int* wbi = (LAS int*)(F.lds + F.wave * 512 + 320);
    for (int it = F.gw; it < T * 8; it += F.NGW) {
        const int t = it >> 3, h = it & 7;
#pragma unroll
        for (int p = 0; p < 2; ++p) {
            const v4u* qr = (const v4u*)(QRY + (size_t)t * DM + h * 256 + p * 128);
            v4u q[16];
#pragma unroll
            for (int i = 0; i < 16; ++i) q[i] = qr[i];
            float v[2];
#pragma unroll
            for (int half = 0; half < 2; ++half) { const v4u* kr = (const v4u*)(SK + ((size_t)((p * 8 + h) * 128 + lane + 64 * half)) * 128); float acc = 0.f;
#pragma unroll
                for (int i = 0; i < 16; ++i) acc = dot8(q[i], kr[i], acc);
                v[half] = acc; }
#pragma unroll
            for (int r = 0; r < 16; ++r) {
                const float bv = fmaxf(v[0], v[1]); const int bi = (v[0] >= v[1]) ? lane : lane + 64;
                const float mx = wave_max(bv);
                const int widx = wave_min_i(bv == mx ? bi : 1 << 20);
                if (lane == 0) { wts[p * 16 + r] = mx; wti[p * 16 + r] = widx; }
                if (lane == (widx & 63)) { if (widx < 64) v[0] = -INFINITY; else v[1] = -INFINITY; }
            }
        }
        LDS_WAIT(); asm volatile("" ::: "memory");
        float cv[4];
        const float tb = wts[16 + (lane & 15)];
#pragma unroll
        for (int qq = 0; qq < 4; ++qq) cv[qq] = wts[(lane >> 4) + 4 * qq] + tb;
#pragma unroll
        for (int r = 0; r < 16; ++r) {
            float bv = cv[0]; int bf = lane;
#pragma unroll
            for (int qq = 1; qq < 4; ++qq) if (cv[qq] > bv) { bv = cv[qq]; bf = lane + 64 * qq; }
            const float mx = wave_max(bv);
            const int fmin = wave_min_i(bv == mx ? bf : 1 << 20);
            if (lane == 0) { wbs[r] = mx; wbi[r] = wti[fmin >> 4] * 128 + wti[16 + (fmin & 15)]; }
            if (lane == (fmin & 63)) {
#pragma unroll
                for (int qq = 0; qq < 4; ++qq) if ((fmin >> 6) == qq) cv[qq] = -INFINITY; }
        }
        LDS_WAIT(); asm volatile("" ::: "memory");
        const float bs = (lane < 16) ? wbs[lane] : -INFINITY; const float bmax = wbs[0];
        const float ex = (lane < 16) ? __expf(bs - bmax) : 0.f; const float sum = wave_sum(ex);
        if (lane < 16) { IDX[(size_t)t * 128 + h * 16 + lane] = wbi[lane]; GATE[(size_t)t * 128 + h * 16 + lane] = ex / sum; }
        LDS_WAIT(); asm volatile("" ::: "memory");
    }
}
__device__ __forceinline__ float gelu_erf(float v) { return 0.5f * v * (1.0f + erff(v * 0.70710678118654752f)); }
__device__ __forceinline__ void p6_peer(Frame& F) {
    const bf16* ED = (const bf16*)(F.ws + WS_ED); const bf16* EU = (const bf16*)(F.ws + WS_EU);
    const int* IDX = (const int*)(F.ws + WS_IDX); const float* GATE = (const float*)(F.ws + WS_GATE); const float* ssq = (const float*)(F.ws + WS_SSQ);
    const int lane = F.lane;
    for (int t = F.gw; t < T; t += F.NGW) {
        float* hrow = F.out + (size_t)t * DM;
        const float r2 = 1.0f / sqrtf(__hip_atomic_load(ssq + t, __ATOMIC_RELAXED, __HIP_MEMORY_SCOPE_AGENT) * (1.0f / DM) + EPS);
        v4u hn[4];
#pragma unroll
        for (int j = 0; j < 4; ++j) { const f32x4 a = ((const f32x4*)hrow)[128 * j + 2 * lane], b = ((const f32x4*)hrow)[128 * j + 2 * lane + 1];
            const f32x4 ga = ((const f32x4*)F.ffn_norm)[128 * j + 2 * lane], gb = ((const f32x4*)F.ffn_norm)[128 * j + 2 * lane + 1];
            hn[j] = pack8(a * r2 * ga, b * r2 * gb); }
        const int id0 = IDX[(size_t)t * 128 + lane], id1 = IDX[(size_t)t * 128 + 64 + lane];
        const float g0 = GATE[(size_t)t * 128 + lane], g1 = GATE[(size_t)t * 128 + 64 + lane];
        float c0 = 0.f, c1 = 0.f;
#pragma unroll 1
        for (int e0 = 0; e0 < 128; e0 += 4) {
            float part[4];
#pragma unroll
            for (int ee = 0; ee < 4; ++ee) { const int e = e0 + ee; const int row = rdlane_i(e < 64 ? id0 : id1, e & 63);
                const v4u* rp = (const v4u*)(ED + (size_t)row * DM) + lane; float acc = 0.f;
#pragma unroll
                for (int j = 0; j < 4; ++j) acc = dot8(hn[j], rp[64 * j], acc);
                part[ee] = acc; }
#pragma unroll
            for (int ee = 0; ee < 4; ++ee) { const int e = e0 + ee; const float uu = wave_sum(part[ee]); const float cc = gelu_erf(uu);
                if (lane == (e & 63)) { if (e < 64) c0 = cc * g0; else c1 = cc * g1; } }
        }
        f32x4 y[8];
#pragma unroll
        for (int j = 0; j < 8; ++j) y[j] = (f32x4){0.f, 0.f, 0.f, 0.f};
#pragma unroll 1
        for (int e0 = 0; e0 < 128; e0 += 4) {
#pragma unroll
            for (int ee = 0; ee < 4; ++ee) { const int e = e0 + ee; const int row = rdlane_i(e < 64 ? id0 : id1, e & 63); const float ce = rdlane(e < 64 ? c0 : c1, e & 63);
                const v4u* rp = (const v4u*)(EU + (size_t)row * DM) + lane;
#pragma unroll
                for (int j = 0; j < 4; ++j) { const v4u w = rp[64 * j];
                    y[2 * j][0] += ce * bflo(w.x); y[2 * j][1] += ce * bfhi(w.x); y[2 * j][2] += ce * bflo(w.y); y[2 * j][3] += ce * bfhi(w.y);
                    y[2 * j + 1][0] += ce * bflo(w.z); y[2 * j + 1][1] += ce * bfhi(w.z); y[2 * j + 1][2] += ce * bflo(w.w); y[2 * j + 1][3] += ce * bfhi(w.w); } }
        }
        float ss = 0.f;
#pragma unroll
        for (int j = 0; j < 4; ++j) { const f32x4 a = ((const f32x4*)hrow)[128 * j + 2 * lane], b = ((const f32x4*)hrow)[128 * j + 2 * lane + 1];
            y[2 * j] += a; y[2 * j + 1] += b;
            const f32x4 u0 = y[2 * j], u1 = y[2 * j + 1];
            ss += (u0[0] * u0[0] + u0[1] * u0[1]) + (u0[2] * u0[2] + u0[3] * u0[3]) + (u1[0] * u1[0] + u1[1] * u1[1]) + (u1[2] * u1[2] + u1[3] * u1[3]); }
        const float rf = 1.0f / sqrtf(wave_sum(ss) * (1.0f / DM) + EPS);
#pragma unroll
        for (int j = 0; j < 4; ++j) { const f32x4 ga = ((const f32x4*)F.final_norm)[128 * j + 2 * lane], gb = ((const f32x4*)F.final_norm)[128 * j + 2 * lane + 1];
            ((f32x4*)hrow)[128 * j + 2 * lane] = y[2 * j] * rf * ga; ((f32x4*)hrow)[128 * j + 2 * lane + 1] = y[2 * j + 1] * rf * gb; }
    }
}

#ifndef PEER_FP8
#define PEER_FP8 1
#endif
constexpr size_t WS_ESC = WS_SK + 512 * 1024;
__device__ __forceinline__ float wave_sum_fast(float v) { v = g16_sum(v); v += __shfl_xor(v, 16); v += __shfl_xor(v, 32); return v; }
template <bool FP8> __device__ __forceinline__ void p6_peer2(Frame& F) {
    constexpr int NCH = FP8 ? 2 : 4, ROWB = FP8 ? 2048 : 4096, NR = FP8 ? 4 : 2;
    const unsigned char* ED = F.ws + WS_ED; const unsigned char* EU = F.ws + WS_EU; const float* ESC = (const float*)(F.ws + WS_ESC);
    const int* IDX = (const int*)(F.ws + WS_IDX); const float* GATE = (const float*)(F.ws + WS_GATE); const float* ssq = (const float*)(F.ws + WS_SSQ);
    const int lane = F.lane;
#define P6_LOAD(BUF, TAB, E0) do { _Pragma("unroll") for (int ee = 0; ee < NR; ++ee) { const int e_ = (E0) + ee; const int row_ = rdlane_i(e_ < 64 ? id0 : id1, e_ & 63); \
        const v4u* rp_ = (const v4u*)((TAB) + (size_t)row_ * ROWB) + lane; _Pragma("unroll") for (int j = 0; j < NCH; ++j) BUF[ee][j] = rp_[64 * j]; } } while (0)
#define P6_DOTS(BUF, E0) do { _Pragma("unroll") for (int ee = 0; ee < NR; ++ee) { const int e_ = (E0) + ee; float part_; \
        if constexpr (FP8) { f32x2 acc_ = {0.f, 0.f}; \
            _Pragma("unroll") for (int j = 0; j < 2; ++j) { const unsigned wd_[4] = {BUF[ee][j].x, BUF[ee][j].y, BUF[ee][j].z, BUF[ee][j].w}; \
                _Pragma("unroll") for (int k = 0; k < 4; ++k) { acc_ = __builtin_elementwise_fma(hf[8 * j + 2 * k], __builtin_amdgcn_cvt_pk_f32_fp8((int)wd_[k], false), acc_); \
                    acc_ = __builtin_elementwise_fma(hf[8 * j + 2 * k + 1], __builtin_amdgcn_cvt_pk_f32_fp8((int)wd_[k], true), acc_); } } \
            part_ = acc_.x + acc_.y; \
        } else { part_ = 0.f; _Pragma("unroll") for (int j = 0; j < NCH; ++j) part_ = dot8(hn[j & 3], BUF[ee][j], part_); } \
        float uu_ = wave_sum_fast(part_); \
        if constexpr (FP8) { const int row_ = rdlane_i(e_ < 64 ? id0 : id1, e_ & 63); uu_ *= ESC[row_]; } \
        const float cc_ = gelu_erf(uu_); \
        if (lane == (e_ & 63)) { if (e_ < 64) c0 = cc_ * g0; else c1 = cc_ * g1; } \
        asm volatile("" ::: "memory"); } } while (0)
#define P6_AXPY(BUF, E0) do { _Pragma("unroll") for (int ee = 0; ee < NR; ++ee) { const int e_ = (E0) + ee; float ce_ = rdlane(e_ < 64 ? c0 : c1, e_ & 63); \
        if constexpr (FP8) { const int row_ = rdlane_i(e_ < 64 ? id0 : id1, e_ & 63); ce_ *= ESC[NEXP + row_]; const f32x2 ce2_ = {ce_, ce_}; \
            _Pragma("unroll") for (int j = 0; j < 2; ++j) { const unsigned wd_[4] = {BUF[ee][j].x, BUF[ee][j].y, BUF[ee][j].z, BUF[ee][j].w}; \
                _Pragma("unroll") for (int k = 0; k < 4; ++k) { f32x2 lo_ = {y[4 * j + k][0], y[4 * j + k][1]}, hi_ = {y[4 * j + k][2], y[4 * j + k][3]}; \
                    lo_ = __builtin_elementwise_fma(ce2_, __builtin_amdgcn_cvt_pk_f32_fp8((int)wd_[k], false), lo_); hi_ = __builtin_elementwise_fma(ce2_, __builtin_amdgcn_cvt_pk_f32_fp8((int)wd_[k], true), hi_); \
                    y[4 * j + k] = (f32x4){lo_.x, lo_.y, hi_.x, hi_.y}; } } \
        } else { _Pragma("unroll") for (int j = 0; j < NCH; ++j) { const v4u w_ = BUF[ee][j]; const int a_ = (2 * j) & 7, b_ = (2 * j + 1) & 7; \
                y[a_][0] += ce_ * bflo(w_.x); y[a_][1] += ce_ * bfhi(w_.x); y[a_][2] += ce_ * bflo(w_.y); y[a_][3] += ce_ * bfhi(w_.y); \
                y[b_][0] += ce_ * bflo(w_.z); y[b_][1] += ce_ * bfhi(w_.z); y[b_][2] += ce_ * bflo(w_.w); y[b_][3] += ce_ * bfhi(w_.w); } } } } while (0)
#pragma unroll 1
    for (int t = F.gw; t < T; t += F.NGW) {
        float* hrow = F.out + (size_t)t * DM;
        const float r2 = 1.0f / sqrtf(__hip_atomic_load(ssq + t, __ATOMIC_RELAXED, __HIP_MEMORY_SCOPE_AGENT) * (1.0f / DM) + EPS);
        v4u hn[4]; f32x2 hf[16];
        if constexpr (FP8) {
#pragma unroll
            for (int j = 0; j < 2; ++j)
#pragma unroll
                for (int k = 0; k < 4; ++k) { const f32x4 a = ((const f32x4*)hrow)[256 * j + 4 * lane + k] * r2 * ((const f32x4*)F.ffn_norm)[256 * j + 4 * lane + k];
                    hf[8 * j + 2 * k] = (f32x2){a[0], a[1]}; hf[8 * j + 2 * k + 1] = (f32x2){a[2], a[3]}; }
        } else {
#pragma unroll
            for (int j = 0; j < 4; ++j) { const f32x4 a = ((const f32x4*)hrow)[128 * j + 2 * lane], b = ((const f32x4*)hrow)[128 * j + 2 * lane + 1];
                const f32x4 ga = ((const f32x4*)F.ffn_norm)[128 * j + 2 * lane], gb = ((const f32x4*)F.ffn_norm)[128 * j + 2 * lane + 1];
                hn[j] = pack8(a * r2 * ga, b * r2 * gb); }
        }
        const int id0 = IDX[(size_t)t * 128 + lane], id1 = IDX[(size_t)t * 128 + 64 + lane];
        const float g0 = GATE[(size_t)t * 128 + lane], g1 = GATE[(size_t)t * 128 + 64 + lane];
        float c0 = 0.f, c1 = 0.f;
        v4u A[NR][NCH], B[NR][NCH];
        P6_LOAD(A, ED, 0);
#pragma unroll 1
        for (int e0 = 0; e0 < 128; e0 += 2 * NR) {
            P6_LOAD(B, ED, e0 + NR);
            P6_DOTS(A, e0);
            if (e0 + 2 * NR < 128) P6_LOAD(A, ED, e0 + 2 * NR);
            P6_DOTS(B, e0 + NR);
        }
        f32x4 y[8];
#pragma unroll
        for (int j = 0; j < 8; ++j) y[j] = (f32x4){0.f, 0.f, 0.f, 0.f};
        P6_LOAD(A, EU, 0);
#pragma unroll 1
        for (int e0 = 0; e0 < 128; e0 += 2 * NR) {
            P6_LOAD(B, EU, e0 + NR);
            P6_AXPY(A, e0);
            if (e0 + 2 * NR < 128) P6_LOAD(A, EU, e0 + 2 * NR);
            P6_AXPY(B, e0 + NR);
        }
        float ss = 0.f;
#pragma unroll
        for (int j = 0; j < 8; ++j) { const int fi = FP8 ? (256 * (j >> 2) + 4 * lane + (j & 3)) : (128 * (j >> 1) + 2 * lane + (j & 1));
            y[j] += ((const f32x4*)hrow)[fi]; ss += (y[j][0] * y[j][0] + y[j][1] * y[j][1]) + (y[j][2] * y[j][2] + y[j][3] * y[j][3]); }
        const float rf = 1.0f / sqrtf(wave_sum(ss) * (1.0f / DM) + EPS);
#pragma unroll
        for (int j = 0; j < 8; ++j) { const int fi = FP8 ? (256 * (j >> 2) + 4 * lane + (j & 3)) : (128 * (j >> 1) + 2 * lane + (j & 1));
            ((f32x4*)hrow)[fi] = y[j] * rf * ((const f32x4*)F.final_norm)[fi]; }
    }
#undef P6_LOAD
#undef P6_DOTS
#undef P6_AXPY
}
__device__ __forceinline__ void p0_experts_fp8(Frame& F) {
    const int lane = F.lane; float* ESC = (float*)(F.ws + WS_ESC);
    for (int row = F.gw; row < 2 * NEXP; row += F.NGW) {
        const float* src = (row < NEXP) ? F.e_down + (size_t)row * DM : F.e_up + (size_t)(row - NEXP) * DM;
        unsigned char* dst = (row < NEXP) ? F.ws + WS_ED + (size_t)row * 2048 : F.ws + WS_EU + (size_t)(row - NEXP) * 2048;
        f32x4 v[8]; float am = 0.f;
#pragma unroll
        for (int j = 0; j < 2; ++j)
#pragma unroll
            for (int k = 0; k < 4; ++k) { const f32x4 a = ((const f32x4*)src)[256 * j + 4 * lane + k]; v[4 * j + k] = a;
                am = fmaxf(am, fmaxf(fmaxf(fabsf(a[0]), fabsf(a[1])), fmaxf(fabsf(a[2]), fabsf(a[3])))); }
        am = wave_max(am); if (!(am > 0.f)) am = 1.0f;
        const float sc = 448.0f / am;
        if (lane == 0) ESC[row] = am * (1.0f / 448.0f);
#pragma unroll
        for (int j = 0; j < 2; ++j) { v4u o;
#pragma unroll
            for (int k = 0; k < 4; ++k) { const f32x4 a = v[4 * j + k] * sc; int pw = 0; pw = __builtin_amdgcn_cvt_pk_fp8_f32(a[0], a[1], pw, false); pw = __builtin_amdgcn_cvt_pk_fp8_f32(a[2], a[3], pw, true);
                if (k == 0) o.x = (unsigned)pw; else if (k == 1) o.y = (unsigned)pw; else if (k == 2) o.z = (unsigned)pw; else o.w = (unsigned)pw; }
            *(v4u*)(dst + 1024 * j + 16 * lane) = o; }
    }
}
typedef float f32x16 __attribute__((ext_vector_type(16)));
typedef float f32x32 __attribute__((ext_vector_type(32)));
typedef unsigned u32x6 __attribute__((ext_vector_type(6)));
typedef unsigned u32x2 __attribute__((ext_vector_type(2)));
struct __attribute__((packed, aligned(4))) U3 { unsigned a, b, c; };
__device__ __forceinline__ void p0_experts_fp6(Frame& F) {
    const int lane = F.lane; float* ESC = (float*)(F.ws + WS_ESC);
    for (int row = F.gw; row < 2 * NEXP; row += F.NGW) {
        const float* src = (row < NEXP) ? F.e_down + (size_t)row * DM : F.e_up + (size_t)(row - NEXP) * DM;
        unsigned char* dst = (row < NEXP) ? F.ws + WS_ED + (size_t)row * 1536 : F.ws + WS_EU + (size_t)(row - NEXP) * 1536;
        f32x4 v[8]; float am = 0.f;
#pragma unroll
        for (int i = 0; i < 8; ++i) { const f32x4 a = ((const f32x4*)src)[64 * i + lane]; v[i] = a;
            am = fmaxf(am, fmaxf(fmaxf(fabsf(a[0]), fabsf(a[1])), fmaxf(fabsf(a[2]), fabsf(a[3])))); }
        am = wave_max(am); if (!(am > 0.f)) am = 1.0f;
        const float sc = 7.5f / am;
        if (lane == 0) ESC[row] = am * (1.0f / 7.5f);
        f32x16 x, y;
#pragma unroll
        for (int k = 0; k < 16; ++k) { x[k] = v[k >> 1][2 * (k & 1)] * sc; y[k] = v[k >> 1][2 * (k & 1) + 1] * sc; }
        const u32x6 p = __builtin_amdgcn_cvt_scalef32_2xpk16_fp6_f32(x, y, 1.0f);
        *(v4u*)(dst + 16 * lane) = (v4u){p[0], p[1], p[2], p[3]};
        *(u32x2*)(dst + 1024 + 8 * lane) = (u32x2){p[4], p[5]};
    }
}
__device__ __forceinline__ void p6_peer_fp6(Frame& F) {
    constexpr int ROWB = 1536, NR = 4;
    const unsigned char* ED = F.ws + WS_ED; const unsigned char* EU = F.ws + WS_EU; const float* ESC = (const float*)(F.ws + WS_ESC);
    const int* IDX = (const int*)(F.ws + WS_IDX); const float* GATE = (const float*)(F.ws + WS_GATE); const float* ssq = (const float*)(F.ws + WS_SSQ);
    const int lane = F.lane;
#define P6F_LOAD(BA, BB, TAB, E0) do { _Pragma("unroll") for (int ee = 0; ee < NR; ++ee) { const int e_ = (E0) + ee; const int row_ = rdlane_i(e_ < 64 ? id0 : id1, e_ & 63); \
        const unsigned char* rp_ = (TAB) + (size_t)row_ * ROWB; BA[ee] = *(const v4u*)(rp_ + 16 * lane); BB[ee] = *(const u32x2*)(rp_ + 1024 + 8 * lane); } } while (0)
#define P6F_DEC(BA, BB, ee) __builtin_amdgcn_cvt_scalef32_pk32_f32_fp6((u32x6){BA[ee].x, BA[ee].y, BA[ee].z, BA[ee].w, BB[ee].x, BB[ee].y}, 1.0f)
#define P6F_DOTS(BA, BB, E0) do { _Pragma("unroll") for (int ee = 0; ee < NR; ++ee) { const int e_ = (E0) + ee; const f32x32 w_ = P6F_DEC(BA, BB, ee); \
        float p0_ = 0.f, p1_ = 0.f; _Pragma("unroll") for (int i = 0; i < 16; ++i) { p0_ += hf[2 * i] * w_[2 * i]; p1_ += hf[2 * i + 1] * w_[2 * i + 1]; } \
        const int row_ = rdlane_i(e_ < 64 ? id0 : id1, e_ & 63); const float uu_ = wave_sum_fast(p0_ + p1_) * ESC[row_]; \
        const float cc_ = gelu_erf(uu_); \
        if (lane == (e_ & 63)) { if (e_ < 64) c0 = cc_ * g0; else c1 = cc_ * g1; } \
        __builtin_amdgcn_sched_barrier(0); } } while (0)
#define P6F_AXPY(BA, BB, E0) do { _Pragma("unroll") for (int ee = 0; ee < NR; ++ee) { const int e_ = (E0) + ee; const int row_ = rdlane_i(e_ < 64 ? id0 : id1, e_ & 63); \
        const float ce_ = rdlane(e_ < 64 ? c0 : c1, e_ & 63) * ESC[NEXP + row_]; const f32x32 w_ = P6F_DEC(BA, BB, ee); \
        _Pragma("unroll") for (int i = 0; i < 32; ++i) y[i] += ce_ * w_[i]; __builtin_amdgcn_sched_barrier(0); } } while (0)
#pragma unroll 1
    for (int t = F.gw; t < T; t += F.NGW) {
        float* hrow = F.out + (size_t)t * DM;
        const float r2 = 1.0f / sqrtf(__hip_atomic_load(ssq + t, __ATOMIC_RELAXED, __HIP_MEMORY_SCOPE_AGENT) * (1.0f / DM) + EPS);
        int ln = lane; asm volatile("" : "+v"(ln));
        float hf[32];
#pragma unroll
        for (int i = 0; i < 8; ++i) { const f32x4 a = ((const f32x4*)hrow)[64 * i + ln] * r2 * ((const f32x4*)F.ffn_norm)[64 * i + ln];
            hf[4 * i] = a[0]; hf[4 * i + 1] = a[1]; hf[4 * i + 2] = a[2]; hf[4 * i + 3] = a[3]; }
        const int id0 = IDX[(size_t)t * 128 + lane], id1 = IDX[(size_t)t * 128 + 64 + lane];
        const float g0 = GATE[(size_t)t * 128 + lane], g1 = GATE[(size_t)t * 128 + 64 + lane];
        float c0 = 0.f, c1 = 0.f;
        v4u A0[NR], B0[NR]; u32x2 A1[NR], B1[NR];
        P6F_LOAD(A0, A1, ED, 0);
#pragma unroll 1
        for (int e0 = 0; e0 < 128; e0 += 2 * NR) {
            P6F_LOAD(B0, B1, ED, e0 + NR);
            P6F_DOTS(A0, A1, e0);
            if (e0 + 2 * NR < 128) P6F_LOAD(A0, A1, ED, e0 + 2 * NR);
            P6F_DOTS(B0, B1, e0 + NR);
        }
        float y[32];
#pragma unroll
        for (int i = 0; i < 32; ++i) y[i] = 0.f;
        P6F_LOAD(A0, A1, EU, 0);
#pragma unroll 1
        for (int e0 = 0; e0 < 128; e0 += 2 * NR) {
            P6F_LOAD(B0, B1, EU, e0 + NR);
            P6F_AXPY(A0, A1, e0);
            if (e0 + 2 * NR < 128) P6F_LOAD(A0, A1, EU, e0 + 2 * NR);
            P6F_AXPY(B0, B1, e0 + NR);
        }
        float ss = 0.f; int l2 = lane; asm volatile("" : "+v"(l2));
#pragma unroll
        for (int i = 0; i < 8; ++i) { const f32x4 a = ((const f32x4*)hrow)[64 * i + l2];
            y[4 * i] += a[0]; y[4 * i + 1] += a[1]; y[4 * i + 2] += a[2]; y[4 * i + 3] += a[3];
            ss += (y[4 * i] * y[4 * i] + y[4 * i + 1] * y[4 * i + 1]) + (y[4 * i + 2] * y[4 * i + 2] + y[4 * i + 3] * y[4 * i + 3]); }
        const float rf = 1.0f / sqrtf(wave_sum(ss) * (1.0f / DM) + EPS);
#pragma unroll
        for (int i = 0; i < 8; ++i) { const f32x4 gf = ((const f32x4*)F.final_norm)[64 * i + l2];
            ((f32x4*)hrow)[64 * i + l2] = (f32x4){y[4 * i] * rf * gf[0], y[4 * i + 1] * rf * gf[1], y[4 * i + 2] * rf * gf[2], y[4 * i + 3] * rf * gf[3]}; }
    }
#undef P6F_LOAD
#undef P6F_DEC
#undef P6F_DOTS
#undef P6F_AXPY
}
constexpr size_t WS_U = WS_XB;
constexpr size_t WS_SSZ = 256 * 1024;
__device__ __forceinline__ void p0_experts_fp6s(Frame& F) {
    const int lane = F.lane; float* ESC = (float*)(F.ws + WS_ESC);
    for (int row = F.gw; row < 2 * NEXP; row += F.NGW) {
        const bool dn = row < NEXP; const int e = dn ? row : row - NEXP;
        const float* src = (dn ? F.e_down : F.e_up) + (size_t)e * DM;
        unsigned char* dst = F.ws + (dn ? WS_ED : WS_EU) + ((size_t)(lane >> 3) * NEXP + e) * 192;
        LAS f32x4* rs = (LAS f32x4*)(F.lds + F.wave * 16640);
#pragma unroll
        for (int i = 0; i < 8; ++i) { const int idx = 64 * i + lane; f32x4 a = __builtin_nontemporal_load((const f32x4*)src + idx); if (dn) a = a * ((const f32x4*)F.ffn_norm)[idx];
            rs[idx + (idx >> 3)] = a; }
        LDS_WAIT(); asm volatile("" ::: "memory");
        f32x4 v[8]; float am = 0.f;
#pragma unroll
        for (int i = 0; i < 8; ++i) { const int idx = 8 * lane + i; const f32x4 a = rs[idx + (idx >> 3)];
            v[i] = a; am = fmaxf(am, fmaxf(fmaxf(fabsf(a[0]), fabsf(a[1])), fmaxf(fabsf(a[2]), fabsf(a[3])))); }
        LDS_WAIT(); asm volatile("" ::: "memory");
        am = wave_max(am); if (!(am > 0.f)) am = 1.0f;
        const float sc = 7.5f / am;
        if (lane == 0) ESC[row] = am * (1.0f / 7.5f);
        f32x16 x, y;
#pragma unroll
        for (int k = 0; k < 16; ++k) { x[k] = v[k >> 1][2 * (k & 1)] * sc; y[k] = v[k >> 1][2 * (k & 1) + 1] * sc; }
        const u32x6 p = __builtin_amdgcn_cvt_scalef32_2xpk16_fp6_f32(x, y, 1.0f);
        const int s = lane & 7;
        *(U3*)(dst + 12 * s) = (U3){p[0], p[1], p[2]};
        *(U3*)(dst + 96 + 12 * s) = (U3){p[3], p[4], p[5]};
    }
}
__device__ __forceinline__ float g8_sum(float v) { v += dppf<0xB1>(v); v += dppf<0x4E>(v); v += dppf<0x141>(v); return v; }
#define P6S_LOADN(BA, BB, N_, TAB, IT0, IDA_, IDB_) do { _Pragma("unroll") for (int q_ = 0; q_ < (N_); ++q_) { const int it_ = (IT0) + q_; const int e_ = __shfl((it_ < 8) ? (IDA_) : (IDB_), gq + 8 * (it_ & 7)); \
        const unsigned char* rp_ = (TAB) + (size_t)e_ * 192; BA[q_] = *(const v4u*)(rp_ + 16 * s); BB[q_] = *(const u32x2*)(rp_ + 128 + 8 * s); } } while (0)
#define P6S_DEC(BA, BB, q_) __builtin_amdgcn_cvt_scalef32_pk32_f32_fp6((u32x6){BA[q_].x, BA[q_].y, BA[q_].z, BA[q_].w, BB[q_].x, BB[q_].y}, 1.0f)
__device__ __forceinline__ void p6a_down(Frame& F) {
    const int lane = F.lane, gq = lane >> 3, s = lane & 7, x = F.bid & 7, wsl = (F.bid >> 3) * NWAVES + F.wave, nws = (F.G >> 3) * NWAVES;
    const unsigned char* TAB = F.ws + WS_ED + (size_t)x * NEXP * 192;
    const int* IDX = (const int*)(F.ws + WS_IDX); const float* ssq = (const float*)(F.ws + WS_SSQ); float* U = (float*)(F.ws + WS_U) + (size_t)x * T * 128;
    int t = wsl; if (t >= T) return;
    f32x4 hc[8], hx[8]; float sq, sqn = 0.f, r2; int idA, idB, idAn = 0, idBn = 0;
#define P6A_FETCH(HH, SQ_, TT, IA_, IB_) do { const float* hr_ = F.out + (size_t)(TT) * DM; _Pragma("unroll") for (int i = 0; i < 8; ++i) HH[i] = ((const f32x4*)hr_)[64 * x + 8 * s + i]; \
        SQ_ = __hip_atomic_load(ssq + (TT), __ATOMIC_RELAXED, __HIP_MEMORY_SCOPE_AGENT); IA_ = IDX[(size_t)(TT) * 128 + lane]; IB_ = IDX[(size_t)(TT) * 128 + 64 + lane]; } while (0)
#define P6S_DOT1(BA, BB, q_, IT_) do { const f32x32 w_ = P6S_DEC(BA, BB, q_); float p0_ = 0.f, p1_ = 0.f; \
        _Pragma("unroll") for (int i = 0; i < 8; ++i) { p0_ += hc[i][0] * w_[4 * i]; p1_ += hc[i][1] * w_[4 * i + 1]; p0_ += hc[i][2] * w_[4 * i + 2]; p1_ += hc[i][3] * w_[4 * i + 3]; } \
        const float d_ = g8_sum(p0_ + p1_) * r2; if (s == 0) U[(size_t)t * 128 + gq + 8 * (IT_)] = d_; \
        __builtin_amdgcn_sched_barrier(0); } while (0)
#define P6S_DOTS(BA, BB, IT0) do { P6S_DOT1(BA, BB, 0, (IT0)); P6S_DOT1(BA, BB, 1, (IT0) + 1); P6S_DOT1(BA, BB, 2, (IT0) + 2); P6S_DOT1(BA, BB, 3, (IT0) + 3); } while (0)
    P6A_FETCH(hc, sq, t, idA, idB); r2 = 1.0f / sqrtf(sq * (1.0f / DM) + EPS);
    int tn = t + nws; if (tn < T) P6A_FETCH(hx, sqn, tn, idAn, idBn);
    v4u A0[4], B0[4]; u32x2 A1[4], B1[4];
    P6S_LOADN(A0, A1, 4, TAB, 0, idA, idB);
#pragma unroll 1
    for (;;) {
        P6S_LOADN(B0, B1, 4, TAB, 4, idA, idB); P6S_DOTS(A0, A1, 0);
        P6S_LOADN(A0, A1, 4, TAB, 8, idA, idB); P6S_DOTS(B0, B1, 4);
        P6S_LOADN(B0, B1, 4, TAB, 12, idA, idB); P6S_DOTS(A0, A1, 8);
        const bool more = tn < T;
        if (more) P6S_LOADN(A0, A1, 4, TAB, 0, idAn, idBn);
        P6S_DOTS(B0, B1, 12);
        if (!more) break;
        t = tn; idA = idAn; idB = idBn; r2 = 1.0f / sqrtf(sqn * (1.0f / DM) + EPS);
#pragma unroll
        for (int i = 0; i < 8; ++i) hc[i] = hx[i];
        tn += nws; if (tn < T) P6A_FETCH(hx, sqn, tn, idAn, idBn);
    }
#undef P6S_DOTS
#undef P6S_DOT1
#undef P6A_FETCH
}
__device__ __forceinline__ void p6b_up(Frame& F) {
    const int lane = F.lane, gq = lane >> 3, s = lane & 7, x = F.bid & 7, wsl = (F.bid >> 3) * NWAVES + F.wave, nws = (F.G >> 3) * NWAVES;
    const unsigned char* TAB = F.ws + WS_EU + (size_t)x * NEXP * 192;
    const int* IDX = (const int*)(F.ws + WS_IDX); const float* GATE = (const float*)(F.ws + WS_GATE); const float* ESC = (const float*)(F.ws + WS_ESC);
    const float* U = (const float*)(F.ws + WS_U); float* ssz = (float*)(F.ws + WS_SSZ);
    int t = wsl; if (t >= T) return;
    int idA, idB, idAn = 0, idBn = 0; float cA, cB, gAn = 0.f, gBn = 0.f, uAn = 0.f, uBn = 0.f, sdA = 0.f, sdB = 0.f, suA = 0.f, suB = 0.f; f32x4 h4, h4n = {0.f, 0.f, 0.f, 0.f};
    const size_t zoff = 256 * x + 32 * s + 4 * gq;
#define P6B_FETCH1(TT) do { idAn = IDX[(size_t)(TT) * 128 + lane]; idBn = IDX[(size_t)(TT) * 128 + 64 + lane]; gAn = GATE[(size_t)(TT) * 128 + lane]; gBn = GATE[(size_t)(TT) * 128 + 64 + lane]; \
        uAn = 0.f; uBn = 0.f; _Pragma("unroll") for (int xx = 0; xx < 8; ++xx) { uAn += U[((size_t)xx * T + (TT)) * 128 + lane]; uBn += U[((size_t)xx * T + (TT)) * 128 + 64 + lane]; } \
        h4n = *(const f32x4*)(F.out + (size_t)(TT) * DM + zoff); } while (0)
#define P6B_FETCH2() do { sdA = ESC[idAn]; sdB = ESC[idBn]; suA = ESC[NEXP + idAn]; suB = ESC[NEXP + idBn]; } while (0)
#define P6B_COEF() do { cA = gAn * gelu_erf(uAn * sdA) * suA; cB = gBn * gelu_erf(uBn * sdB) * suB; } while (0)
#define P6_PIN16(Y, B_) asm volatile("" : "+v"(Y[B_]), "+v"(Y[B_ + 1]), "+v"(Y[B_ + 2]), "+v"(Y[B_ + 3]), "+v"(Y[B_ + 4]), "+v"(Y[B_ + 5]), "+v"(Y[B_ + 6]), "+v"(Y[B_ + 7]), \
        "+v"(Y[B_ + 8]), "+v"(Y[B_ + 9]), "+v"(Y[B_ + 10]), "+v"(Y[B_ + 11]), "+v"(Y[B_ + 12]), "+v"(Y[B_ + 13]), "+v"(Y[B_ + 14]), "+v"(Y[B_ + 15]))
#define P6S_AXPY1(BA, BB, q_, IT_, NXT_) do { const float ce_ = __shfl(((IT_) < 8) ? cA : cB, gq + 8 * ((IT_) & 7)); \
        const f32x32 w_ = P6S_DEC(BA, BB, q_); _Pragma("unroll") for (int i = 0; i < 32; ++i) y[i] += ce_ * w_[i]; \
        P6_PIN16(y, 0); P6_PIN16(y, 16); asm volatile("" : "+v"(NXT_)); } while (0)
#define P6S_AXPY(BA, BB, IT0) do { P6S_AXPY1(BA, BB, 0, (IT0), BA[1].x); P6S_AXPY1(BA, BB, 1, (IT0) + 1, pin_); } while (0)
    P6B_FETCH1(t); P6B_FETCH2(); P6B_COEF(); idA = idAn; idB = idBn; h4 = h4n;
    int tn = t + nws; if (tn < T) P6B_FETCH1(tn);
    v4u A0[2], B0[2]; u32x2 A1[2], B1[2];
    P6S_LOADN(A0, A1, 2, TAB, 0, idA, idB);
    const bool b2 = (gq & 4) != 0, b1 = (gq & 2) != 0, b0 = (gq & 1) != 0; int pin_ = 0;
#pragma unroll 1
    for (;;) {
        float y[32];
#pragma unroll
        for (int i = 0; i < 32; ++i) y[i] = 0.f;
        const bool more = tn < T;
        P6S_LOADN(B0, B1, 2, TAB, 2, idA, idB); P6S_AXPY(A0, A1, 0);
        P6S_LOADN(A0, A1, 2, TAB, 4, idA, idB); P6S_AXPY(B0, B1, 2);
        if (more) P6B_FETCH2();
        P6S_LOADN(B0, B1, 2, TAB, 6, idA, idB); P6S_AXPY(A0, A1, 4);
        P6S_LOADN(A0, A1, 2, TAB, 8, idA, idB); P6S_AXPY(B0, B1, 6);
        P6S_LOADN(B0, B1, 2, TAB, 10, idA, idB); P6S_AXPY(A0, A1, 8);
        P6S_LOADN(A0, A1, 2, TAB, 12, idA, idB); P6S_AXPY(B0, B1, 10);
        P6S_LOADN(B0, B1, 2, TAB, 14, idA, idB); P6S_AXPY(A0, A1, 12);
        if (more) P6S_LOADN(A0, A1, 2, TAB, 0, idAn, idBn);
        P6S_AXPY(B0, B1, 14);
        float k16[16], k8[8], k4[4];
#pragma unroll
        for (int j = 0; j < 16; ++j) { const float keep = b2 ? y[16 + j] : y[j], send = b2 ? y[j] : y[16 + j]; k16[j] = keep + __shfl_xor(send, 32); }
#pragma unroll
        for (int j = 0; j < 8; ++j) { const float keep = b1 ? k16[8 + j] : k16[j], send = b1 ? k16[j] : k16[8 + j]; k8[j] = keep + __shfl_xor(send, 16); }
#pragma unroll
        for (int j = 0; j < 4; ++j) { const float keep = b0 ? k8[4 + j] : k8[j], send = b0 ? k8[j] : k8[4 + j]; k4[j] = keep + __shfl_xor(send, 8); }
        const f32x4 z = {h4[0] + k4[0], h4[1] + k4[1], h4[2] + k4[2], h4[3] + k4[3]};
        *(f32x4*)(F.out + (size_t)t * DM + zoff) = z;
        const float ss = wave_sum((z[0] * z[0] + z[1] * z[1]) + (z[2] * z[2] + z[3] * z[3]));
        if (lane == 0) atomicAdd(ssz + t, ss);
        if (!more) break;
        P6B_COEF(); t = tn; idA = idAn; idB = idBn; h4 = h4n;
        tn += nws; if (tn < T) P6B_FETCH1(tn);
    }
#undef P6B_FETCH1
#undef P6B_FETCH2
#undef P6B_COEF
#undef P6S_AXPY
#undef P6S_AXPY1
#undef P6_PIN16
}
#undef P6S_LOADN
#undef P6S_DEC
__device__ __forceinline__ void p6c_norm(Frame& F) {
    const int lane = F.lane; const float* ssz = (const float*)(F.ws + WS_SSZ);
    for (int t = F.gw; t < T; t += F.NGW) {
        f32x4* row = (f32x4*)(F.out + (size_t)t * DM);
        const float rf = 1.0f / sqrtf(__hip_atomic_load(ssz + t, __ATOMIC_RELAXED, __HIP_MEMORY_SCOPE_AGENT) * (1.0f / DM) + EPS);
#pragma unroll
        for (int i = 0; i < 8; ++i) row[64 * i + lane] = row[64 * i + lane] * rf * ((const f32x4*)F.final_norm)[64 * i + lane];
    }
}
__device__ __forceinline__ void p6_rot(Frame& F) {
    const int lane = opq(F.lane), gq = lane >> 3, s = lane & 7, x0 = F.bid & 7;
    const int* IDX = (const int*)(F.ws + WS_IDX); const float* GATE = (const float*)(F.ws + WS_GATE); const float* ESC = (const float*)(F.ws + WS_ESC); const float* ssq = (const float*)(F.ws + WS_SSQ);
    typedef _Float16 h16x4 __attribute__((ext_vector_type(4)));
    LAS unsigned char* wl = F.lds + F.wave * 19520;
    LAS _Float16* LZ = (LAS _Float16*)wl;
    LAS unsigned short* LID = (LAS unsigned short*)(wl + 16384);
    LAS float* LDOT = (LAS float*)(wl + 17408);
    LAS float* LSS = (LAS float*)(wl + 19456);
    const bf16* HB = (const bf16*)(F.ws + WS_AO);
#pragma unroll 1
    for (int tbase = F.gw; tbase < T; tbase += 4 * F.NGW) {
#pragma unroll
    for (int j = 0; j < 4; ++j) { const int t = tbase + F.NGW * j; const bool ok = t < T;
        LID[j * 128 + lane] = (unsigned short)(ok ? IDX[(size_t)t * 128 + lane] : 0); LID[j * 128 + 64 + lane] = (unsigned short)(ok ? IDX[(size_t)t * 128 + 64 + lane] : 0);
        LDOT[j * 128 + lane] = 0.f; LDOT[j * 128 + 64 + lane] = 0.f; if (lane == 0) LSS[j] = 0.f; }
    LDS_WAIT(); asm volatile("" ::: "memory");
#define P6R_LOAD(BA, BB, TAB, IT0) do { _Pragma("unroll") for (int q_ = 0; q_ < 4; ++q_) { const int it_ = (IT0) + q_; const int e_ = __shfl((it_ < 8) ? idA : idB, gq + 8 * (it_ & 7)); \
        const unsigned char* rp_ = (TAB) + (size_t)e_ * 192; BA[q_] = *(const U3*)(rp_ + 12 * s); BB[q_] = *(const U3*)(rp_ + 96 + 12 * s); } } while (0)
#define P6R_DEC(BA, BB, q_) __builtin_amdgcn_cvt_scalef32_pk32_f32_fp6((u32x6){BA[q_].a, BA[q_].b, BA[q_].c, BB[q_].a, BB[q_].b, BB[q_].c}, 1.0f)
    {
    typedef __bf16 b16x2 __attribute__((ext_vector_type(2)));
    typedef __bf16 b16x32 __attribute__((ext_vector_type(32)));
#pragma unroll 1
    for (int k = 0; k < 8; ++k) {
        const int x = (x0 + k) & 7; const unsigned char* TAB = F.ws + WS_ED + (size_t)x * NEXP * 192;
#pragma unroll 1
        for (int j = 0; j < 4; ++j) {
            const int t = tbase + F.NGW * j; if (t >= T) break;
            const bf16* hrow = HB + (size_t)t * DM + 256 * x + 32 * s;
            unsigned hh[16];
#pragma unroll
            for (int i = 0; i < 4; ++i) { const v4u a = ((const v4u*)hrow)[i]; hh[4 * i] = a.x; hh[4 * i + 1] = a.y; hh[4 * i + 2] = a.z; hh[4 * i + 3] = a.w; }
            const int idA = LID[j * 128 + lane], idB = LID[j * 128 + 64 + lane];
            U3 A0[4], B0[4], A1[4], B1[4];
#define P6R_DOTS(BA, BB, IT0) do { _Pragma("unroll") for (int q_ = 0; q_ < 4; ++q_) { \
        const b16x32 w_ = __builtin_amdgcn_cvt_scalef32_pk32_bf16_fp6((u32x6){BA[q_].a, BA[q_].b, BA[q_].c, BB[q_].a, BB[q_].b, BB[q_].c}, 1.0f); float p0_ = 0.f, p1_ = 0.f; \
        _Pragma("unroll") for (int i = 0; i < 8; ++i) { p0_ = __builtin_amdgcn_fdot2_f32_bf16((b16x2){w_[4 * i], w_[4 * i + 1]}, __builtin_bit_cast(b16x2, hh[2 * i]), p0_, false); p1_ = __builtin_amdgcn_fdot2_f32_bf16((b16x2){w_[4 * i + 2], w_[4 * i + 3]}, __builtin_bit_cast(b16x2, hh[2 * i + 1]), p1_, false); } \
        const float d_ = g8_sum(p0_ + p1_); if (s == 0) { LAS float* dp_ = LDOT + j * 128 + gq + 8 * ((IT0) + q_); *dp_ = *dp_ + d_; } \
        __builtin_amdgcn_sched_barrier(0); } } while (0)
            P6R_LOAD(A0, A1, TAB, 0);
            P6R_LOAD(B0, B1, TAB, 4); P6R_DOTS(A0, A1, 0);
            P6R_LOAD(A0, A1, TAB, 8); P6R_DOTS(B0, B1, 4);
            P6R_LOAD(B0, B1, TAB, 12); P6R_DOTS(A0, A1, 8);
            P6R_DOTS(B0, B1, 12);
#undef P6R_DOTS
        }
    }
    }
    LDS_WAIT(); asm volatile("" ::: "memory");
#pragma unroll 1
    for (int j = 0; j < 4; ++j) {
        const int t = tbase + F.NGW * j; if (t >= T) break;
        const float r2 = 1.0f / sqrtf(__hip_atomic_load(ssq + t, __ATOMIC_RELAXED, __HIP_MEMORY_SCOPE_AGENT) * (1.0f / DM) + EPS);
        const int idA = LID[j * 128 + lane], idB = LID[j * 128 + 64 + lane];
        const float cA = GATE[(size_t)t * 128 + lane] * gelu_erf(LDOT[j * 128 + lane] * r2 * ESC[idA]) * ESC[NEXP + idA];
        const float cB = GATE[(size_t)t * 128 + 64 + lane] * gelu_erf(LDOT[j * 128 + 64 + lane] * r2 * ESC[idB]) * ESC[NEXP + idB];
        LDOT[j * 128 + lane] = cA; LDOT[j * 128 + 64 + lane] = cB;
    }
    LDS_WAIT(); asm volatile("" ::: "memory");
    const bool b0 = (gq & 1) != 0; int pin_ = 0;
#pragma unroll 1
    for (int k = 0; k < 8; ++k) {
        const int x = (x0 + k) & 7; const unsigned char* TAB = F.ws + WS_EU + (size_t)x * NEXP * 192;
#pragma unroll 1
        for (int j = 0; j < 4; ++j) {
            const int t = tbase + F.NGW * j; if (t >= T) break;
            const f32x2 hq = *(const f32x2*)(HB + (size_t)t * DM + 256 * x + 32 * s + 4 * gq); const unsigned hq0 = __float_as_uint(hq.x), hq1 = __float_as_uint(hq.y);
            const f32x4 h4 = {bflo(hq0), bfhi(hq0), bflo(hq1), bfhi(hq1)};
            const int idA = LID[j * 128 + lane], idB = LID[j * 128 + 64 + lane];
            const float cA = LDOT[j * 128 + lane], cB = LDOT[j * 128 + 64 + lane];
            f32x2 y2[16];
#pragma unroll
            for (int i = 0; i < 16; ++i) y2[i] = (f32x2){0.f, 0.f};
            U3 A0[4], B0[4], A1[4], B1[4];
#define P6R_PIN16(Y, B_) asm volatile("" : "+v"(Y[B_]), "+v"(Y[B_ + 1]), "+v"(Y[B_ + 2]), "+v"(Y[B_ + 3]), "+v"(Y[B_ + 4]), "+v"(Y[B_ + 5]), "+v"(Y[B_ + 6]), "+v"(Y[B_ + 7]))
#define P6R_AXPY1(BA, BB, q_, IT_, NXT_) do { const float ce_ = __shfl(((IT_) < 8) ? cA : cB, gq + 8 * ((IT_) & 7)); \
        const f32x32 w_ = P6R_DEC(BA, BB, q_); const f32x2 ce2_ = {ce_, ce_}; _Pragma("unroll") for (int i = 0; i < 16; ++i) y2[i] = __builtin_elementwise_fma((f32x2){w_[2 * i], w_[2 * i + 1]}, ce2_, y2[i]); \
        P6R_PIN16(y2, 0); P6R_PIN16(y2, 8); asm volatile("" : "+v"(NXT_)); } while (0)
#define P6R_AXPY(BA, BB, IT0) do { P6R_AXPY1(BA, BB, 0, (IT0), BA[1].a); P6R_AXPY1(BA, BB, 1, (IT0) + 1, BA[2].a); P6R_AXPY1(BA, BB, 2, (IT0) + 2, BA[3].a); P6R_AXPY1(BA, BB, 3, (IT0) + 3, pin_); } while (0)
            P6R_LOAD(A0, A1, TAB, 0);
            P6R_LOAD(B0, B1, TAB, 4); P6R_AXPY(A0, A1, 0);
            P6R_LOAD(A0, A1, TAB, 8); P6R_AXPY(B0, B1, 4);
            P6R_LOAD(B0, B1, TAB, 12); P6R_AXPY(A0, A1, 8);
            P6R_AXPY(B0, B1, 12);
#undef P6R_AXPY
#undef P6R_AXPY1
#undef P6R_PIN16
            float y[32], k16[16], k8[8], k4[4];
#pragma unroll
            for (int i = 0; i < 16; ++i) { y[2 * i] = y2[i].x; y[2 * i + 1] = y2[i].y; }
#pragma unroll
            for (int i = 0; i < 16; ++i) { const auto r_ = __builtin_amdgcn_permlane32_swap(__float_as_uint(y[i]), __float_as_uint(y[16 + i]), false, false); k16[i] = __uint_as_float(r_[0]) + __uint_as_float(r_[1]); }
#pragma unroll
            for (int i = 0; i < 8; ++i) { const auto r_ = __builtin_amdgcn_permlane16_swap(__float_as_uint(k16[i]), __float_as_uint(k16[8 + i]), false, false); k8[i] = __uint_as_float(r_[0]) + __uint_as_float(r_[1]); }
#pragma unroll
            for (int i = 0; i < 4; ++i) { const float keep = b0 ? k8[4 + i] : k8[i], send = b0 ? k8[i] : k8[4 + i]; k4[i] = keep + dppf<0x128>(send); }
            const f32x4 z = {h4[0] + k4[0], h4[1] + k4[1], h4[2] + k4[2], h4[3] + k4[3]};
            *(LAS h16x4*)(LZ + j * 2048 + 256 * x + 32 * s + 4 * gq) = (h16x4){(_Float16)z[0], (_Float16)z[1], (_Float16)z[2], (_Float16)z[3]};
            const float ss = wave_sum_fast((z[0] * z[0] + z[1] * z[1]) + (z[2] * z[2] + z[3] * z[3]));
            if (lane == 0) LSS[j] = LSS[j] + ss;
        }
    }
#undef P6R_LOAD
#undef P6R_DEC
    LDS_WAIT(); asm volatile("" ::: "memory");
#pragma unroll 1
    for (int j = 0; j < 4; ++j) {
        const int t = tbase + F.NGW * j; if (t >= T) break;
        f32x4* row = (f32x4*)(F.out + (size_t)t * DM);
        const float rf = 1.0f / sqrtf(LSS[j] * (1.0f / DM) + EPS);
#pragma unroll
        for (int i = 0; i < 8; ++i) { const h16x4 zv = *(const LAS h16x4*)(LZ + j * 2048 + 256 * i + 4 * lane); const f32x4 w = ((const f32x4*)F.final_norm)[64 * i + lane];
            row[64 * i + lane] = (f32x4){(float)zv[0] * rf * w[0], (float)zv[1] * rf * w[1], (float)zv[2] * rf * w[2], (float)zv[3] * rf * w[3]}; }
    }
    asm volatile("s_waitcnt vmcnt(0) lgkmcnt(0)" ::: "memory");
    }
}
typedef unsigned gu32;
#define XB_TMO      128
#define XB_XCNT(j)  (256  + 64 * (j))
#define XB_XSUB(j)  (1280 + 64 * (j))
#define XB_XGEN(j)  (2304 + 64 * (j))
#define XB_TOP      3328
#define XB_TOPGEN   3392
#define XCD_BAR_WORDS 3456
#define XB_SPIN_CAP (1u << 18)

__device__ __forceinline__ unsigned xb_ld(unsigned* p)              { return __hip_atomic_load(p, __ATOMIC_RELAXED, __HIP_MEMORY_SCOPE_AGENT); }
__device__ __forceinline__ unsigned xb_add(unsigned* p, unsigned v) { return __hip_atomic_fetch_add(p, v, __ATOMIC_RELAXED, __HIP_MEMORY_SCOPE_AGENT); }
__device__ __forceinline__ unsigned xb_xcc_id() { return (unsigned)__builtin_amdgcn_s_getreg((3 << 11) | 20) & 0xFu; }
#define XB_SPIN(cond, bar) do { unsigned _sp = 0; while (cond) { __builtin_amdgcn_s_sleep(1); \
    if ((++_sp & 255u) == 0u) { if (xb_ld(&(bar)[XB_TMO])) break; if (_sp > XB_SPIN_CAP) { atomicAdd(&(bar)[XB_TMO], 1u); break; } } } } while (0)

struct XcdBarrier {
    unsigned* bar; unsigned x;
    volatile LAS unsigned* st;
};

__device__ __forceinline__ XcdBarrier xcd_barrier_post(unsigned* bar, volatile LAS unsigned* st) {
    XcdBarrier b; b.bar = bar; b.x = xb_xcc_id(); b.st = st;
    if (threadIdx.x == 0) (void)xb_add(&bar[XB_XCNT(b.x)], 1u);
    return b;
}
__device__ __forceinline__ void xcd_barrier_complete(unsigned* bar, unsigned x, unsigned& nloc, unsigned& nx) {
    const unsigned G = gridDim.x * gridDim.y * gridDim.z;
    unsigned sum, cnt, mine, sp = 0u;
    for (;;) {
        sum = 0u; cnt = 0u; mine = 0u;
#pragma unroll
        for (unsigned j = 0; j < 16; ++j) { const unsigned c = xb_ld(&bar[XB_XCNT(j)]); sum += c; cnt += (c > 0u) ? 1u : 0u; mine = (j == x) ? c : mine; }
        if (sum == G) break;
        __builtin_amdgcn_s_sleep(1);
        if ((++sp & 255u) == 0u) { if (xb_ld(&bar[XB_TMO])) break; if (sp > XB_SPIN_CAP) { atomicAdd(&bar[XB_TMO], 1u); break; } }
    }
    nloc = mine > 0u ? mine : 1u; nx = cnt > 0u ? cnt : 1u;
}

__device__ __forceinline__ void xcd_barrier(const XcdBarrier& b) {
    asm volatile("s_waitcnt vmcnt(0)" ::: "memory");
    __syncthreads();
    if (threadIdx.x == 0) {
        unsigned* bar = b.bar;
        __builtin_amdgcn_s_waitcnt(0);
        unsigned nloc = b.st[0], nx = b.st[1];
        if (nloc == 0u) { xcd_barrier_complete(bar, b.x, nloc, nx); b.st[0] = nloc; b.st[1] = nx; }
        const unsigned old = xb_add(&bar[XB_XSUB(b.x)], 1u);
        const unsigned gen = old / nloc;
        if (old + 1u == (gen + 1u) * nloc) {
            __builtin_amdgcn_fence(__ATOMIC_RELEASE, "agent");
            asm volatile("s_waitcnt vmcnt(0)" ::: "memory");
            const unsigned og = xb_add(&bar[XB_TOP], 1u);
            const unsigned tg = og / nx;
            if (og + 1u == (tg + 1u) * nx) xb_add(&bar[XB_TOPGEN], 1u);
            else XB_SPIN(xb_ld(&bar[XB_TOPGEN]) == tg, bar);
            __builtin_amdgcn_fence(__ATOMIC_ACQUIRE, "agent");
            xb_add(&bar[XB_XGEN(b.x)], 1u);
            asm volatile("s_waitcnt vmcnt(0)" ::: "memory");
        } else {
            XB_SPIN(xb_ld(&bar[XB_XGEN(b.x)]) == gen, bar);
            __builtin_amdgcn_fence(__ATOMIC_ACQUIRE, "agent");
            asm volatile("s_waitcnt vmcnt(0)" ::: "memory");
        }
    }
    __syncthreads();
}

constexpr int NPH = 10;
struct Args { const float* in[13]; float* out; unsigned char* ws; int ph_lo, ph_hi; };
__global__ void __launch_bounds__(NWAVES * 64, 2) mk_fwd(Args a) {
    extern __shared__ __attribute__((aligned(16))) unsigned char lds[];
    cg::grid_group grid = cg::this_grid();
    Frame F;
    F.lds = (LAS unsigned char*)lds; F.tid = threadIdx.x; F.lane = F.tid & 63; F.wave = __builtin_amdgcn_readfirstlane(F.tid >> 6);
    F.G = gridDim.x; F.bid = blockIdx.x; F.gw = F.bid * NWAVES + F.wave; F.NGW = F.G * NWAVES;
    F.x = a.in[0]; F.attn_norm = a.in[1]; F.w_in = a.in[2]; F.sinks = a.in[3]; F.w_attn = a.in[4]; F.w_ret = a.in[5]; F.w_out = a.in[6]; F.ffn_norm = a.in[7];
    F.w_q = a.in[8]; F.sub_keys = a.in[9]; F.e_down = a.in[10]; F.e_up = a.in[11]; F.final_norm = a.in[12]; F.out = a.out; F.ws = a.ws;
    unsigned char* ws = a.ws;
    const int lo = a.ph_lo, hi = a.ph_hi;
#define IN(k) (lo <= (k) && (k) < hi)
    volatile LAS unsigned* MISC = (volatile LAS unsigned*)(F.lds + LDS_BYTES - 256);
    if (F.tid < 32) MISC[F.tid] = 0u;
    __syncthreads();
    XcdBarrier xbar = xcd_barrier_post((unsigned*)(ws + 16384), MISC + 8);
#define SEAM(k) do { if (IN(k) && IN((k) + 1)) { if (lo < 0) grid.sync(); else xcd_barrier(xbar); } } while (0)
    pg8::bf16_t* PROJ = (pg8::bf16_t*)(ws + WS_PROJ);
    float* KV = F.out;
    if (IN(0)) { p0_prologue(F); if (PEER_FP8 == 1) p0_experts_fp8(F); if (PEER_FP8 == 2) p0_experts_fp6(F); if (PEER_FP8 == 3) p0_experts_fp6s(F); }
    SEAM(0);
    if (IN(1)) {
        pg8::Gemm g{(const pg8::bf16_t*)(ws + WS_XB), (const pg8::bf16_t*)(ws + WS_WIN), T, NPROJ, GEMM1_FP8 ? DM / 2 : DM}; pg8::StaticOrder S; S.init(T, NPROJ, F.G, F.bid);
        pg8::EpiProj E{PROJ, (const float*)(ws + WS_R1), (const pg8::f32x4*)(ws + WS_ROPE), GEMM1_FP8 ? 1.0f / (G1_XS * G1_WS) : 0.0f};
        pg8::gemm_phase<pg8::EpiProj, pg8::StaticOrder, true, true, (GEMM1_FP8 != 0)>(F.lds, g, S, E);
    }
    SEAM(1);
    if (IN(2)) { p2_attn_mfma(F); p2_kv_mfma(F, KV); }
    SEAM(2);
    if (IN(3)) p2_scan(F, KV);
    SEAM(3);
    if (IN(4)) p2_retout_mfma(F, KV);
    SEAM(4);
    if (IN(5)) {
        constexpr float p3fix = P3_FP8 ? 1.0f / (P3_AS * G1_WS) : 1.0f;
        { pg8::Gemm g{(const pg8::bf16_t*)(ws + WS_AO), (const pg8::bf16_t*)(ws + WS_WA), T, DM, P3_FP8 ? 512 : 1024}; pg8::StaticOrder S; S.init(T, DM, F.G, F.bid);
          pg8::EpiGate1 E{(pg8::bf16_t*)F.out, PROJ, C_GA, p3fix};
          pg8::gemm_phase<pg8::EpiGate1, pg8::StaticOrder, true, true, (P3_FP8 != 0)>(F.lds, g, S, E); }
        { pg8::Gemm g{(const pg8::bf16_t*)(ws + WS_RO), (const pg8::bf16_t*)(ws + WS_WR), T, DM, P3_FP8 ? DM / 2 : DM}; pg8::StaticOrder S; S.init(T, DM, F.G, F.bid);
          pg8::EpiGate2 E{(const pg8::bf16_t*)F.out, PROJ, C_GT, (pg8::bf16_t*)(ws + WS_XB), p3fix, P4_FP8 ? P3_AS : 0.0f};
          pg8::gemm_phase<pg8::EpiGate2, pg8::StaticOrder, true, true, (P3_FP8 != 0)>(F.lds, g, S, E); }
    }
    SEAM(5);
    if (IN(6)) {
        pg8::Gemm g{(const pg8::bf16_t*)(ws + WS_XB), (const pg8::bf16_t*)(ws + WS_WO), T, DM, P4_FP8 ? DM / 2 : DM}; pg8::StaticOrder S; S.init(T, DM, F.G, F.bid);
        pg8::EpiHres E{F.x, (pg8::bf16_t*)(ws + WS_AO), (float*)(ws + WS_SSQ), P4_FP8 ? 1.0f / (P3_AS * G1_WS) : 1.0f};
        pg8::gemm_phase<pg8::EpiHres, pg8::StaticOrder, true, true, (P4_FP8 != 0)>(F.lds, g, S, E);
    }
    SEAM(6);
    if (IN(7)) {
        pg8::Gemm g{(const pg8::bf16_t*)(ws + WS_AO), (const pg8::bf16_t*)(ws + WS_WQ), T, DM, DM}; pg8::StaticOrder S; S.init(T, DM, F.G, F.bid);
        pg8::EpiQry E{PROJ, (const float*)(ws + WS_SSQ)};
        pg8::gemm_phase<pg8::EpiQry, pg8::StaticOrder, true, true>(F.lds, g, S, E);
        asm volatile("s_waitcnt vmcnt(0)" ::: "memory"); __syncthreads();
        __builtin_amdgcn_fence(__ATOMIC_ACQUIRE, "agent"); asm volatile("s_waitcnt vmcnt(0)" ::: "memory"); __syncthreads();
        pg8::Unit uu; for (int i = 0; S.next(i, uu); ++i) p5_topk_v2(F, uu.pm, uu.pn);
    }
    SEAM(8);
    if (PEER_FP8 == 3) {
        if (IN(9)) p6_rot(F);
    } else {
        if (IN(9)) { if (PEER_FP8 == 2) p6_peer_fp6(F); else p6_peer2<(PEER_FP8 == 1)>(F); }
    }
#undef IN
#undef SEAM
}
}

#ifndef MK_N_LAUNCHES
#define MK_N_LAUNCHES 1
#endif
extern "C" void kernel_launch(void* const* d_in, const int* in_sizes, int n_in, void* d_out, int out_size, void* d_ws, size_t ws_size, hipStream_t stream) {
    using namespace mk;
    static int grid = 0;
    if (grid == 0) {
        if (n_in != 13 || out_size != T * DM || ws_size < WS_END) { fprintf(stderr, "kernel_launch: unexpected problem (n_in %d, out %d, ws %zu)\n", n_in, out_size, ws_size); grid = -1; return; }
        int dev = 0, cus = 0, per_cu = 0;
        if (hipGetDevice(&dev) != hipSuccess || hipDeviceGetAttribute(&cus, hipDeviceAttributeMultiprocessorCount, dev) != hipSuccess) { grid = -1; return; }
        if (hipFuncSetAttribute((const void*)mk_fwd, hipFuncAttributeMaxDynamicSharedMemorySize, LDS_BYTES) != hipSuccess) { fprintf(stderr, "kernel_launch: hipFuncSetAttribute failed\n"); grid = -1; return; }
        if (hipOccupancyMaxActiveBlocksPerMultiprocessor(&per_cu, (const void*)mk_fwd, NWAVES * 64, LDS_BYTES) != hipSuccess || per_cu < 1) { fprintf(stderr, "kernel_launch: occupancy query says %d\n", per_cu); per_cu = 1; }
        (void)hipGetLastError();
        grid = cus * (per_cu < 1 ? 1 : per_cu);
        if (grid > 256) grid = 256;
    }
    if (grid < 0) return;
    (void)hipMemsetAsync((char*)d_ws + WS_CTL, 0, CTL_BYTES, stream);
    Args a{};
    for (int i = 0; i < 13; ++i) a.in[i] = (const float*)d_in[i];
    a.out = (float*)d_out; a.ws = (unsigned char*)d_ws;
#if MK_N_LAUNCHES == 1
    a.ph_lo = 0; a.ph_hi = NPH;
    void* args[] = {&a};
    hipError_t e = hipLaunchCooperativeKernel((const void*)mk_fwd, dim3(grid), dim3(NWAVES * 64), args, LDS_BYTES, stream);
    if (e != hipSuccess) fprintf(stderr, "kernel_launch: cooperative launch failed: %s (grid %d)\n", hipGetErrorString(e), grid);
#else
    for (int ph = 0; ph < NPH; ++ph) { a.ph_lo = ph; a.ph_hi = ph + 1; hipLaunchKernelGGL(mk_fwd, dim3(grid), dim3(NWAVES * 64), LDS_BYTES, stream, a); }
#endif
}
```

```cpp
#include <hip/hip_runtime.h>
#include <hip/hip_cooperative_groups.h>
#include <cstdio>
#include <cstdint>
namespace cg = cooperative_groups;
namespace pg8 {
#define PG8_LAS __attribute__((address_space(3)))
typedef unsigned short bf16_t;
typedef short bf16x8 __attribute__((ext_vector_type(8)));
typedef float f32x4 __attribute__((ext_vector_type(4)));
typedef unsigned u32x4 __attribute__((ext_vector_type(4)));
typedef int i32x4_t __attribute__((ext_vector_type(4)));
typedef int i32x8_t __attribute__((ext_vector_type(8)));
constexpr int BM = 256, BK = 64, HALF = 128, HTB = HALF * BK * 2  , STAGE_BYTES = 8 * HTB, NXCD = 8, WGM = 8;

__host__ __device__ __forceinline__ int lds_byte(int r, int c) { const int st = (r >> 4) * 2 + (c >> 5), rr = r & 15, cc = c & 31, ob = rr * 64 + cc * 2; return st * 1024 + (ob ^ (((ob >> 9) & 1) << 5)); }
__host__ __device__ __forceinline__ void stage_rc(int b, int& R, int& C) { const int st = b / 1024, sb = b % 1024, swz = sb ^ (((sb >> 9) & 1) << 5); R = (st >> 1) * 16 + swz / 64; C = (st & 1) * 32 + (swz % 64) / 2; }
__host__ __device__ __forceinline__ int perm32(int rho) { const int n = rho >> 4, i = rho & 15; return 8 * (i >> 2) + 4 * n + (i & 3); }

struct Unit { int pm, pn; };
struct Gemm { const bf16_t* A; const bf16_t* Bt; int M, N, K; };

struct StaticOrder {
    int nM, nN, nwg, G, c;
    __host__ __device__ void init(int M, int N, int G_, int c_) { nM = M / BM; nN = N / BM; nwg = nM * nN; G = G_; c = c_; }
    __host__ __device__ __forceinline__ bool next(int i, Unit& u) const {
        const long L = (long)i * G + c; if (L >= nwg) return false;
        int wgid = (int)L; { const int q = nwg / NXCD, r = nwg % NXCD, xcd = wgid % NXCD, off = wgid / NXCD; wgid = (xcd < r ? xcd * (q + 1) : r * (q + 1) + (xcd - r) * q) + off; }
        const int nig = WGM * nN, gid = wgid / nig, fm = gid * WGM, gsz = (nM - fm) < WGM ? (nM - fm) : WGM;
        u.pm = fm + ((wgid % nig) % gsz); u.pn = (wgid % nig) / gsz; return true;
    }
    __device__ __forceinline__ void a_ready(const Unit&) const {}
    __device__ __forceinline__ void done(const Unit&) const {}
};

__device__ __forceinline__ unsigned cvt_pk_bf16(float lo, float hi) { unsigned r; asm volatile("v_cvt_pk_bf16_f32 %0, %1, %2" : "=v"(r) : "v"(lo), "v"(hi)); return r; }
typedef float f32x2 __attribute__((ext_vector_type(2)));
__device__ __forceinline__ f32x2 gelu_pk(f32x2 v) {
    const f32x2 av = __builtin_elementwise_abs(v), d = av * 0.2316418882f + 1.0f;
    f32x2 t; t.x = __builtin_amdgcn_rcpf(d.x); t.y = __builtin_amdgcn_rcpf(d.y);
    f32x2 q = t * 0.5307027145f + (-0.7265760135f); q = q * t + 0.7107068705f; q = q * t + (-0.142248368f); q = q * t + 0.127414796f; q = q * t;
    const f32x2 s = (v * v) * (-0.72134752044f);
    f32x2 e; e.x = __builtin_amdgcn_exp2f(s.x); e.y = __builtin_amdgcn_exp2f(s.y);
    const f32x2 m = v * (q * e), r = v - m;
    f32x2 o; o.x = v.x < 0.f ? m.x : r.x; o.y = v.y < 0.f ? m.y : r.y; return o;
}

constexpr float QA_SCALE = 0.08838834764831845f * 1.4426950408889634f;
constexpr float KR_SCALE = 0.08838834764831845f;
constexpr int NPROJ = 11776;
__device__ __forceinline__ f32x4 rope4(f32x4 v, f32x4 cs) {
    f32x4 o; o[0] = v[0] * cs[0] - v[1] * cs[1]; o[1] = v[1] * cs[0] + v[0] * cs[1]; o[2] = v[2] * cs[2] - v[3] * cs[3]; o[3] = v[3] * cs[2] + v[2] * cs[3]; return o;
}
__device__ __forceinline__ float sigm(float x) { return __builtin_amdgcn_rcpf(1.0f + __builtin_amdgcn_exp2f(x * -1.4426950408889634f)); }
struct EpiProj {
    static constexpr bool PERM = true, AFTER_DRAIN = false;
    bf16_t* O; const float* r1; const f32x4* rope; float fixed;
    __device__ __forceinline__ void operator()(const f32x4 (&acc)[2][2][4][2], const Unit& u, int wr, int wc, int fr, int fq) const {
        asm volatile("" : "+v"(fr), "+v"(fq));
        const int colt = u.pn * BM;
        int mode; float sc = 1.f;
        if (colt < 1024) { mode = 1; sc = QA_SCALE; } else if (colt < 1280) mode = 1; else if (colt < 1536) mode = 0;
        else if (colt < 2560) mode = 1; else if (colt < 3584) { mode = 1; sc = KR_SCALE; } else if (colt < 5632) mode = 0;
        else if (colt < 7680) mode = 2; else mode = 3;
        const int row0 = u.pm * BM + wr * 64 + fr, col0 = colt + wc * 32 + 8 * fq;
        float rsv[2][4];
#pragma unroll
        for (int ai = 0; ai < 2; ++ai)
#pragma unroll
            for (int m = 0; m < 4; ++m) rsv[ai][m] = (fixed != 0.f) ? fixed : r1[row0 + ai * HALF + m * 16];
#pragma unroll
        for (int ai = 0; ai < 2; ++ai)
#pragma unroll
            for (int m = 0; m < 4; ++m) {
                const int row = row0 + ai * HALF + m * 16; const float rs = rsv[ai][m] * sc;
                bf16_t* rowp = O + (size_t)row * NPROJ + col0;
                f32x4 cs0 = {1.f, 0.f, 1.f, 0.f}, cs1 = {1.f, 0.f, 1.f, 0.f};
                if (mode == 1) { const f32x4* rp = rope + (size_t)(row & 4095) * 32 + 8 * wc + 2 * fq; cs0 = rp[0]; cs1 = rp[1]; }
#pragma unroll
                for (int bj = 0; bj < 2; ++bj) {
                    f32x4 v0 = acc[ai][bj][m][0] * rs, v1 = acc[ai][bj][m][1] * rs;
                    if (mode == 1) { v0 = rope4(v0, cs0); v1 = rope4(v1, cs1); }
                    else if (mode == 2) {
#pragma unroll
                        for (int i = 0; i < 4; ++i) { v0[i] = v0[i] * sigm(v0[i]); v1[i] = v1[i] * sigm(v1[i]); } }
                    else if (mode == 3) {
#pragma unroll
                        for (int i = 0; i < 4; ++i) { v0[i] = sigm(v0[i]); v1[i] = sigm(v1[i]); } }
                    u32x4 w; w.x = cvt_pk_bf16(v0[0], v0[1]); w.y = cvt_pk_bf16(v0[2], v0[3]); w.z = cvt_pk_bf16(v1[0], v1[1]); w.w = cvt_pk_bf16(v1[2], v1[3]);
                    *(u32x4*)(rowp + bj * HALF) = w; }
            }
    }
};
__device__ __forceinline__ float bf_lo(unsigned u) { return __uint_as_float(u << 16); }
__device__ __forceinline__ float bf_hi(unsigned u) { return __uint_as_float(u & 0xffff0000u); }
struct EpiGate1 {
    static constexpr bool PERM = true, AFTER_DRAIN = false;
    bf16_t* TMP; const bf16_t* G; int gcol; float fixed;
    __device__ __forceinline__ void operator()(const f32x4 (&acc)[2][2][4][2], const Unit& u, int wr, int wc, int fr, int fq) const {
        const int row0 = u.pm * BM + wr * 64 + fr, col0 = u.pn * BM + wc * 32 + 8 * fq;
#pragma unroll
        for (int ai = 0; ai < 2; ++ai)
#pragma unroll
            for (int m = 0; m < 4; ++m) { const int row = row0 + ai * HALF + m * 16;
#pragma unroll
                for (int bj = 0; bj < 2; ++bj) { const int col = col0 + bj * HALF;
                    const u32x4 g = *(const u32x4*)(G + (size_t)row * NPROJ + gcol + col);
                    f32x4 v0 = acc[ai][bj][m][0] * fixed, v1 = acc[ai][bj][m][1] * fixed;
                    v0[0] *= bf_lo(g.x); v0[1] *= bf_hi(g.x); v0[2] *= bf_lo(g.y); v0[3] *= bf_hi(g.y);
                    v1[0] *= bf_lo(g.z); v1[1] *= bf_hi(g.z); v1[2] *= bf_lo(g.w); v1[3] *= bf_hi(g.w);
                    u32x4 w; w.x = cvt_pk_bf16(v0[0], v0[1]); w.y = cvt_pk_bf16(v0[2], v0[3]); w.z = cvt_pk_bf16(v1[0], v1[1]); w.w = cvt_pk_bf16(v1[2], v1[3]);
                    *(u32x4*)(TMP + (size_t)row * 2048 + col) = w; } }
    }
};
struct EpiGate2 {
    static constexpr bool PERM = true, AFTER_DRAIN = false;
    const bf16_t* TMP; const bf16_t* G; int gcol; bf16_t* MG; float fixed; float out8;
    __device__ __forceinline__ void operator()(const f32x4 (&acc)[2][2][4][2], const Unit& u, int wr, int wc, int fr, int fq) const {
        const int row0 = u.pm * BM + wr * 64 + fr, col0 = u.pn * BM + wc * 32 + 8 * fq;
#pragma unroll
        for (int ai = 0; ai < 2; ++ai)
#pragma unroll
            for (int m = 0; m < 4; ++m) { const int row = row0 + ai * HALF + m * 16;
#pragma unroll
                for (int bj = 0; bj < 2; ++bj) { const int col = col0 + bj * HALF;
                    const u32x4 g = *(const u32x4*)(G + (size_t)row * NPROJ + gcol + col);
                    const u32x4 tq = *(const u32x4*)(TMP + (size_t)row * 2048 + col); const f32x4 t0 = {bf_lo(tq.x), bf_hi(tq.x), bf_lo(tq.y), bf_hi(tq.y)}, t1 = {bf_lo(tq.z), bf_hi(tq.z), bf_lo(tq.w), bf_hi(tq.w)};
                    f32x4 v0 = acc[ai][bj][m][0] * fixed, v1 = acc[ai][bj][m][1] * fixed;
                    v0[0] = t0[0] + v0[0] * bf_lo(g.x); v0[1] = t0[1] + v0[1] * bf_hi(g.x); v0[2] = t0[2] + v0[2] * bf_lo(g.y); v0[3] = t0[3] + v0[3] * bf_hi(g.y);
                    v1[0] = t1[0] + v1[0] * bf_lo(g.z); v1[1] = t1[1] + v1[1] * bf_hi(g.z); v1[2] = t1[2] + v1[2] * bf_lo(g.w); v1[3] = t1[3] + v1[3] * bf_hi(g.w);
                    if (out8 != 0.f) { v0 = v0 * out8; v1 = v1 * out8;
#pragma unroll
                        for (int i = 0; i < 4; ++i) { v0[i] = fminf(fmaxf(v0[i], -448.f), 448.f); v1[i] = fminf(fmaxf(v1[i], -448.f), 448.f); }
                        int p0 = 0, p1 = 0; p0 = __builtin_amdgcn_cvt_pk_fp8_f32(v0[0], v0[1], p0, false); p0 = __builtin_amdgcn_cvt_pk_fp8_f32(v0[2], v0[3], p0, true);
                        p1 = __builtin_amdgcn_cvt_pk_fp8_f32(v1[0], v1[1], p1, false); p1 = __builtin_amdgcn_cvt_pk_fp8_f32(v1[2], v1[3], p1, true);
                        f32x2 o; o.x = __builtin_bit_cast(float, p0); o.y = __builtin_bit_cast(float, p1); *(f32x2*)((unsigned char*)MG + (size_t)row * 2048 + col) = o; }
                    else { u32x4 w; w.x = cvt_pk_bf16(v0[0], v0[1]); w.y = cvt_pk_bf16(v0[2], v0[3]); w.z = cvt_pk_bf16(v1[0], v1[1]); w.w = cvt_pk_bf16(v1[2], v1[3]);
                    *(u32x4*)(MG + (size_t)row * 2048 + col) = w; } } }
    }
};
struct EpiHres {
    static constexpr bool PERM = true, AFTER_DRAIN = false;
    const float* X; bf16_t* Hb; float* ssq; float fixed;
    __device__ __forceinline__ void operator()(const f32x4 (&acc)[2][2][4][2], const Unit& u, int wr, int wc, int fr, int fq) const {
        const int row0 = u.pm * BM + wr * 64 + fr, col0 = u.pn * BM + wc * 32 + 8 * fq;
#pragma unroll
        for (int ai = 0; ai < 2; ++ai)
#pragma unroll
            for (int m = 0; m < 4; ++m) { const int row = row0 + ai * HALF + m * 16; float ss = 0.f;
#pragma unroll
                for (int bj = 0; bj < 2; ++bj) { const size_t off = (size_t)row * 2048 + col0 + bj * HALF;
                    const f32x4 x0 = *(const f32x4*)(X + off), x1 = *(const f32x4*)(X + off + 4);
                    const f32x4 v0 = acc[ai][bj][m][0] * fixed + x0, v1 = acc[ai][bj][m][1] * fixed + x1;
                    u32x4 w; w.x = cvt_pk_bf16(v0[0], v0[1]); w.y = cvt_pk_bf16(v0[2], v0[3]); w.z = cvt_pk_bf16(v1[0], v1[1]); w.w = cvt_pk_bf16(v1[2], v1[3]);
                    *(u32x4*)(Hb + off) = w;
                    ss += (v0[0] * v0[0] + v0[1] * v0[1]) + (v0[2] * v0[2] + v0[3] * v0[3]) + (v1[0] * v1[0] + v1[1] * v1[1]) + (v1[2] * v1[2] + v1[3] * v1[3]); }
                ss += __shfl_xor(ss, 16); ss += __shfl_xor(ss, 32);
                if (fq == 0) atomicAdd(ssq + row, ss); }
    }
};
struct EpiQry {
    static constexpr bool PERM = true, AFTER_DRAIN = false;
    bf16_t* Q; const float* ssq;
    __device__ __forceinline__ void operator()(const f32x4 (&acc)[2][2][4][2], const Unit& u, int wr, int wc, int fr, int fq) const {
        const int row0 = u.pm * BM + wr * 64 + fr, col0 = u.pn * BM + wc * 32 + 8 * fq;
#pragma unroll
        for (int ai = 0; ai < 2; ++ai)
#pragma unroll
            for (int m = 0; m < 4; ++m) { const int row = row0 + ai * HALF + m * 16;
                const float rs = 1.0f / sqrtf(__hip_atomic_load(ssq + row, __ATOMIC_RELAXED, __HIP_MEMORY_SCOPE_AGENT) * (1.0f / 2048.0f) + 1e-6f);
#pragma unroll
                for (int bj = 0; bj < 2; ++bj) { const f32x4 v0 = acc[ai][bj][m][0] * rs, v1 = acc[ai][bj][m][1] * rs;
                    u32x4 w; w.x = cvt_pk_bf16(v0[0], v0[1]); w.y = cvt_pk_bf16(v0[2], v0[3]); w.z = cvt_pk_bf16(v1[0], v1[1]); w.w = cvt_pk_bf16(v1[2], v1[3]);
                    *(u32x4*)(Q + (size_t)row * 2048 + col0 + bj * HALF) = w; } }
    }
};

template <class Epi, class Sched, bool ALIGN_EPI = false, bool SP2 = false, bool FP8 = false>
__device__ __forceinline__ void gemm_phase(PG8_LAS unsigned char* lds, const Gemm g, const Sched& S, const Epi& E) {
    const int tid = threadIdx.x, wid = __builtin_amdgcn_readfirstlane(tid >> 6), lane = tid & 63, wr = wid >> 2, wc = wid & 3, fr = lane & 15, fq = lane >> 4;
    const int K = g.K, nt = K / BK;
    unsigned voffA[2], voffB[2];
#pragma unroll
    for (int i = 0; i < 2; ++i) { int R, C; stage_rc(tid * 16 + i * 8192, R, C); const int Rb = Epi::PERM ? ((R & ~31) + perm32(R & 31)) : R;
        voffA[i] = (unsigned)(R * K + C) * 2u; voffB[i] = (unsigned)(Rb * K + C) * 2u; }
    const size_t kstep = (size_t)(BK * 2);
    const size_t hstep = (size_t)HALF * K * 2;
    const size_t tstep = 2 * hstep;
    const unsigned ldsw = (unsigned)wid * 1024u;
    const int aoff = lds_byte(wr * 64 + fr, fq * 8), boff = lds_byte(wc * 32 + fr, fq * 8);
#define PG8_SA(b, h) (((b) * 2 + (h)) * HTB)
#define PG8_SB(b, h) ((4 + (b) * 2 + (h)) * HTB)
#define PG8_STAGE(bufoff, gbase, voff) do { _Pragma("unroll") for (int _i = 0; _i < 2; ++_i) \
        __builtin_amdgcn_global_load_lds((const unsigned*)((const char*)(gbase) + (voff)[_i]), (PG8_LAS unsigned*)(lds + (bufoff) + ldsw + _i * 8192), 16, 0, 0); } while (0)
#define PG8_LD8(p_) ({ const i32x4_t lo_ = *(const PG8_LAS i32x4_t*)(p_), hi_ = *(const PG8_LAS i32x4_t*)((p_) + 1024); (i32x8_t){lo_[0], lo_[1], lo_[2], lo_[3], hi_[0], hi_[1], hi_[2], hi_[3]}; })
#define PG8_LDA(dst, b, h) do { if constexpr (FP8) { _Pragma("unroll") for (int m = 0; m < 4; ++m) dst##8[m] = PG8_LD8(lds + PG8_SA(b, h) + aoff + m * 2048); } \
        else { _Pragma("unroll") for (int m = 0; m < 4; ++m) _Pragma("unroll") for (int k = 0; k < 2; ++k) dst[m][k] = *(const PG8_LAS bf16x8*)(lds + PG8_SA(b, h) + aoff + m * 2048 + k * 1024); } } while (0)
#define PG8_LDB(dst, b, h) do { if constexpr (FP8) { _Pragma("unroll") for (int n = 0; n < 2; ++n) dst##8[n] = PG8_LD8(lds + PG8_SB(b, h) + boff + n * 2048); } \
        else { _Pragma("unroll") for (int n = 0; n < 2; ++n) _Pragma("unroll") for (int k = 0; k < 2; ++k) dst[n][k] = *(const PG8_LAS bf16x8*)(lds + PG8_SB(b, h) + boff + n * 2048 + k * 1024); } } while (0)
#define PG8_MMA(ai, bj, At, Bt) do { __builtin_amdgcn_s_setprio(1); \
        if constexpr (FP8) { _Pragma("unroll") for (int m = 0; m < 4; ++m) _Pragma("unroll") for (int n = 0; n < 2; ++n) \
            asm volatile("v_mfma_scale_f32_16x16x128_f8f6f4 %0, %1, %2, %0, %3, %3 op_sel_hi:[0,0,0]" : "+v"(acc[ai][bj][m][n]) : "v"(Bt##8[n]), "v"(At##8[m]), "v"(one_scale)); } \
              \
        else { _Pragma("unroll") for (int m = 0; m < 4; ++m) _Pragma("unroll") for (int n = 0; n < 2; ++n) _Pragma("unroll") for (int k = 0; k < 2; ++k) \
            acc[ai][bj][m][n] = __builtin_amdgcn_mfma_f32_16x16x32_bf16(Bt[n][k], At[m][k], acc[ai][bj][m][n], 0, 0, 0); } \
        __builtin_amdgcn_s_setprio(0); } while (0)
#define PG8_WAIT_V(n) asm volatile("s_waitcnt vmcnt(" #n ")" ::: "memory")
#define PG8_WAIT_L(n) asm volatile("s_waitcnt lgkmcnt(" #n ")" ::: "memory")
#define PG8_BAR __builtin_amdgcn_s_barrier()
#define PG8_SCHED __builtin_amdgcn_sched_barrier(0)
    Unit cur, nxt; int ui = 0;
    if (!S.next(0, cur)) return;
    f32x4 acc[2][2][4][2];
#pragma unroll
    for (int a = 0; a < 2; ++a)
#pragma unroll
        for (int b = 0; b < 2; ++b)
#pragma unroll
            for (int m = 0; m < 4; ++m)
#pragma unroll
                for (int n = 0; n < 2; ++n) acc[a][b][m][n] = (f32x4){0.f, 0.f, 0.f, 0.f};
    int one_scale = 0x7f7f7f7f; asm volatile("" : "+v"(one_scale));
    bf16x8 At[4][2], B0[2][2], B1[2][2]; i32x8_t At8[4], B08[2], B18[2];
    const char* cA = (const char*)g.A + (size_t)cur.pm * tstep; const char* cB = (const char*)g.Bt + (size_t)cur.pn * tstep;
    S.a_ready(cur);
    if constexpr (SP2) {
        PG8_STAGE(PG8_SB(0, 0), cB, voffB); PG8_STAGE(PG8_SB(0, 1), cB + hstep, voffB); PG8_STAGE(PG8_SA(0, 0), cA, voffA); PG8_STAGE(PG8_SA(0, 1), cA + hstep, voffA);
        if (wr == 1) PG8_BAR;
        PG8_WAIT_V(2); PG8_BAR;
        PG8_STAGE(PG8_SB(1, 0), cB + kstep, voffB); PG8_STAGE(PG8_SA(1, 0), cA + kstep, voffA); PG8_STAGE(PG8_SB(1, 1), cB + hstep + kstep, voffB);
        PG8_WAIT_V(6); PG8_BAR;
    } else {
        PG8_STAGE(PG8_SB(0, 0), cB, voffB); PG8_STAGE(PG8_SA(0, 0), cA, voffA); PG8_STAGE(PG8_SB(0, 1), cB + hstep, voffB); PG8_STAGE(PG8_SA(0, 1), cA + hstep, voffA);
        if (wr == 1) PG8_BAR;
        PG8_WAIT_V(4); PG8_BAR;
        PG8_STAGE(PG8_SB(1, 0), cB + kstep, voffB); PG8_STAGE(PG8_SA(1, 0), cA + kstep, voffA); PG8_STAGE(PG8_SB(1, 1), cB + hstep + kstep, voffB);
        PG8_WAIT_V(6); PG8_BAR;
    }
    for (;;) {
        const bool has_next = S.next(ui + 1, nxt);
        const char* nA = has_next ? (const char*)g.A + (size_t)nxt.pm * tstep : cA; const char* nB = has_next ? (const char*)g.Bt + (size_t)nxt.pn * tstep : cB;
        for (int t = 0; t < nt; t += 2) {
            const bool last = (t == nt - 2);
            const char* a1 = cA + (size_t)(t + 1) * kstep;
            const char* a2 = last ? nA : cA + (size_t)(t + 2) * kstep; const char* b2 = last ? nB : cB + (size_t)(t + 2) * kstep;
            const char* a3 = a2 + kstep; const char* b3 = b2 + kstep;
            if (last && has_next) S.a_ready(nxt);
            if constexpr (SP2) {
            PG8_LDB(B0, 0, 0); PG8_LDB(B1, 0, 1); PG8_SCHED; PG8_LDA(At, 0, 0); PG8_STAGE(PG8_SA(1, 1), a1 + hstep, voffA);
            PG8_WAIT_V(8); PG8_WAIT_L(0); PG8_BAR; PG8_MMA(0, 0, At, B0); PG8_MMA(0, 1, At, B1); PG8_BAR; PG8_SCHED;
            PG8_LDA(At, 0, 1); PG8_STAGE(PG8_SB(0, 0), b2, voffB); PG8_STAGE(PG8_SB(0, 1), b2 + hstep, voffB); PG8_STAGE(PG8_SA(0, 0), a2, voffA);
            PG8_WAIT_V(8); PG8_WAIT_L(0); PG8_BAR; PG8_MMA(1, 0, At, B0); PG8_MMA(1, 1, At, B1); PG8_BAR; PG8_SCHED;
            PG8_LDB(B0, 1, 0); PG8_LDB(B1, 1, 1); PG8_SCHED; PG8_LDA(At, 1, 0); PG8_STAGE(PG8_SA(0, 1), a2 + hstep, voffA);
            PG8_WAIT_V(8); PG8_WAIT_L(0); PG8_BAR; PG8_MMA(0, 0, At, B0); PG8_MMA(0, 1, At, B1); PG8_BAR; PG8_SCHED;
            PG8_LDA(At, 1, 1); PG8_STAGE(PG8_SB(1, 0), b3, voffB); PG8_STAGE(PG8_SB(1, 1), b3 + hstep, voffB); PG8_STAGE(PG8_SA(1, 0), a3, voffA);
            PG8_WAIT_V(8); PG8_WAIT_L(0); PG8_BAR; PG8_MMA(1, 0, At, B0); PG8_MMA(1, 1, At, B1); PG8_BAR; PG8_SCHED;
            } else {
            PG8_LDB(B0, 0, 0); PG8_SCHED; PG8_LDA(At, 0, 0); PG8_STAGE(PG8_SA(1, 1), a1 + hstep, voffA);
            PG8_WAIT_L(8); PG8_BAR; PG8_WAIT_L(0); PG8_MMA(0, 0, At, B0); PG8_BAR; PG8_SCHED;
            PG8_LDB(B1, 0, 1); PG8_STAGE(PG8_SB(0, 0), b2, voffB);
            PG8_BAR; PG8_WAIT_L(0); PG8_MMA(0, 1, At, B1); PG8_BAR;
            PG8_LDA(At, 0, 1); PG8_STAGE(PG8_SA(0, 0), a2, voffA);
            PG8_BAR; PG8_WAIT_L(0); PG8_MMA(1, 0, At, B0); PG8_BAR; PG8_SCHED;
            PG8_STAGE(PG8_SB(0, 1), b2 + hstep, voffB);
            PG8_WAIT_V(6); PG8_BAR; PG8_MMA(1, 1, At, B1); PG8_BAR;
            PG8_LDB(B0, 1, 0); PG8_SCHED; PG8_LDA(At, 1, 0); PG8_STAGE(PG8_SA(0, 1), a2 + hstep, voffA);
            PG8_WAIT_L(8); PG8_BAR; PG8_WAIT_L(0); PG8_MMA(0, 0, At, B0); PG8_BAR; PG8_SCHED;
            PG8_LDB(B1, 1, 1); PG8_STAGE(PG8_SB(1, 0), b3, voffB);
            PG8_BAR; PG8_WAIT_L(0); PG8_MMA(0, 1, At, B1); PG8_BAR;
            PG8_LDA(At, 1, 1); PG8_STAGE(PG8_SA(1, 0), a3, voffA);
            PG8_BAR; PG8_WAIT_L(0); PG8_MMA(1, 0, At, B0); PG8_BAR; PG8_SCHED;
            PG8_STAGE(PG8_SB(1, 1), b3 + hstep, voffB);
            PG8_WAIT_V(6); PG8_BAR; PG8_MMA(1, 1, At, B1); PG8_BAR;
            }
        }
        if constexpr (ALIGN_EPI) { if (wr == 0) PG8_BAR; }
        if constexpr (FP8) asm volatile("s_nop 15\n\ts_nop 15\n\ts_nop 7" ::: "memory");
        if constexpr (!Epi::AFTER_DRAIN) { E(acc, cur, wr, wc, fr, fq); S.done(cur); }
        if (!has_next) break;
#pragma unroll
        for (int a = 0; a < 2; ++a)
#pragma unroll
            for (int b = 0; b < 2; ++b)
#pragma unroll
                for (int m = 0; m < 4; ++m)
#pragma unroll
                    for (int n = 0; n < 2; ++n) { acc[a][b][m][n] = (f32x4){0.f, 0.f, 0.f, 0.f}; if constexpr (FP8) asm volatile("" : "+v"(acc[a][b][m][n])); }
        cur = nxt; cA = nA; cB = nB; ++ui;
        if constexpr (ALIGN_EPI) { if (wr == 1) PG8_BAR; }
    }
    PG8_WAIT_V(0);
    if constexpr (!ALIGN_EPI) { if (wr == 0) PG8_BAR; }
    PG8_BAR;
    if constexpr (Epi::AFTER_DRAIN) { E.fused(acc, cur, wr, wc, fr, fq, lds, wid, lane); S.done(cur); }
#undef PG8_SA
#undef PG8_SB
#undef PG8_STAGE
#undef PG8_LDA
#undef PG8_LDB
#undef PG8_MMA
#undef PG8_LD8
#undef PG8_WAIT_V
#undef PG8_WAIT_L
#undef PG8_BAR
#undef PG8_SCHED
}
}
#ifndef PEER_FP8
#define PEER_FP8 3
#endif
#define PEER_FP8_P0 (PEER_FP8 != 0)
namespace mk {
typedef unsigned short bf16;
typedef unsigned v4u __attribute__((ext_vector_type(4)));
typedef float f32x4 __attribute__((ext_vector_type(4)));
typedef float f32x2 __attribute__((ext_vector_type(2)));
#define LAS __attribute__((address_space(3)))
constexpr int T = 8192, DM = 2048, SEQ = 4096, NPROJ = 11776, NEXP = 16384, NWAVES = 8;
constexpr int C_QA = 0, C_KA = 1024, C_VA = 1280, C_QR = 1536, C_KR = 2560, C_VR = 3584, C_GR = 5632, C_GA = 7680, C_GT = 9728;
constexpr float EPS = 1e-6f, LOG2E = 1.4426950408889634f;
constexpr size_t MiB = 1u << 20;
constexpr size_t WS_CTL = 0, CTL_BYTES = 1 * MiB;
constexpr size_t WS_SSQ = 512 * 1024, WS_R1 = 768 * 1024;
constexpr size_t WS_ROPE = 1 * MiB;
constexpr size_t WS_SK = 3 * MiB;
constexpr size_t WS_WIN = 4 * MiB;
constexpr size_t WS_WA = 50 * MiB, WS_WR = 54 * MiB, WS_WO = 62 * MiB, WS_WQ = 70 * MiB;
constexpr size_t WS_ED = 78 * MiB, WS_EU = 142 * MiB;
constexpr size_t WS_XB = 206 * MiB;
constexpr size_t WS_PROJ = 238 * MiB;
constexpr size_t WS_AO = 422 * MiB, WS_RO = 438 * MiB;
constexpr size_t WS_IDX = 470 * MiB, WS_GATE = 474 * MiB, WS_END = 478 * MiB;
constexpr int LDS_BYTES = 156672;
__constant__ float INV_FREQ[64] = {
1.000000000e+00f, 8.659643531e-01f, 7.498942018e-01f, 6.493816376e-01f, 5.623413324e-01f, 4.869675338e-01f, 4.216965139e-01f, 3.651741147e-01f, 3.162277639e-01f, 2.738419771e-01f, 2.371373922e-01f, 2.053525001e-01f, 1.778279394e-01f, 1.539926529e-01f, 1.333521456e-01f, 1.154782027e-01f, 1.000000015e-01f, 8.659642935e-02f, 7.498941571e-02f, 6.493816525e-02f, 5.623412877e-02f, 4.869675264e-02f, 4.216964915e-02f, 3.651741147e-02f, 3.162277862e-02f, 2.738419734e-02f, 2.371373586e-02f, 2.053524926e-02f, 1.778279431e-02f, 1.539926510e-02f, 1.333521493e-02f, 1.154781971e-02f, 9.999999776e-03f, 8.659643121e-03f, 7.498942316e-03f, 6.493816618e-03f, 5.623413250e-03f, 4.869675264e-03f, 4.216964822e-03f, 3.651741426e-03f, 3.162277862e-03f, 2.738419687e-03f, 2.371373819e-03f, 2.053525066e-03f, 1.778279431e-03f, 1.539926627e-03f, 1.333521446e-03f, 1.154781901e-03f, 1.000000047e-03f, 8.659643354e-04f, 7.498941850e-04f, 6.493816618e-04f, 5.623413017e-04f, 4.869675031e-04f, 4.216965463e-04f, 3.651741135e-04f, 3.162277862e-04f, 2.738419571e-04f, 2.371373848e-04f, 2.053525241e-04f, 1.778279402e-04f, 1.539926452e-04f, 1.333521504e-04f, 1.154782076e-04f};
__constant__ float LOG2G[8] = {-4.58036896131247886e-02f, -2.27200765000835289e-02f, -1.13153132278341461e-02f, -5.64656314114206272e-03f, -2.82051906237866263e-03f, -1.40957025467135363e-03f, -7.04612976589372706e-04f, -3.52263471629021385e-04f};

__device__ __forceinline__ unsigned f2bf(float f) { unsigned u = __builtin_bit_cast(unsigned, f); return (u + 0x7fffu + ((u >> 16) & 1u)) >> 16; }
__device__ __forceinline__ unsigned pk2(float lo, float hi) { return f2bf(lo) | (f2bf(hi) << 16); }
__device__ __forceinline__ float bflo(unsigned u) { return __uint_as_float(u << 16); }
__device__ __forceinline__ float bfhi(unsigned u) { return __uint_as_float(u & 0xffff0000u); }
__device__ __forceinline__ float bf2f(bf16 b) { return __uint_as_float((unsigned)b << 16); }
typedef __bf16 bf16x2_t __attribute__((ext_vector_type(2)));
__device__ __forceinline__ float dot2(unsigned a, unsigned b, float c) { return __builtin_amdgcn_fdot2_f32_bf16(__builtin_bit_cast(bf16x2_t, a), __builtin_bit_cast(bf16x2_t, b), c, false); }
__device__ __forceinline__ float dot8(v4u a, v4u b, float c) { c = dot2(a.x, b.x, c); c = dot2(a.y, b.y, c); c = dot2(a.z, b.z, c); c = dot2(a.w, b.w, c); return c; }
__device__ __forceinline__ float wave_sum(float v) {
#pragma unroll
    for (int o = 1; o < 64; o <<= 1) v += __shfl_xor(v, o);
    return v;
}
__device__ __forceinline__ float wave_max(float v) {
#pragma unroll
    for (int o = 1; o < 64; o <<= 1) v = fmaxf(v, __shfl_xor(v, o));
    return v;
}
__device__ __forceinline__ int wave_min_i(int v) {
#pragma unroll
    for (int o = 1; o < 64; o <<= 1) { const int w = __shfl_xor(v, o); v = w < v ? w : v; }
    return v;
}
__device__ __forceinline__ float rdlane(float v, int l) { return __uint_as_float((unsigned)__builtin_amdgcn_readlane((int)__float_as_uint(v), l)); }
__device__ __forceinline__ int rdlane_i(int v, int l) { return __builtin_amdgcn_readlane(v, l); }
#define LDS_WAIT() asm volatile("s_waitcnt lgkmcnt(0)" ::: "memory")

__device__ __forceinline__ int opq(int v) { asm volatile("" : "+v"(v)); return v; }
struct Frame {
    LAS unsigned char* lds; int tid, lane, wave, G, bid, gw, NGW;
    const float *x, *attn_norm, *w_in, *sinks, *w_attn, *w_ret, *w_out, *ffn_norm, *w_q, *sub_keys, *e_down, *e_up, *final_norm;
    float* out; unsigned char* ws;
};
__device__ __forceinline__ int proj_dst_col(int n) {
    const bool rope = (n < 1280) || (n >= 1536 && n < 3584);
    if (!rope) return n;
    const int hb = n & ~127, d = n & 127;
    return hb + ((d & 63) << 1) + (d >> 6);
}
__device__ __forceinline__ void p0_transpose_item(const float* W, int K, int N, const float* g, bf16* WT, bool perm, LAS float* scr, int item, int lane) {
    const int nblk = N / 64, kb = item / nblk, nb = item % nblk, k0 = 64 * kb, n0 = 64 * nb;
    const int lr = lane >> 4, lc = (lane & 15) * 4;
#pragma unroll 4
    for (int i = 0; i < 16; ++i) { const int kk = 4 * i + lr; f32x4 w = __builtin_nontemporal_load((const f32x4*)(W + (size_t)(k0 + kk) * N + n0 + lc)); if (g) w = w * g[k0 + kk];
        LAS float* d = scr + kk * 65 + lc; d[0] = w[0]; d[1] = w[1]; d[2] = w[2]; d[3] = w[3]; }
    LDS_WAIT(); asm volatile("" ::: "memory");
    const int c = lane & 7;
#pragma unroll
    for (int j = 0; j < 8; ++j) { const int n = (lane >> 3) + 8 * j; const LAS float* s = scr + (8 * c) * 65 + n;
        v4u o; o.x = pk2(s[0 * 65], s[1 * 65]); o.y = pk2(s[2 * 65], s[3 * 65]); o.z = pk2(s[4 * 65], s[5 * 65]); o.w = pk2(s[6 * 65], s[7 * 65]);
        int nd = n0 + n; if (perm) nd = proj_dst_col(nd);
        *(v4u*)(WT + (size_t)nd * K + k0 + 8 * c) = o; }
    LDS_WAIT(); asm volatile("" ::: "memory");
}
#ifndef GEMM1_FP8
#define GEMM1_FP8 1
#endif
#ifndef P3_FP8
#define P3_FP8 1
#endif
#ifndef P4_FP8
#define P4_FP8 1
#endif
constexpr float P3_AS = 16.0f;
constexpr float G1_XS = 16.0f, G1_WS = 1024.0f;
__device__ __forceinline__ unsigned pk4_fp8(float a, float b, float c, float d) {
    a = fminf(fmaxf(a, -448.f), 448.f); b = fminf(fmaxf(b, -448.f), 448.f); c = fminf(fmaxf(c, -448.f), 448.f); d = fminf(fmaxf(d, -448.f), 448.f);
    int pw = 0; pw = __builtin_amdgcn_cvt_pk_fp8_f32(a, b, pw, false); pw = __builtin_amdgcn_cvt_pk_fp8_f32(c, d, pw, true); return (unsigned)pw;
}
__device__ __forceinline__ void p0_transpose_item_fp8(const float* W, int K, int N, const float* g, float scale, unsigned char* WT, bool perm, LAS float* scr, int item, int lane) {
    const int nblk = N / 64, kb = item / nblk, nb = item % nblk, k0 = 64 * kb, n0 = 64 * nb;
    const int lr = lane >> 4, lc = (lane & 15) * 4;
#pragma unroll 4
    for (int i = 0; i < 16; ++i) { const int kk = 4 * i + lr; f32x4 w = __builtin_nontemporal_load((const f32x4*)(W + (size_t)(k0 + kk) * N + n0 + lc)); w = w * ((g ? g[k0 + kk] : 1.0f) * scale);
        LAS float* d = scr + kk * 65 + lc; d[0] = w[0]; d[1] = w[1]; d[2] = w[2]; d[3] = w[3]; }
    LDS_WAIT(); asm volatile("" ::: "memory");
    const int c = lane & 7;
#pragma unroll
    for (int j = 0; j < 8; ++j) { const int n = (lane >> 3) + 8 * j; const LAS float* s = scr + (8 * c) * 65 + n;
        f32x2 o; o.x = __uint_as_float(pk4_fp8(s[0 * 65], s[1 * 65], s[2 * 65], s[3 * 65])); o.y = __uint_as_float(pk4_fp8(s[4 * 65], s[5 * 65], s[6 * 65], s[7 * 65]));
        int nd = n0 + n; if (perm) nd = proj_dst_col(nd);
        *(f32x2*)(WT + (size_t)nd * K + k0 + 8 * c) = o; }
    LDS_WAIT(); asm volatile("" ::: "memory");
}
__device__ __forceinline__ void sincos_acc(float xf, float& sn, float& cs) {
    const double x = (double)xf;
    const double q = __builtin_rint(x * 0.63661977236758134308);
    const double r = __builtin_fma(-q, 1.57079632679489661923, x) - q * 6.123233995736766e-17;
    const double r2 = r * r;
    double s = -1.0 / 6227020800.0; s = s * r2 + 1.0 / 39916800.0; s = -s; s = s * r2 + 1.0 / 362880.0; s = -s;
    double ps = 1.0 / 6227020800.0;
    ps = ps * r2 - 1.0 / 39916800.0; ps = ps * r2 + 1.0 / 362880.0; ps = ps * r2 - 1.0 / 5040.0; ps = ps * r2 + 1.0 / 120.0; ps = ps * r2 - 1.0 / 6.0; ps = ps * r2 + 1.0;
    const double sv = ps * r;
    double pc = -1.0 / 87178291200.0;
    pc = pc * r2 + 1.0 / 479001600.0; pc = pc * r2 - 1.0 / 3628800.0; pc = pc * r2 + 1.0 / 40320.0; pc = pc * r2 - 1.0 / 720.0; pc = pc * r2 + 1.0 / 24.0; pc = pc * r2 - 0.5; pc = pc * r2 + 1.0;
    (void)s;
    const int qi = ((int)q) & 3;
    const double so = (qi == 0) ? sv : (qi == 1) ? pc : (qi == 2) ? -sv : -pc;
    const double co = (qi == 0) ? pc : (qi == 1) ? -sv : (qi == 2) ? -pc : sv;
    sn = (float)so; cs = (float)co;
}
__device__ __forceinline__ v4u pack8(f32x4 a, f32x4 b) { v4u o; o.x = pk2(a[0], a[1]); o.y = pk2(a[2], a[3]); o.z = pk2(b[0], b[1]); o.w = pk2(b[2], b[3]); return o; }

__device__ __forceinline__ void p0_prologue(Frame& F) {
    LAS float* scr = (LAS float*)(F.lds + F.wave * 16640);
    unsigned char* ws = F.ws;
    const int lane = opq(F.lane);
    constexpr int I_IN = (DM / 64) * (NPROJ / 64), I_A = (1024 / 64) * (DM / 64), I_S = (DM / 64) * (DM / 64);
    constexpr int NITEMS = I_IN + I_A + 3 * I_S;
    for (int it = F.gw; it < NITEMS; it += F.NGW) {
        int r = it;
        if (r < I_IN) { if (GEMM1_FP8) p0_transpose_item_fp8(F.w_in, DM, NPROJ, F.attn_norm, G1_WS, ws + WS_WIN, true, scr, r, lane);
                        else p0_transpose_item(F.w_in, DM, NPROJ, F.attn_norm, (bf16*)(ws + WS_WIN), true, scr, r, lane); continue; } r -= I_IN;
        if (r < I_A) { if (P3_FP8) p0_transpose_item_fp8(F.w_attn, 1024, DM, nullptr, G1_WS, ws + WS_WA, false, scr, r, lane); else p0_transpose_item(F.w_attn, 1024, DM, nullptr, (bf16*)(ws + WS_WA), false, scr, r, lane); continue; } r -= I_A;
        if (r < I_S) { if (P3_FP8) p0_transpose_item_fp8(F.w_ret, DM, DM, nullptr, G1_WS, ws + WS_WR, false, scr, r, lane); else p0_transpose_item(F.w_ret, DM, DM, nullptr, (bf16*)(ws + WS_WR), false, scr, r, lane); continue; } r -= I_S;
        if (r < I_S) { if (P4_FP8) p0_transpose_item_fp8(F.w_out, DM, DM, nullptr, G1_WS, ws + WS_WO, false, scr, r, lane); else p0_transpose_item(F.w_out, DM, DM, nullptr, (bf16*)(ws + WS_WO), false, scr, r, lane); continue; } r -= I_S;
        p0_transpose_item(F.w_q, DM, DM, F.ffn_norm, (bf16*)(ws + WS_WQ), false, scr, r, lane);
    }
    for (int row = F.gw; row < (PEER_FP8_P0 ? 0 : 2 * NEXP); row += F.NGW) {
        const float* src = (row < NEXP) ? F.e_down + (size_t)row * DM : F.e_up + (size_t)(row - NEXP) * DM;
        bf16* dst = (row < NEXP) ? (bf16*)(ws + WS_ED) + (size_t)row * DM : (bf16*)(ws + WS_EU) + (size_t)(row - NEXP) * DM;
        const f32x4* s4 = (const f32x4*)src;
#pragma unroll
        for (int j = 0; j < 4; ++j) { const f32x4 a = s4[128 * j + 2 * lane], b = s4[128 * j + 2 * lane + 1]; *(v4u*)(dst + 512 * j + 8 * lane) = pack8(a, b); }
    }
    for (int m = F.gw; m < T; m += F.NGW) {
        const f32x4* s4 = (const f32x4*)(F.x + (size_t)m * DM); float ss = 0.f; f32x4 xa[4], xb[4];
#pragma unroll
        for (int j = 0; j < 4; ++j) { const f32x4 a = __builtin_nontemporal_load(s4 + 128 * j + 2 * lane), b = __builtin_nontemporal_load(s4 + 128 * j + 2 * lane + 1); xa[j] = a; xb[j] = b;
            ss += (a[0] * a[0] + a[1] * a[1]) + (a[2] * a[2] + a[3] * a[3]) + (b[0] * b[0] + b[1] * b[1]) + (b[2] * b[2] + b[3] * b[3]); }
        ss = wave_sum(ss);
        const float r1v = 1.0f / sqrtf(ss * (1.0f / DM) + EPS);
        if (lane == 0) ((float*)(ws + WS_R1))[m] = r1v;
        if (GEMM1_FP8) { unsigned char* dst = ws + WS_XB + (size_t)m * DM; const float sc = r1v * G1_XS;
#pragma unroll
            for (int j = 0; j < 4; ++j) { const f32x4 a = xa[j] * sc, b = xb[j] * sc; f32x2 o; o.x = __uint_as_float(pk4_fp8(a[0], a[1], a[2], a[3])); o.y = __uint_as_float(pk4_fp8(b[0], b[1], b[2], b[3]));
                *(f32x2*)(dst + 512 * j + 8 * lane) = o; }
        } else { bf16* dst = (bf16*)(ws + WS_XB) + (size_t)m * DM;
#pragma unroll
            for (int j = 0; j < 4; ++j) *(v4u*)(dst + 512 * j + 8 * lane) = pack8(xa[j], xb[j]); }
    }
    for (int c = F.gw; c < 2 * 8 * 128 * 128 / 512; c += F.NGW) {
        const f32x4* s4 = (const f32x4*)(F.sub_keys + (size_t)c * 512); const f32x4 a = s4[2 * lane], b = s4[2 * lane + 1];
        *(v4u*)((bf16*)(ws + WS_SK) + (size_t)c * 512 + 8 * lane) = pack8(a, b);
    }
    for (int c = F.gw; c < SEQ * 64 / 64; c += F.NGW) {
        const int e = c * 64 + lane, pos = e >> 6, i = e & 63; const float ang = (float)pos * INV_FREQ[i];
        float sn, cs; sincos_acc(ang, sn, cs);
        ((f32x2*)(ws + WS_ROPE))[e] = (f32x2){cs, sn};
    }
}

__device__ __forceinline__ void p2_attn_naive(Frame& F) {
    const bf16* PROJ = (const bf16*)(F.ws + WS_PROJ); bf16* AO = (bf16*)(F.ws + WS_AO); const int lane = F.lane;
    for (int it = F.gw; it < T * 8; it += F.NGW) {
        const int t = it >> 3, h = it & 7, pos = t & 4095, kvh = h >> 2;
        const v4u* qr = (const v4u*)(PROJ + (size_t)t * NPROJ + C_QA + h * 128);
        v4u q[16];
#pragma unroll
        for (int i = 0; i < 16; ++i) q[i] = qr[i];
        float s[2];
#pragma unroll
        for (int half = 0; half < 2; ++half) {
            const int sp = pos - 127 + lane + 64 * half; float acc = -1e30f;
            if (sp >= 0) { const v4u* kr = (const v4u*)(PROJ + (size_t)(t - pos + sp) * NPROJ + C_KA + kvh * 128); acc = 0.f;
#pragma unroll
                for (int i = 0; i < 16; ++i) acc = dot8(q[i], kr[i], acc); }
            s[half] = acc;
        }
        const float sink = F.sinks[h] * LOG2E;
        const float m = wave_max(fmaxf(fmaxf(s[0], s[1]), sink));
        const float p0 = exp2f(s[0] - m), p1 = exp2f(s[1] - m);
        const float l = wave_sum(p0 + p1) + exp2f(sink - m);
        float o0 = 0.f, o1 = 0.f;
        for (int j = 0; j < 128; ++j) {
            const int sp = pos - 127 + j; if (sp < 0) continue;
            const float pj = rdlane(j < 64 ? p0 : p1, j & 63);
            const unsigned vv = *(const unsigned*)(PROJ + (size_t)(t - pos + sp) * NPROJ + C_VA + kvh * 128 + 2 * lane);
            o0 += pj * bflo(vv); o1 += pj * bfhi(vv);
        }
        const float inv = 1.0f / l;
        *(unsigned*)(AO + (size_t)t * 1024 + h * 128 + 2 * lane) = pk2(o0 * inv, o1 * inv);
    }
}
__device__ __forceinline__ void p2_kv_naive(Frame& F, float* KV) {
    const bf16* PROJ = (const bf16*)(F.ws + WS_PROJ);
    for (int u = F.bid; u < 512; u += F.G) {
        const int b = u >> 8, h = (u >> 5) & 7, n = u & 31; const size_t t0 = (size_t)b * SEQ + n * 128; const float l2g = LOG2G[h];
        for (int de = F.tid; de < 32768; de += 512) {
            const int d = de >> 8, e = de & 255; float acc = 0.f;
            for (int k = 0; k < 128; ++k) {
                const float kk = bf2f(PROJ[(t0 + k) * NPROJ + C_KR + h * 128 + d]) * exp2f((float)(127 - k) * l2g);
                acc += kk * bf2f(PROJ[(t0 + k) * NPROJ + C_VR + h * 256 + e]);
            }
            KV[((size_t)u * 128 + d) * 256 + e] = acc;
        }
    }
}
__device__ __forceinline__ void p2_scan(Frame& F, float* KV) {
    bf16* S = (bf16*)KV;
    for (int c = F.bid * 512 + F.tid; c < 16 * 32768 / 4; c += F.G * 512) {
        const int bh = c >> 13, de = (c & 8191) * 4; const float cd = exp2f(128.0f * LOG2G[bh & 7]); float s0 = 0.f, s1 = 0.f, s2 = 0.f, s3 = 0.f;
        for (int n = 0; n < 32; ++n) { unsigned long long* p = (unsigned long long*)(S + ((size_t)(bh * 32 + n) * 32768 + de)); const unsigned long long v = *p; const unsigned lo = (unsigned)v, hi = (unsigned)(v >> 32);
            *p = (unsigned long long)pk2(s0, s1) | ((unsigned long long)pk2(s2, s3) << 32);
            s0 = s0 * cd + bflo(lo); s1 = s1 * cd + bfhi(lo); s2 = s2 * cd + bflo(hi); s3 = s3 * cd + bfhi(hi); }
    }
}
__device__ __forceinline__ void p2_retout_naive(Frame& F, const float* KV) {
    const bf16* PROJ = (const bf16*)(F.ws + WS_PROJ); bf16* RO = (bf16*)(F.ws + WS_RO); const int lane = F.lane;
    for (int it = F.gw; it < T * 8; it += F.NGW) {
        const int t = it >> 3, h = it & 7, c = t & 127, t0 = t - c, b = t >> 12, n = (t & 4095) >> 7, u = (b * 8 + h) * 32 + n; const float l2g = LOG2G[h];
        const v4u* qr = (const v4u*)(PROJ + (size_t)t * NPROJ + C_QR + h * 128);
        v4u q[16];
#pragma unroll
        for (int i = 0; i < 16; ++i) q[i] = qr[i];
        float s[2];
#pragma unroll
        for (int half = 0; half < 2; ++half) {
            const int k = lane + 64 * half; float acc = 0.f;
            if (k <= c) { const v4u* kr = (const v4u*)(PROJ + (size_t)(t0 + k) * NPROJ + C_KR + h * 128);
#pragma unroll
                for (int i = 0; i < 16; ++i) acc = dot8(q[i], kr[i], acc);
                acc *= exp2f((float)(c - k) * l2g); }
            s[half] = acc;
        }
        float o[4] = {0.f, 0.f, 0.f, 0.f};
        for (int k = 0; k <= c; ++k) {
            const float sk = rdlane(k < 64 ? s[0] : s[1], k & 63); const bf16* vr = PROJ + (size_t)(t0 + k) * NPROJ + C_VR + h * 256 + lane;
#pragma unroll
            for (int j = 0; j < 4; ++j) o[j] += sk * bf2f(vr[64 * j]);
        }
        float oc[4] = {0.f, 0.f, 0.f, 0.f};
        const float* st = KV + (size_t)u * 32768 + lane;
#pragma unroll
        for (int i = 0; i < 16; ++i) {
            const unsigned w[4] = {q[i].x, q[i].y, q[i].z, q[i].w};
#pragma unroll
            for (int jj = 0; jj < 4; ++jj) {
                const float qlo = bflo(w[jj]), qhi = bfhi(w[jj]); const int d = 8 * i + 2 * jj;
#pragma unroll
                for (int j = 0; j < 4; ++j) { oc[j] += qlo * st[(size_t)d * 256 + 64 * j]; oc[j] += qhi * st[(size_t)(d + 1) * 256 + 64 * j]; }
            }
        }
        const float qd = exp2f((float)(c + 1) * l2g);
#pragma unroll
        for (int j = 0; j < 4; ++j) o[j] += qd * oc[j];
        const float mu = wave_sum((o[0] + o[1]) + (o[2] + o[3])) * (1.0f / 256.0f);
        float vs = 0.f;
#pragma unroll
        for (int j = 0; j < 4; ++j) { o[j] -= mu; vs += o[j] * o[j]; }
        const float rs = 1.0f / sqrtf(wave_sum(vs) * (1.0f / 256.0f) + EPS);
        const bf16* gr = PROJ + (size_t)t * NPROJ + C_GR + h * 256 + lane; bf16* orow = RO + (size_t)t * DM + h * 256 + lane;
#pragma unroll
        for (int j = 0; j < 4; ++j) orow[64 * j] = (bf16)f2bf(o[j] * rs * bf2f(gr[64 * j]));
    }
}
typedef short bf16x8 __attribute__((ext_vector_type(8)));
typedef short s16x4 __attribute__((ext_vector_type(4)));
#define MFMA16(a, b, c) __builtin_amdgcn_mfma_f32_16x16x32_bf16((a), (b), (c), 0, 0, 0)
__device__ __forceinline__ s16x4 tr16(const LAS unsigned char* p) { return __builtin_amdgcn_ds_read_tr16_b64_v4i16((LAS s16x4*)p); }
__device__ __forceinline__ bf16x8 cat8(s16x4 a, s16x4 b) { return (bf16x8){a[0], a[1], a[2], a[3], b[0], b[1], b[2], b[3]}; }
__device__ __forceinline__ v4u scale8(v4u v, float s) { v4u o; o.x = pk2(bflo(v.x) * s, bfhi(v.x) * s); o.y = pk2(bflo(v.y) * s, bfhi(v.y) * s); o.z = pk2(bflo(v.z) * s, bfhi(v.z) * s); o.w = pk2(bflo(v.w) * s, bfhi(v.w) * s); return o; }

__device__ __forceinline__ void p2_kv_mfma(Frame& F, float* KV) {
    const bf16* PROJ = (const bf16*)(F.ws + WS_PROJ);
    const int tid = opq(F.tid), lane = tid & 63, w = F.wave, g = lane >> 4, fr = lane & 15, q = fr >> 2, p = fr & 3;
    constexpr int PV = 528, PK = 272, VS = 0, KS = 128 * 528;
    LAS unsigned char* lds = F.lds;
    for (int u = F.bid; u < 512; u += F.G) {
        const int b = u >> 8, h = (u >> 5) & 7, n = u & 31; const size_t t0 = (size_t)b * SEQ + n * 128; const float l2g = LOG2G[h];
#pragma unroll
        for (int i = 0; i < 8; ++i) { const int c = tid + 512 * i, row = c >> 5, ch = c & 31;
            const v4u v = *(const v4u*)(PROJ + (t0 + row) * NPROJ + C_VR + h * 256 + ch * 8); *(LAS v4u*)(lds + VS + row * PV + ch * 16) = v; }
#pragma unroll
        for (int i = 0; i < 4; ++i) { const int c = tid + 512 * i, row = c >> 4, ch = c & 15;
            const v4u v = *(const v4u*)(PROJ + (t0 + row) * NPROJ + C_KR + h * 128 + ch * 8);
            *(LAS v4u*)(lds + KS + row * PK + ch * 16) = scale8(v, exp2f((float)(127 - row) * l2g)); }
        __syncthreads();
        f32x4 acc[8][2];
#pragma unroll
        for (int dt = 0; dt < 8; ++dt) { acc[dt][0] = (f32x4){0.f, 0.f, 0.f, 0.f}; acc[dt][1] = (f32x4){0.f, 0.f, 0.f, 0.f}; }
#pragma unroll
        for (int ks = 0; ks < 4; ++ks) {
            bf16x8 Bf[2];
#pragma unroll
            for (int ei = 0; ei < 2; ++ei) { const LAS unsigned char* ap = lds + VS + (32 * ks + 8 * g + q) * PV + (16 * (2 * w + ei) + 4 * p) * 2; Bf[ei] = cat8(tr16(ap), tr16(ap + 4 * PV)); }
#pragma unroll
            for (int dt = 0; dt < 8; ++dt) { const LAS unsigned char* ap = lds + KS + (32 * ks + 8 * g + q) * PK + (16 * dt + 4 * p) * 2; const bf16x8 Af = cat8(tr16(ap), tr16(ap + 4 * PK));
                acc[dt][0] = MFMA16(Af, Bf[0], acc[dt][0]); acc[dt][1] = MFMA16(Af, Bf[1], acc[dt][1]); }
        }
#pragma unroll
        for (int dt = 0; dt < 8; ++dt)
#pragma unroll
            for (int ei = 0; ei < 2; ++ei) { const int e = 16 * (2 * w + ei) + fr; const f32x4 a = acc[dt][ei];
                *(unsigned long long*)((bf16*)KV + ((size_t)u * 256 + e) * 128 + 16 * dt + 4 * g) = (unsigned long long)pk2(a[0], a[1]) | ((unsigned long long)pk2(a[2], a[3]) << 32); }
        __syncthreads();
    }
}
__device__ __forceinline__ void p2_retout_mfma(Frame& F, const float* KV) {
    const bf16* PROJ = (const bf16*)(F.ws + WS_PROJ); bf16* RO = (bf16*)(F.ws + WS_RO);
    const int tid = opq(F.tid), lane = tid & 63, w = F.wave, g = lane >> 4, fr = lane & 15, q = fr >> 2, p = fr & 3;
    constexpr int P1 = 272, PV = 528, KS = 0, VS = 128 * 272, STS = 0;
    LAS unsigned char* lds = F.lds;
    for (int u = F.bid; u < 512; u += F.G) {
        const int b = u >> 8, h = (u >> 5) & 7, n = u & 31; const size_t t0 = (size_t)b * SEQ + n * 128; const float l2g = LOG2G[h];
        v4u kreg[4], vreg[8];
#pragma unroll
        for (int i = 0; i < 4; ++i) { const int c = tid + 512 * i, row = c >> 4, ch = c & 15; kreg[i] = *(const v4u*)(PROJ + (t0 + row) * NPROJ + C_KR + h * 128 + ch * 8); }
#pragma unroll
        for (int i = 0; i < 8; ++i) { const int c = tid + 512 * i, row = c >> 5, ch = c & 31; vreg[i] = *(const v4u*)(PROJ + (t0 + row) * NPROJ + C_VR + h * 256 + ch * 8); }
#pragma unroll
        for (int i = 0; i < 8; ++i) { const int c = tid + 512 * i, row = c >> 4, ch = c & 15;
            *(LAS v4u*)(lds + STS + row * P1 + ch * 16) = *(const v4u*)((const bf16*)KV + ((size_t)u * 256 + row) * 128 + ch * 8); }
        bf16x8 qf[4];
#pragma unroll
        for (int ds = 0; ds < 4; ++ds) qf[ds] = *(const bf16x8*)(PROJ + (t0 + 16 * w + fr) * NPROJ + C_QR + h * 128 + 32 * ds + 8 * g);
        __syncthreads();
        f32x4 acc[16];
#pragma unroll
        for (int et = 0; et < 16; ++et) { acc[et] = (f32x4){0.f, 0.f, 0.f, 0.f};
#pragma unroll
            for (int ds = 0; ds < 4; ++ds) { const bf16x8 A = *(const LAS bf16x8*)(lds + STS + (16 * et + fr) * P1 + (32 * ds + 8 * g) * 2); acc[et] = MFMA16(A, qf[ds], acc[et]); } }
        const int c = 16 * w + fr; const float qd = exp2f((float)(c + 1) * l2g);
#pragma unroll
        for (int et = 0; et < 16; ++et) acc[et] = acc[et] * qd;
        __syncthreads();
#pragma unroll
        for (int i = 0; i < 4; ++i) { const int cc = tid + 512 * i, row = cc >> 4, ch = cc & 15; *(LAS v4u*)(lds + KS + row * P1 + ch * 16) = kreg[i]; }
#pragma unroll
        for (int i = 0; i < 8; ++i) { const int cc = tid + 512 * i, row = cc >> 5, ch = cc & 31; *(LAS v4u*)(lds + VS + row * PV + ch * 16) = vreg[i]; }
        __syncthreads();
        float dq[4]; bool mk[4];
#pragma unroll
        for (int r = 0; r < 4; ++r) { dq[r] = exp2f((float)(fr - 4 * g - r) * l2g); mk[r] = (fr - 4 * g - r) >= 0; }
#pragma unroll 1
        for (int i2 = 0; 2 * i2 <= w; ++i2) {
            const int k0 = 2 * i2, k1 = 2 * i2 + 1;
            f32x4 s0 = {0.f, 0.f, 0.f, 0.f}, s1 = {0.f, 0.f, 0.f, 0.f};
#pragma unroll
            for (int ds = 0; ds < 4; ++ds) { const bf16x8 A0 = *(const LAS bf16x8*)(lds + KS + (16 * k0 + fr) * P1 + (32 * ds + 8 * g) * 2); s0 = MFMA16(A0, qf[ds], s0); }
            if (k1 <= w) {
#pragma unroll
                for (int ds = 0; ds < 4; ++ds) { const bf16x8 A1 = *(const LAS bf16x8*)(lds + KS + (16 * k1 + fr) * P1 + (32 * ds + 8 * g) * 2); s1 = MFMA16(A1, qf[ds], s1); } }
            const float tf0 = exp2f((float)(16 * (w - k0)) * l2g), tf1 = (k1 <= w) ? exp2f((float)(16 * (w - k1)) * l2g) : 0.f;
            const bool d0 = (k0 == w), d1 = (k1 == w);
#pragma unroll
            for (int r = 0; r < 4; ++r) { s0[r] = (!d0 || mk[r]) ? s0[r] * (dq[r] * tf0) : 0.f; s1[r] = (!d1 || mk[r]) ? s1[r] * (dq[r] * tf1) : 0.f; }
            v4u bp; bp.x = pk2(s0[0], s0[1]); bp.y = pk2(s0[2], s0[3]); bp.z = pk2(s1[0], s1[1]); bp.w = pk2(s1[2], s1[3]);
            const bf16x8 Bp = __builtin_bit_cast(bf16x8, bp);
            const int k1c = (k1 <= 7) ? k1 : 7;
            const LAS unsigned char* va0 = lds + VS + (16 * k0 + 4 * g + q) * PV + (4 * p) * 2; const LAS unsigned char* va1 = lds + VS + (16 * k1c + 4 * g + q) * PV + (4 * p) * 2;
#pragma unroll
            for (int et = 0; et < 16; ++et) { const s16x4 a0 = tr16(va0 + 32 * et), a1 = tr16(va1 + 32 * et);
                acc[et] = MFMA16(cat8(a0, a1), Bp, acc[et]); }
        }
        float sm = 0.f;
#pragma unroll
        for (int et = 0; et < 16; ++et) sm += (acc[et][0] + acc[et][1]) + (acc[et][2] + acc[et][3]);
        sm += __shfl_xor(sm, 16); sm += __shfl_xor(sm, 32);
        const float mu = sm * (1.0f / 256.0f); float vs = 0.f;
#pragma unroll
        for (int et = 0; et < 16; ++et) { acc[et] = acc[et] - mu; vs += (acc[et][0] * acc[et][0] + acc[et][1] * acc[et][1]) + (acc[et][2] * acc[et][2] + acc[et][3] * acc[et][3]); }
        vs += __shfl_xor(vs, 16); vs += __shfl_xor(vs, 32);
        const float rs = 1.0f / sqrtf(vs * (1.0f / 256.0f) + EPS);
        const size_t t = t0 + c;
#pragma unroll
        for (int et = 0; et < 16; ++et) { const int e0 = 16 * et + 4 * g;
            const unsigned long long gg = *(const unsigned long long*)(PROJ + t * NPROJ + C_GR + h * 256 + e0); const unsigned glo = (unsigned)gg, ghi = (unsigned)(gg >> 32);
            if (P3_FP8) { const float rq = rs * P3_AS; *(unsigned*)((unsigned char*)RO + t * DM + h * 256 + e0) = pk4_fp8(acc[et][0] * rq * bflo(glo), acc[et][1] * rq * bfhi(glo), acc[et][2] * rq * bflo(ghi), acc[et][3] * rq * bfhi(ghi)); }
            else { const unsigned o0 = pk2(acc[et][0] * rs * bflo(glo), acc[et][1] * rs * bfhi(glo)), o1 = pk2(acc[et][2] * rs * bflo(ghi), acc[et][3] * rs * bfhi(ghi));
            *(unsigned long long*)(RO + t * DM + h * 256 + e0) = (unsigned long long)o0 | ((unsigned long long)o1 << 32); } }
        __syncthreads();
    }
}
__device__ __forceinline__ void p2_attn_mfma(Frame& F) {
    const bf16* PROJ = (const bf16*)(F.ws + WS_PROJ); bf16* AO = (bf16*)(F.ws + WS_AO);
    const int tid = opq(F.tid), lane = tid & 63, w = F.wave, g = lane >> 4, fr = lane & 15, q = fr >> 2, p = fr & 3;
    constexpr int PK = 272, KS = 0, VS = 192 * 272;
    LAS unsigned char* lds = F.lds;
    for (int u = F.bid; u < 256; u += F.G) {
        const int b = u >> 7, kvh = (u >> 6) & 1, qb = u & 63, q0 = qb * 64; const size_t tb = (size_t)b * SEQ;
#pragma unroll
        for (int i = 0; i < 6; ++i) { const int c = tid + 512 * i, row = c >> 4, ch = c & 15, kp = q0 - 128 + row;
            v4u kv = {0u, 0u, 0u, 0u}, vv = {0u, 0u, 0u, 0u};
            if (kp >= 0) { kv = *(const v4u*)(PROJ + (tb + kp) * NPROJ + C_KA + kvh * 128 + ch * 8); vv = *(const v4u*)(PROJ + (tb + kp) * NPROJ + C_VA + kvh * 128 + ch * 8); }
            *(LAS v4u*)(lds + KS + row * PK + ch * 16) = kv; *(LAS v4u*)(lds + VS + row * PK + ch * 16) = vv; }
        __syncthreads();
        const int hq = w >> 1, qh = w & 1, h = kvh * 4 + hq; const float sink = F.sinks[h] * LOG2E;
#pragma unroll 1
        for (int qt = 0; qt < 2; ++qt) {
            const int qpos = q0 + 32 * qh + 16 * qt + fr;
            bf16x8 qf[4];
#pragma unroll
            for (int ds = 0; ds < 4; ++ds) qf[ds] = *(const bf16x8*)(PROJ + (tb + qpos) * NPROJ + C_QA + h * 128 + 32 * ds + 8 * g);
            const int rb = 32 * qh + 16 * qt;
            f32x4 s[10]; float m = sink;
#pragma unroll
            for (int j = 0; j < 9; ++j) { s[j] = (f32x4){0.f, 0.f, 0.f, 0.f};
#pragma unroll
                for (int ds = 0; ds < 4; ++ds) { const bf16x8 A = *(const LAS bf16x8*)(lds + KS + (rb + 16 * j + fr) * PK + (32 * ds + 8 * g) * 2); s[j] = MFMA16(A, qf[ds], s[j]); } }
            s[9] = (f32x4){-1e30f, -1e30f, -1e30f, -1e30f};
#pragma unroll
            for (int r = 0; r < 4; ++r) { const int dd = fr - 4 * g - r; s[0][r] = (dd < 0) ? s[0][r] : -1e30f; s[8][r] = (dd >= 0) ? s[8][r] : -1e30f; }
            if (q0 < 128) {
#pragma unroll
                for (int j = 0; j < 9; ++j)
#pragma unroll
                    for (int r = 0; r < 4; ++r) { const int kp = q0 - 128 + rb + 16 * j + 4 * g + r; s[j][r] = (kp >= 0) ? s[j][r] : -1e30f; } }
#pragma unroll
            for (int j = 0; j < 9; ++j) m = fmaxf(m, fmaxf(fmaxf(s[j][0], s[j][1]), fmaxf(s[j][2], s[j][3])));
            m = fmaxf(m, __shfl_xor(m, 16)); m = fmaxf(m, __shfl_xor(m, 32));
            float l = 0.f;
#pragma unroll
            for (int j = 0; j < 10; ++j)
#pragma unroll
                for (int r = 0; r < 4; ++r) { s[j][r] = __builtin_amdgcn_exp2f(s[j][r] - m); l += s[j][r]; }
            l += __shfl_xor(l, 16); l += __shfl_xor(l, 32); l += __builtin_amdgcn_exp2f(sink - m);
            f32x4 o[8];
#pragma unroll
            for (int dt = 0; dt < 8; ++dt) o[dt] = (f32x4){0.f, 0.f, 0.f, 0.f};
#pragma unroll
            for (int st = 0; st < 5; ++st) {
                v4u bp; bp.x = pk2(s[2 * st][0], s[2 * st][1]); bp.y = pk2(s[2 * st][2], s[2 * st][3]); bp.z = pk2(s[2 * st + 1][0], s[2 * st + 1][1]); bp.w = pk2(s[2 * st + 1][2], s[2 * st + 1][3]);
                const bf16x8 Bp = __builtin_bit_cast(bf16x8, bp);
                const LAS unsigned char* va = lds + VS + (rb + 32 * st + 4 * g + q) * PK + (4 * p) * 2;
                const int o1 = (st < 4) ? 16 * PK : 0;
#pragma unroll
                for (int dt = 0; dt < 8; ++dt) { const s16x4 a0 = tr16(va + 32 * dt), a1 = tr16(va + o1 + 32 * dt); o[dt] = MFMA16(cat8(a0, a1), Bp, o[dt]); }
            }
            const float inv = 1.0f / l;
#pragma unroll
            for (int dt = 0; dt < 8; ++dt) {
                if (P3_FP8) { const float is = inv * P3_AS; *(unsigned*)((unsigned char*)AO + (tb + qpos) * 1024 + h * 128 + 16 * dt + 4 * g) = pk4_fp8(o[dt][0] * is, o[dt][1] * is, o[dt][2] * is, o[dt][3] * is); }
                else { const unsigned o0 = pk2(o[dt][0] * inv, o[dt][1] * inv), o1 = pk2(o[dt][2] * inv, o[dt][3] * inv);
                *(unsigned long long*)(AO + (tb + qpos) * 1024 + h * 128 + 16 * dt + 4 * g) = (unsigned long long)o0 | ((unsigned long long)o1 << 32); } }
        }
        __syncthreads();
    }
}
template <int CTRL> __device__ __forceinline__ float dppf(float v) { return __builtin_bit_cast(float, __builtin_amdgcn_update_dpp(0, __builtin_bit_cast(int, v), CTRL, 0xF, 0xF, true)); }
template <int CTRL> __device__ __forceinline__ int dppi(int v) { return __builtin_amdgcn_update_dpp(0, v, CTRL, 0xF, 0xF, true); }
__device__ __forceinline__ float g16_max(float v) { v = fmaxf(v, dppf<0xB1>(v)); v = fmaxf(v, dppf<0x4E>(v)); v = fmaxf(v, dppf<0x141>(v)); v = fmaxf(v, dppf<0x140>(v)); return v; }
__device__ __forceinline__ float g16_sum(float v) { v += dppf<0xB1>(v); v += dppf<0x4E>(v); v += dppf<0x141>(v); v += dppf<0x140>(v); return v; }
__device__ __forceinline__ int g16_min(int v) { v = min(v, dppi<0xB1>(v)); v = min(v, dppi<0x4E>(v)); v = min(v, dppi<0x141>(v)); v = min(v, dppi<0x140>(v)); return v; }
__constant__ unsigned char CAND_SLOT[64] = {
    0, 1, 2, 3, 4, 5, 6, 7, 8, 9, 10, 11, 12, 13, 14, 15,
    16, 17, 18, 19, 20, 21, 22, 23, 32, 33, 34, 35, 36, 48, 49, 50,
    51, 64, 65, 66, 80, 81, 96, 97, 112, 113, 128, 144, 160, 176, 192, 208,
    224, 240, 255, 255, 255, 255, 255, 255, 255, 255, 255, 255, 255, 255, 255, 255};
__device__ __forceinline__ void p5_topk_mfma(Frame& F) {
    const bf16* QRY = (const bf16*)(F.ws + WS_PROJ); const bf16* SK = (const bf16*)(F.ws + WS_SK);
    int* IDX = (int*)(F.ws + WS_IDX); float* GATE = (float*)(F.ws + WS_GATE);
    const int lane = opq(F.lane), w = F.wave, g = lane >> 4, fr = lane & 15;
    LAS unsigned char* lds = F.lds;
    int cslot[4];
#pragma unroll
    for (int s = 0; s < 4; ++s) cslot[s] = CAND_SLOT[16 * s + fr];
    for (int u = F.bid; u < 1024; u += F.G) {
        const int tbk = u >> 3, h = u & 7, pp = w >> 2, tt = w & 3;
        bf16x8 af[4];
#pragma unroll
        for (int ds = 0; ds < 4; ++ds) af[ds] = *(const bf16x8*)(QRY + (size_t)(64 * tbk + 16 * tt + fr) * DM + h * 256 + pp * 128 + 32 * ds + 8 * g);
        f32x4 sc[8];
#pragma unroll
        for (int nt = 0; nt < 8; ++nt) { sc[nt] = (f32x4){0.f, 0.f, 0.f, 0.f};
#pragma unroll
            for (int ds = 0; ds < 4; ++ds) { const bf16x8 Bk = *(const bf16x8*)(SK + (size_t)((pp * 8 + h) * 128 + 16 * nt + fr) * 128 + 32 * ds + 8 * g); sc[nt] = MFMA16(af[ds], Bk, sc[nt]); } }
#pragma unroll
        for (int r = 0; r < 4; ++r) {
            float v[8];
#pragma unroll
            for (int nt = 0; nt < 8; ++nt) v[nt] = sc[nt][r];
            float tv = 0.f; int ti = 0;
#pragma unroll 1
            for (int rd = 0; rd < 16; ++rd) {
                float lm = fmaxf(fmaxf(fmaxf(v[0], v[1]), fmaxf(v[2], v[3])), fmaxf(fmaxf(v[4], v[5]), fmaxf(v[6], v[7])));
                const float mx = g16_max(lm);
                int li = 1 << 20;
#pragma unroll
                for (int nt = 7; nt >= 0; --nt) li = (v[nt] == mx) ? (16 * nt + fr) : li;
                const int wi = g16_min(li);
#pragma unroll
                for (int nt = 0; nt < 8; ++nt) v[nt] = (wi == 16 * nt + fr) ? -INFINITY : v[nt];
                if (fr == rd) { tv = mx; ti = wi; }
            }
            const int tok = 16 * tt + 4 * g + r;
            *(LAS f32x2*)(lds + ((tok * 2 + pp) * 16 + fr) * 8) = (f32x2){tv, __int_as_float(ti)};
        }
        __syncthreads();
#pragma unroll 1
        for (int tk = 0; tk < 2; ++tk) {
            const int tok = 8 * w + 2 * g + tk;
            const LAS f32x2* La = (const LAS f32x2*)(lds + (tok * 2 + 0) * 128); const LAS f32x2* Lb = (const LAS f32x2*)(lds + (tok * 2 + 1) * 128);
            float cv[4];
#pragma unroll
            for (int s = 0; s < 4; ++s) { const int ij = cslot[s]; cv[s] = (ij == 255) ? -INFINITY : La[(ij >> 4) & 15].x + Lb[ij & 15].x; }
            float bs = 0.f, m0 = 0.f; int be = 0;
#pragma unroll 1
            for (int rd = 0; rd < 16; ++rd) {
                const float lm = fmaxf(fmaxf(cv[0], cv[1]), fmaxf(cv[2], cv[3]));
                const float mx = g16_max(lm);
                int li = 1 << 20;
#pragma unroll
                for (int s = 3; s >= 0; --s) li = (cv[s] == mx && cslot[s] < li) ? cslot[s] : li;
                const int wf = g16_min(li);
#pragma unroll
                for (int s = 0; s < 4; ++s) cv[s] = (cslot[s] == wf) ? -INFINITY : cv[s];
                if (rd == 0) m0 = mx;
                if (fr == rd) { bs = mx; be = wf; }
            }
            const int ex_id = __float_as_int(La[(be >> 4) & 15].y) * 128 + __float_as_int(Lb[be & 15].y);
            const float ex = __expf(bs - m0); const float sum = g16_sum(ex);
            const size_t o = (size_t)(64 * tbk + tok) * 128 + h * 16 + fr;
            IDX[o] = ex_id; GATE[o] = ex / sum;
        }
        __syncthreads();
    }
}
__device__ __forceinline__ int f2sort(float f) { const int i = __float_as_int(f); return i ^ ((i >> 31) & 0x7fffffff); }
__device__ __forceinline__ float sort2f(int k) { return __int_as_float(k ^ ((k >> 31) & 0x7fffffff)); }
__device__ __forceinline__ int g16_max_i(int v) { v = max(v, dppi<0xB1>(v)); v = max(v, dppi<0x4E>(v)); v = max(v, dppi<0x141>(v)); v = max(v, dppi<0x140>(v)); return v; }
#define TK_CE(a, b) do { const int hi_ = max((a), (b)), lo_ = min((a), (b)); (a) = hi_; (b) = lo_; } while (0)
constexpr int QL_OFF = 86016, QL_PITCH = 528;
__device__ __forceinline__ void p5_topk_v2(Frame& F, int tile_pm = -1, int tile_pn = 0, int half = -1, bool load_keys = true) {
    const bf16* QRY = (const bf16*)(F.ws + WS_PROJ); const bf16* SK = (const bf16*)(F.ws + WS_SK);
    int* IDX = (int*)(F.ws + WS_IDX); float* GATE = (float*)(F.ws + WS_GATE);
    const int lane = opq(F.lane), w = F.wave, g = lane >> 4, fr = lane & 15;
    LAS unsigned char* lds = F.lds + 69632;
    LAS unsigned char* kl = F.lds;
    const bool keys_in_lds = (tile_pm >= 0) || (F.G & 7) == 0;
    if (keys_in_lds && load_keys) { const int hh = (tile_pm >= 0) ? tile_pn : (F.bid & 7);
#pragma unroll
        for (int i = 0; i < 8; ++i) { const int c = F.tid + 512 * i, row = c >> 4, ch = c & 15, pq = row >> 7, n = row & 127;
            *(LAS v4u*)(kl + row * 272 + ch * 16) = *(const v4u*)(SK + (size_t)((pq * 8 + hh) * 128 + n) * 128 + ch * 8); }
        __syncthreads(); }
    int cslot[4];
#pragma unroll
    for (int s = 0; s < 4; ++s) cslot[s] = CAND_SLOT[16 * s + fr];
    const int u_first = (tile_pm >= 0) ? (32 * tile_pm + (half > 0 ? 16 : 0) + tile_pn) : F.bid, u_step = (tile_pm >= 0) ? 8 : F.G, u_end = (tile_pm >= 0) ? (32 * tile_pm + (half == 0 ? 16 : 32)) : 1024;
    for (int u = u_first; u < u_end; u += u_step) {
        const int tbk = u >> 3, h = u & 7, pp = w >> 2, tt = w & 3;
        bf16x8 af[4];
#pragma unroll
        for (int ds = 0; ds < 4; ++ds) { if (half >= 0) af[ds] = *(const LAS bf16x8*)(F.lds + QL_OFF + (64 * (tbk & 1) + 16 * tt + fr) * QL_PITCH + (pp * 128 + 32 * ds + 8 * g) * 2);
            else af[ds] = *(const bf16x8*)(QRY + (size_t)(64 * tbk + 16 * tt + fr) * DM + h * 256 + pp * 128 + 32 * ds + 8 * g); }
        f32x4 sc[8];
#pragma unroll
        for (int nt = 0; nt < 8; ++nt) { sc[nt] = (f32x4){0.f, 0.f, 0.f, 0.f};
#pragma unroll
            for (int ds = 0; ds < 4; ++ds) { bf16x8 Bk;
                if (keys_in_lds) Bk = *(const LAS bf16x8*)(kl + (pp * 128 + 16 * nt + fr) * 272 + (32 * ds + 8 * g) * 2);
                else Bk = *(const bf16x8*)(SK + (size_t)((pp * 8 + h) * 128 + 16 * nt + fr) * 128 + 32 * ds + 8 * g);
                sc[nt] = MFMA16(af[ds], Bk, sc[nt]); } }
        int k[4][8];
#pragma unroll
        for (int r = 0; r < 4; ++r) {
#pragma unroll
            for (int nt = 0; nt < 8; ++nt) k[r][nt] = (f2sort(sc[nt][r]) & ~127) | (127 - (16 * nt + fr));
            TK_CE(k[r][0], k[r][1]); TK_CE(k[r][2], k[r][3]); TK_CE(k[r][4], k[r][5]); TK_CE(k[r][6], k[r][7]);
            TK_CE(k[r][0], k[r][2]); TK_CE(k[r][1], k[r][3]); TK_CE(k[r][4], k[r][6]); TK_CE(k[r][5], k[r][7]);
            TK_CE(k[r][1], k[r][2]); TK_CE(k[r][5], k[r][6]);
            TK_CE(k[r][0], k[r][4]); TK_CE(k[r][1], k[r][5]); TK_CE(k[r][2], k[r][6]); TK_CE(k[r][3], k[r][7]);
            TK_CE(k[r][2], k[r][4]); TK_CE(k[r][3], k[r][5]);
            TK_CE(k[r][1], k[r][2]); TK_CE(k[r][3], k[r][4]); TK_CE(k[r][5], k[r][6]);
        }
        int res[4] = {0, 0, 0, 0};
#pragma unroll 1
        for (int rd = 0; rd < 16; ++rd) {
#pragma unroll
            for (int r = 0; r < 4; ++r) {
                const int mx = g16_max_i(k[r][0]); const bool win = (k[r][0] == mx);
#pragma unroll
                for (int i = 0; i < 7; ++i) k[r][i] = win ? k[r][i + 1] : k[r][i];
                k[r][7] = win ? (int)0x80000000 : k[r][7];
                res[r] = (fr == rd) ? mx : res[r];
            }
        }
#pragma unroll
        for (int r = 0; r < 4; ++r) { const int tok = 16 * tt + 4 * g + r;
            *(LAS f32x2*)(lds + ((tok * 2 + pp) * 16 + fr) * 8) = (f32x2){sort2f(res[r] & ~127), __int_as_float(127 - (res[r] & 127))}; }
        __syncthreads();
        int c[2][4];
#pragma unroll
        for (int tk = 0; tk < 2; ++tk) { const int tok = 8 * w + 2 * g + tk;
            const LAS f32x2* La = (const LAS f32x2*)(lds + (tok * 2 + 0) * 128); const LAS f32x2* Lb = (const LAS f32x2*)(lds + (tok * 2 + 1) * 128);
#pragma unroll
            for (int s = 0; s < 4; ++s) { const int ij = cslot[s]; c[tk][s] = (ij == 255) ? (int)0x80000000 : ((f2sort(La[(ij >> 4) & 15].x + Lb[ij & 15].x) & ~255) | (255 - ij)); }
            TK_CE(c[tk][0], c[tk][1]); TK_CE(c[tk][2], c[tk][3]); TK_CE(c[tk][0], c[tk][2]); TK_CE(c[tk][1], c[tk][3]); TK_CE(c[tk][1], c[tk][2]); }
        int rs2[2] = {0, 0}, m0[2] = {0, 0};
#pragma unroll 1
        for (int rd = 0; rd < 16; ++rd) {
#pragma unroll
            for (int tk = 0; tk < 2; ++tk) {
                const int mx = g16_max_i(c[tk][0]); const bool win = (c[tk][0] == mx);
                c[tk][0] = win ? c[tk][1] : c[tk][0]; c[tk][1] = win ? c[tk][2] : c[tk][1]; c[tk][2] = win ? c[tk][3] : c[tk][2]; c[tk][3] = win ? (int)0x80000000 : c[tk][3];
                rs2[tk] = (fr == rd) ? mx : rs2[tk]; m0[tk] = (rd == 0) ? mx : m0[tk];
            }
        }
#pragma unroll
        for (int tk = 0; tk < 2; ++tk) { const int tok = 8 * w + 2 * g + tk;
            const LAS f32x2* La = (const LAS f32x2*)(lds + (tok * 2 + 0) * 128); const LAS f32x2* Lb = (const LAS f32x2*)(lds + (tok * 2 + 1) * 128);
            const int flat = 255 - (rs2[tk] & 255);
            const int ex_id = __float_as_int(La[(flat >> 4) & 15].y) * 128 + __float_as_int(Lb[flat & 15].y);
            const float ex = __expf(sort2f(rs2[tk] & ~255) - sort2f(m0[tk] & ~255)); const float sum = g16_sum(ex);
            const size_t o = (size_t)(64 * tbk + tok) * 128 + h * 16 + fr;
            IDX[o] = ex_id; GATE[o] = ex / sum; }
        __syncthreads();
    }
}
__device__ __forceinline__ void p5_topk_naive(Frame& F) {
    const bf16* QRY = (const bf16*)(F.ws + WS_PROJ); const bf16* SK = (const bf16*)(F.ws + WS_SK);
    int* IDX = (int*)(F.ws + WS_IDX); float* GATE = (float*)(F.ws + WS_GATE); const int lane = F.lane;
    LAS float* wts = (LAS float*)(F.lds + F.wave * 512); LAS int* wti = (LAS int*)(F.lds + F.wave * 512 + 128);
    LAS float* wbs = (LAS float*)(F.lds + F.wave * 512 + 256); LAS int* wbi = (LAS int*)(F.lds + F.wave * 512 + 320);
    for (int it = F.gw; it < T * 8; it += F.NGW) {
        const int t = it >> 3, h = it & 7;
#pragma unroll
        for (int p = 0; p < 2; ++p) {
            const v4u* qr = (const v4u*)(QRY + (size_t)t * DM + h * 256 + p * 128);
            v4u q[16];
#pragma unroll
            for (int i = 0; i < 16; ++i) q[i] = qr[i];
            float v[2];
#pragma unroll
            for (int half = 0; half < 2; ++half) { const v4u* kr = (const v4u*)(SK + ((size_t)((p * 8 + h) * 128 + lane + 64 * half)) * 128); float acc = 0.f;
#pragma unroll
                for (int i = 0; i < 16; ++i) acc = dot8(q[i], kr[i], acc);
                v[half] = acc; }
#pragma unroll
            for (int r = 0; r < 16; ++r) {
                const float bv = fmaxf(v[0], v[1]); const int bi = (v[0] >= v[1]) ? lane : lane + 64;
                const float mx = wave_max(bv);
                const int widx = wave_min_i(bv == mx ? bi : 1 << 20);
                if (lane == 0) { wts[p * 16 + r] = mx; wti[p * 16 + r] = widx; }
                if (lane == (widx & 63)) { if (widx < 64) v[0] = -INFINITY; else v[1] = -INFINITY; }
            }
        }
        LDS_WAIT(); asm volatile("" ::: "memory");
        float cv[4];
        const float tb = wts[16 + (lane & 15)];
#pragma unroll
        for (int qq = 0; qq < 4; ++qq) cv[qq] = wts[(lane >> 4) + 4 * qq] + tb;
#pragma unroll
        for (int r = 0; r < 16; ++r) {
            float bv = cv[0]; int bf = lane;
#pragma unroll
            for (int qq = 1; qq < 4; ++qq) if (cv[qq] > bv) { bv = cv[qq]; bf = lane + 64 * qq; }
            const float mx = wave_max(bv);
            const int fmin = wave_min_i(bv == mx ? bf : 1 << 20);
            if (lane == 0) { wbs[r] = mx; wbi[r] = wti[fmin >> 4] * 128 + wti[16 + (fmin & 15)]; }
            if (lane == (fmin & 63)) {
#pragma unroll
                for (int qq = 0; qq < 4; ++qq) if ((fmin >> 6) == qq) cv[qq] = -INFINITY; }
        }
        LDS_WAIT(); asm volatile("" ::: "memory");
        const float bs = (lane < 16) ? wbs[lane] : -INFINITY; const float bmax = wbs[0];
        const float ex = (lane < 16) ? __expf(bs - bmax) : 0.f; const float sum = wave_sum(ex);
        if (lane < 16) { IDX[(size_t)t * 128 + h * 16 + lane] = wbi[lane]; GATE[(size_t)t * 128 + h * 16 + lane] = ex / sum; }
        LDS_WAIT(); asm volatile("" ::: "memory");
    }
}
__device__ __forceinline__ float gelu_erf(float v) { return 0.5f * v * (1.0f + erff(v * 0.70710678118654752f)); }
__device__ __forceinline__ void p6_peer(Frame& F) {
    const bf16* ED = (const bf16*)(F.ws + WS_ED); const bf16* EU = (const bf16*)(F.ws + WS_EU);
    const int* IDX = (const int*)(F.ws + WS_IDX); const float* GATE = (const float*)(F.ws + WS_GATE); const float* ssq = (const float*)(F.ws + WS_SSQ);
    const int lane = F.lane;
    for (int t = F.gw; t < T; t += F.NGW) {
        float* hrow = F.out + (size_t)t * DM;
        const float r2 = 1.0f / sqrtf(__hip_atomic_load(ssq + t, __ATOMIC_RELAXED, __HIP_MEMORY_SCOPE_AGENT) * (1.0f / DM) + EPS);
        v4u hn[4];
#pragma unroll
        for (int j = 0; j < 4; ++j) { const f32x4 a = ((const f32x4*)hrow)[128 * j + 2 * lane], b = ((const f32x4*)hrow)[128 * j + 2 * lane + 1];
            const f32x4 ga = ((const f32x4*)F.ffn_norm)[128 * j + 2 * lane], gb = ((const f32x4*)F.ffn_norm)[128 * j + 2 * lane + 1];
            hn[j] = pack8(a * r2 * ga, b * r2 * gb); }
        const int id0 = IDX[(size_t)t * 128 + lane], id1 = IDX[(size_t)t * 128 + 64 + lane];
        const float g0 = GATE[(size_t)t * 128 + lane], g1 = GATE[(size_t)t * 128 + 64 + lane];
        float c0 = 0.f, c1 = 0.f;
#pragma unroll 1
        for (int e0 = 0; e0 < 128; e0 += 4) {
            float part[4];
#pragma unroll
            for (int ee = 0; ee < 4; ++ee) { const int e = e0 + ee; const int row = rdlane_i(e < 64 ? id0 : id1, e & 63);
                const v4u* rp = (const v4u*)(ED + (size_t)row * DM) + lane; float acc = 0.f;
#pragma unroll
                for (int j = 0; j < 4; ++j) acc = dot8(hn[j], rp[64 * j], acc);
                part[ee] = acc; }
#pragma unroll
            for (int ee = 0; ee < 4; ++ee) { const int e = e0 + ee; const float uu = wave_sum(part[ee]); const float cc = gelu_erf(uu);
                if (lane == (e & 63)) { if (e < 64) c0 = cc * g0; else c1 = cc * g1; } }
        }
        f32x4 y[8];
#pragma unroll
        for (int j = 0; j < 8; ++j) y[j] = (f32x4){0.f, 0.f, 0.f, 0.f};
#pragma unroll 1
        for (int e0 = 0; e0 < 128; e0 += 4) {
#pragma unroll
            for (int ee = 0; ee < 4; ++ee) { const int e = e0 + ee; const int row = rdlane_i(e < 64 ? id0 : id1, e & 63); const float ce = rdlane(e < 64 ? c0 : c1, e & 63);
                const v4u* rp = (const v4u*)(EU + (size_t)row * DM) + lane;
#pragma unroll
                for (int j = 0; j < 4; ++j) { const v4u w = rp[64 * j];
                    y[2 * j][0] += ce * bflo(w.x); y[2 * j][1] += ce * bfhi(w.x); y[2 * j][2] += ce * bflo(w.y); y[2 * j][3] += ce * bfhi(w.y);
                    y[2 * j + 1][0] += ce * bflo(w.z); y[2 * j + 1][1] += ce * bfhi(w.z); y[2 * j + 1][2] += ce * bflo(w.w); y[2 * j + 1][3] += ce * bfhi(w.w); } }
        }
        float ss = 0.f;
#pragma unroll
        for (int j = 0; j < 4; ++j) { const f32x4 a = ((const f32x4*)hrow)[128 * j + 2 * lane], b = ((const f32x4*)hrow)[128 * j + 2 * lane + 1];
            y[2 * j] += a; y[2 * j + 1] += b;
            const f32x4 u0 = y[2 * j], u1 = y[2 * j + 1];
            ss += (u0[0] * u0[0] + u0[1] * u0[1]) + (u0[2] * u0[2] + u0[3] * u0[3]) + (u1[0] * u1[0] + u1[1] * u1[1]) + (u1[2] * u1[2] + u1[3] * u1[3]); }
        const float rf = 1.0f / sqrtf(wave_sum(ss) * (1.0f / DM) + EPS);
#pragma unroll
        for (int j = 0; j < 4; ++j) { const f32x4 ga = ((const f32x4*)F.final_norm)[128 * j + 2 * lane], gb = ((const f32x4*)F.final_norm)[128 * j + 2 * lane + 1];
            ((f32x4*)hrow)[128 * j + 2 * lane] = y[2 * j] * rf * ga; ((f32x4*)hrow)[128 * j + 2 * lane + 1] = y[2 * j + 1] * rf * gb; }
    }
}

#ifndef PEER_FP8
#define PEER_FP8 1
#endif
constexpr size_t WS_ESC = WS_SK + 512 * 1024;
__device__ __forceinline__ float wave_sum_fast(float v) { v = g16_sum(v); v += __shfl_xor(v, 16); v += __shfl_xor(v, 32); return v; }
template <bool FP8> __device__ __forceinline__ void p6_peer2(Frame& F) {
    constexpr int NCH = FP8 ? 2 : 4, ROWB = FP8 ? 2048 : 4096, NR = FP8 ? 4 : 2;
    const unsigned char* ED = F.ws + WS_ED; const unsigned char* EU = F.ws + WS_EU; const float* ESC = (const float*)(F.ws + WS_ESC);
    const int* IDX = (const int*)(F.ws + WS_IDX); const float* GATE = (const float*)(F.ws + WS_GATE); const float* ssq = (const float*)(F.ws + WS_SSQ);
    const int lane = F.lane;
#define P6_LOAD(BUF, TAB, E0) do { _Pragma("unroll") for (int ee = 0; ee < NR; ++ee) { const int e_ = (E0) + ee; const int row_ = rdlane_i(e_ < 64 ? id0 : id1, e_ & 63); \
        const v4u* rp_ = (const v4u*)((TAB) + (size_t)row_ * ROWB) + lane; _Pragma("unroll") for (int j = 0; j < NCH; ++j) BUF[ee][j] = rp_[64 * j]; } } while (0)
#define P6_DOTS(BUF, E0) do { _Pragma("unroll") for (int ee = 0; ee < NR; ++ee) { const int e_ = (E0) + ee; float part_; \
        if constexpr (FP8) { f32x2 acc_ = {0.f, 0.f}; \
            _Pragma("unroll") for (int j = 0; j < 2; ++j) { const unsigned wd_[4] = {BUF[ee][j].x, BUF[ee][j].y, BUF[ee][j].z, BUF[ee][j].w}; \
                _Pragma("unroll") for (int k = 0; k < 4; ++k) { acc_ = __builtin_elementwise_fma(hf[8 * j + 2 * k], __builtin_amdgcn_cvt_pk_f32_fp8((int)wd_[k], false), acc_); \
                    acc_ = __builtin_elementwise_fma(hf[8 * j + 2 * k + 1], __builtin_amdgcn_cvt_pk_f32_fp8((int)wd_[k], true), acc_); } } \
            part_ = acc_.x + acc_.y; \
        } else { part_ = 0.f; _Pragma("unroll") for (int j = 0; j < NCH; ++j) part_ = dot8(hn[j & 3], BUF[ee][j], part_); } \
        float uu_ = wave_sum_fast(part_); \
        if constexpr (FP8) { const int row_ = rdlane_i(e_ < 64 ? id0 : id1, e_ & 63); uu_ *= ESC[row_]; } \
        const float cc_ = gelu_erf(uu_); \
        if (lane == (e_ & 63)) { if (e_ < 64) c0 = cc_ * g0; else c1 = cc_ * g1; } \
        asm volatile("" ::: "memory"); } } while (0)
#define P6_AXPY(BUF, E0) do { _Pragma("unroll") for (int ee = 0; ee < NR; ++ee) { const int e_ = (E0) + ee; float ce_ = rdlane(e_ < 64 ? c0 : c1, e_ & 63); \
        if constexpr (FP8) { const int row_ = rdlane_i(e_ < 64 ? id0 : id1, e_ & 63); ce_ *= ESC[NEXP + row_]; const f32x2 ce2_ = {ce_, ce_}; \
            _Pragma("unroll") for (int j = 0; j < 2; ++j) { const unsigned wd_[4] = {BUF[ee][j].x, BUF[ee][j].y, BUF[ee][j].z, BUF[ee][j].w}; \
                _Pragma("unroll") for (int k = 0; k < 4; ++k) { f32x2 lo_ = {y[4 * j + k][0], y[4 * j + k][1]}, hi_ = {y[4 * j + k][2], y[4 * j + k][3]}; \
                    lo_ = __builtin_elementwise_fma(ce2_, __builtin_amdgcn_cvt_pk_f32_fp8((int)wd_[k], false), lo_); hi_ = __builtin_elementwise_fma(ce2_, __builtin_amdgcn_cvt_pk_f32_fp8((int)wd_[k], true), hi_); \
                    y[4 * j + k] = (f32x4){lo_.x, lo_.y, hi_.x, hi_.y}; } } \
        } else { _Pragma("unroll") for (int j = 0; j < NCH; ++j) { const v4u w_ = BUF[ee][j]; const int a_ = (2 * j) & 7, b_ = (2 * j + 1) & 7; \
                y[a_][0] += ce_ * bflo(w_.x); y[a_][1] += ce_ * bfhi(w_.x); y[a_][2] += ce_ * bflo(w_.y); y[a_][3] += ce_ * bfhi(w_.y); \
                y[b_][0] += ce_ * bflo(w_.z); y[b_][1] += ce_ * bfhi(w_.z); y[b_][2] += ce_ * bflo(w_.w); y[b_][3] += ce_ * bfhi(w_.w); } } } } while (0)
#pragma unroll 1
    for (int t = F.gw; t < T; t += F.NGW) {
        float* hrow = F.out + (size_t)t * DM;
        const float r2 = 1.0f / sqrtf(__hip_atomic_load(ssq + t, __ATOMIC_RELAXED, __HIP_MEMORY_SCOPE_AGENT) * (1.0f / DM) + EPS);
        v4u hn[4]; f32x2 hf[16];
        if constexpr (FP8) {
#pragma unroll
            for (int j = 0; j < 2; ++j)
#pragma unroll
                for (int k = 0; k < 4; ++k) { const f32x4 a = ((const f32x4*)hrow)[256 * j + 4 * lane + k] * r2 * ((const f32x4*)F.ffn_norm)[256 * j + 4 * lane + k];
                    hf[8 * j + 2 * k] = (f32x2){a[0], a[1]}; hf[8 * j + 2 * k + 1] = (f32x2){a[2], a[3]}; }
        } else {
#pragma unroll
            for (int j = 0; j < 4; ++j) { const f32x4 a = ((const f32x4*)hrow)[128 * j + 2 * lane], b = ((const f32x4*)hrow)[128 * j + 2 * lane + 1];
                const f32x4 ga = ((const f32x4*)F.ffn_norm)[128 * j + 2 * lane], gb = ((const f32x4*)F.ffn_norm)[128 * j + 2 * lane + 1];
                hn[j] = pack8(a * r2 * ga, b * r2 * gb); }
        }
        const int id0 = IDX[(size_t)t * 128 + lane], id1 = IDX[(size_t)t * 128 + 64 + lane];
        const float g0 = GATE[(size_t)t * 128 + lane], g1 = GATE[(size_t)t * 128 + 64 + lane];
        float c0 = 0.f, c1 = 0.f;
        v4u A[NR][NCH], B[NR][NCH];
        P6_LOAD(A, ED, 0);
#pragma unroll 1
        for (int e0 = 0; e0 < 128; e0 += 2 * NR) {
            P6_LOAD(B, ED, e0 + NR);
            P6_DOTS(A, e0);
            if (e0 + 2 * NR < 128) P6_LOAD(A, ED, e0 + 2 * NR);
            P6_DOTS(B, e0 + NR);
        }
        f32x4 y[8];
#pragma unroll
        for (int j = 0; j < 8; ++j) y[j] = (f32x4){0.f, 0.f, 0.f, 0.f};
        P6_LOAD(A, EU, 0);
#pragma unroll 1
        for (int e0 = 0; e0 < 128; e0 += 2 * NR) {
            P6_LOAD(B, EU, e0 + NR);
            P6_AXPY(A, e0);
            if (e0 + 2 * NR < 128) P6_LOAD(A, EU, e0 + 2 * NR);
            P6_AXPY(B, e0 + NR);
        }
        float ss = 0.f;
#pragma unroll
        for (int j = 0; j < 8; ++j) { const int fi = FP8 ? (256 * (j >> 2) + 4 * lane + (j & 3)) : (128 * (j >> 1) + 2 * lane + (j & 1));
            y[j] += ((const f32x4*)hrow)[fi]; ss += (y[j][0] * y[j][0] + y[j][1] * y[j][1]) + (y[j][2] * y[j][2] + y[j][3] * y[j][3]); }
        const float rf = 1.0f / sqrtf(wave_sum(ss) * (1.0f / DM) + EPS);
#pragma unroll
        for (int j = 0; j < 8; ++j) { const int fi = FP8 ? (256 * (j >> 2) + 4 * lane + (j & 3)) : (128 * (j >> 1) + 2 * lane + (j & 1));
            ((f32x4*)hrow)[fi] = y[j] * rf * ((const f32x4*)F.final_norm)[fi]; }
    }
#undef P6_LOAD
#undef P6_DOTS
#undef P6_AXPY
}
__device__ __forceinline__ void p0_experts_fp8(Frame& F) {
    const int lane = F.lane; float* ESC = (float*)(F.ws + WS_ESC);
    for (int row = F.gw; row < 2 * NEXP; row += F.NGW) {
        const float* src = (row < NEXP) ? F.e_down + (size_t)row * DM : F.e_up + (size_t)(row - NEXP) * DM;
        unsigned char* dst = (row < NEXP) ? F.ws + WS_ED + (size_t)row * 2048 : F.ws + WS_EU + (size_t)(row - NEXP) * 2048;
        f32x4 v[8]; float am = 0.f;
#pragma unroll
        for (int j = 0; j < 2; ++j)
#pragma unroll
            for (int k = 0; k < 4; ++k) { const f32x4 a = ((const f32x4*)src)[256 * j + 4 * lane + k]; v[4 * j + k] = a;
                am = fmaxf(am, fmaxf(fmaxf(fabsf(a[0]), fabsf(a[1])), fmaxf(fabsf(a[2]), fabsf(a[3])))); }
        am = wave_max(am); if (!(am > 0.f)) am = 1.0f;
        const float sc = 448.0f / am;
        if (lane == 0) ESC[row] = am * (1.0f / 448.0f);
#pragma unroll
        for (int j = 0; j < 2; ++j) { v4u o;
#pragma unroll
            for (int k = 0; k < 4; ++k) { const f32x4 a = v[4 * j + k] * sc; int pw = 0; pw = __builtin_amdgcn_cvt_pk_fp8_f32(a[0], a[1], pw, false); pw = __builtin_amdgcn_cvt_pk_fp8_f32(a[2], a[3], pw, true);
                if (k == 0) o.x = (unsigned)pw; else if (k == 1) o.y = (unsigned)pw; else if (k == 2) o.z = (unsigned)pw; else o.w = (unsigned)pw; }
            *(v4u*)(dst + 1024 * j + 16 * lane) = o; }
    }
}
typedef float f32x16 __attribute__((ext_vector_type(16)));
typedef float f32x32 __attribute__((ext_vector_type(32)));
typedef unsigned u32x6 __attribute__((ext_vector_type(6)));
typedef unsigned u32x2 __attribute__((ext_vector_type(2)));
struct EpiQryLds {
    static constexpr bool PERM = true, AFTER_DRAIN = true;
    Frame& F; const float* ssq;
    __device__ __forceinline__ void operator()(const pg8::f32x4 (&)[2][2][4][2], const pg8::Unit&, int, int, int, int) const {}
    __device__ __forceinline__ void fused(const pg8::f32x4 (&acc)[2][2][4][2], const pg8::Unit& u, int wr, int wc, int fr, int fq, LAS unsigned char* lds, int, int) const {
        const int upm = __builtin_amdgcn_readfirstlane(u.pm), upn = __builtin_amdgcn_readfirstlane(u.pn);
        v4u pk[2][4][2];
#pragma unroll
        for (int half = 0; half < 2; ++half)
#pragma unroll
            for (int m = 0; m < 4; ++m) { const int rl = wr * 64 + 16 * m + fr;
                const float rs = 1.0f / sqrtf(__hip_atomic_load(ssq + upm * 256 + 128 * half + rl, __ATOMIC_RELAXED, __HIP_MEMORY_SCOPE_AGENT) * (1.0f / DM) + EPS);
#pragma unroll
                for (int bj = 0; bj < 2; ++bj) { const pg8::f32x4 v0 = acc[half][bj][m][0] * rs, v1 = acc[half][bj][m][1] * rs;
                    v4u w; w.x = pg8::cvt_pk_bf16(v0[0], v0[1]); w.y = pg8::cvt_pk_bf16(v0[2], v0[3]); w.z = pg8::cvt_pk_bf16(v1[0], v1[1]); w.w = pg8::cvt_pk_bf16(v1[2], v1[3]); pk[half][m][bj] = w; } }
#pragma unroll
        for (int half = 0; half < 2; ++half) {
#pragma unroll
            for (int m = 0; m < 4; ++m)
#pragma unroll
                for (int bj = 0; bj < 2; ++bj) *(LAS v4u*)(lds + QL_OFF + (wr * 64 + 16 * m + fr) * QL_PITCH + (128 * bj + 32 * wc + 8 * fq) * 2) = pk[half][m][bj];
            __syncthreads();
            p5_topk_v2(F, upm, upn, half, half == 0);
            __syncthreads();
        }
    }
};
struct __attribute__((packed, aligned(4))) U3 { unsigned a, b, c; };
__device__ __forceinline__ void p0_experts_fp6(Frame& F) {
    const int lane = F.lane; float* ESC = (float*)(F.ws + WS_ESC);
    for (int row = F.gw; row < 2 * NEXP; row += F.NGW) {
        const float* src = (row < NEXP) ? F.e_down + (size_t)row * DM : F.e_up + (size_t)(row - NEXP) * DM;
        unsigned char* dst = (row < NEXP) ? F.ws + WS_ED + (size_t)row * 1536 : F.ws + WS_EU + (size_t)(row - NEXP) * 1536;
        f32x4 v[8]; float am = 0.f;
#pragma unroll
        for (int i = 0; i < 8; ++i) { const f32x4 a = ((const f32x4*)src)[64 * i + lane]; v[i] = a;
            am = fmaxf(am, fmaxf(fmaxf(fabsf(a[0]), fabsf(a[1])), fmaxf(fabsf(a[2]), fabsf(a[3])))); }
        am = wave_max(am); if (!(am > 0.f)) am = 1.0f;
        const float sc = 7.5f / am;
        if (lane == 0) ESC[row] = am * (1.0f / 7.5f);
        f32x16 x, y;
#pragma unroll
        for (int k = 0; k < 16; ++k) { x[k] = v[k >> 1][2 * (k & 1)] * sc; y[k] = v[k >> 1][2 * (k & 1) + 1] * sc; }
        const u32x6 p = __builtin_amdgcn_cvt_scalef32_2xpk16_fp6_f32(x, y, 1.0f);
        *(v4u*)(dst + 16 * lane) = (v4u){p[0], p[1], p[2], p[3]};
        *(u32x2*)(dst + 1024 + 8 * lane) = (u32x2){p[4], p[5]};
    }
}
__device__ __forceinline__ void p6_peer_fp6(Frame& F) {
    constexpr int ROWB = 1536, NR = 4;
    const unsigned char* ED = F.ws + WS_ED; const unsigned char* EU = F.ws + WS_EU; const float* ESC = (const float*)(F.ws + WS_ESC);
    const int* IDX = (const int*)(F.ws + WS_IDX); const float* GATE = (const float*)(F.ws + WS_GATE); const float* ssq = (const float*)(F.ws + WS_SSQ);
    const int lane = F.lane;
#define P6F_LOAD(BA, BB, TAB, E0) do { _Pragma("unroll") for (int ee = 0; ee < NR; ++ee) { const int e_ = (E0) + ee; const int row_ = rdlane_i(e_ < 64 ? id0 : id1, e_ & 63); \
        const unsigned char* rp_ = (TAB) + (size_t)row_ * ROWB; BA[ee] = *(const v4u*)(rp_ + 16 * lane); BB[ee] = *(const u32x2*)(rp_ + 1024 + 8 * lane); } } while (0)
#define P6F_DEC(BA, BB, ee) __builtin_amdgcn_cvt_scalef32_pk32_f32_fp6((u32x6){BA[ee].x, BA[ee].y, BA[ee].z, BA[ee].w, BB[ee].x, BB[ee].y}, 1.0f)
#define P6F_DOTS(BA, BB, E0) do { _Pragma("unroll") for (int ee = 0; ee < NR; ++ee) { const int e_ = (E0) + ee; const f32x32 w_ = P6F_DEC(BA, BB, ee); \
        float p0_ = 0.f, p1_ = 0.f; _Pragma("unroll") for (int i = 0; i < 16; ++i) { p0_ += hf[2 * i] * w_[2 * i]; p1_ += hf[2 * i + 1] * w_[2 * i + 1]; } \
        const int row_ = rdlane_i(e_ < 64 ? id0 : id1, e_ & 63); const float uu_ = wave_sum_fast(p0_ + p1_) * ESC[row_]; \
        const float cc_ = gelu_erf(uu_); \
        if (lane == (e_ & 63)) { if (e_ < 64) c0 = cc_ * g0; else c1 = cc_ * g1; } \
        __builtin_amdgcn_sched_barrier(0); } } while (0)
#define P6F_AXPY(BA, BB, E0) do { _Pragma("unroll") for (int ee = 0; ee < NR; ++ee) { const int e_ = (E0) + ee; const int row_ = rdlane_i(e_ < 64 ? id0 : id1, e_ & 63); \
        const float ce_ = rdlane(e_ < 64 ? c0 : c1, e_ & 63) * ESC[NEXP + row_]; const f32x32 w_ = P6F_DEC(BA, BB, ee); \
        _Pragma("unroll") for (int i = 0; i < 32; ++i) y[i] += ce_ * w_[i]; __builtin_amdgcn_sched_barrier(0); } } while (0)
#pragma unroll 1
    for (int t = F.gw; t < T; t += F.NGW) {
        float* hrow = F.out + (size_t)t * DM;
        const float r2 = 1.0f / sqrtf(__hip_atomic_load(ssq + t, __ATOMIC_RELAXED, __HIP_MEMORY_SCOPE_AGENT) * (1.0f / DM) + EPS);
        int ln = lane; asm volatile("" : "+v"(ln));
        float hf[32];
#pragma unroll
        for (int i = 0; i < 8; ++i) { const f32x4 a = ((const f32x4*)hrow)[64 * i + ln] * r2 * ((const f32x4*)F.ffn_norm)[64 * i + ln];
            hf[4 * i] = a[0]; hf[4 * i + 1] = a[1]; hf[4 * i + 2] = a[2]; hf[4 * i + 3] = a[3]; }
        const int id0 = IDX[(size_t)t * 128 + lane], id1 = IDX[(size_t)t * 128 + 64 + lane];
        const float g0 = GATE[(size_t)t * 128 + lane], g1 = GATE[(size_t)t * 128 + 64 + lane];
        float c0 = 0.f, c1 = 0.f;
        v4u A0[NR], B0[NR]; u32x2 A1[NR], B1[NR];
        P6F_LOAD(A0, A1, ED, 0);
#pragma unroll 1
        for (int e0 = 0; e0 < 128; e0 += 2 * NR) {
            P6F_LOAD(B0, B1, ED, e0 + NR);
            P6F_DOTS(A0, A1, e0);
            if (e0 + 2 * NR < 128) P6F_LOAD(A0, A1, ED, e0 + 2 * NR);
            P6F_DOTS(B0, B1, e0 + NR);
        }
        float y[32];
#pragma unroll
        for (int i = 0; i < 32; ++i) y[i] = 0.f;
        P6F_LOAD(A0, A1, EU, 0);
#pragma unroll 1
        for (int e0 = 0; e0 < 128; e0 += 2 * NR) {
            P6F_LOAD(B0, B1, EU, e0 + NR);
            P6F_AXPY(A0, A1, e0);
            if (e0 + 2 * NR < 128) P6F_LOAD(A0, A1, EU, e0 + 2 * NR);
            P6F_AXPY(B0, B1, e0 + NR);
        }
        float ss = 0.f; int l2 = lane; asm volatile("" : "+v"(l2));
#pragma unroll
        for (int i = 0; i < 8; ++i) { const f32x4 a = ((const f32x4*)hrow)[64 * i + l2];
            y[4 * i] += a[0]; y[4 * i + 1] += a[1]; y[4 * i + 2] += a[2]; y[4 * i + 3] += a[3];
            ss += (y[4 * i] * y[4 * i] + y[4 * i + 1] * y[4 * i + 1]) + (y[4 * i + 2] * y[4 * i + 2] + y[4 * i + 3] * y[4 * i + 3]); }
        const float rf = 1.0f / sqrtf(wave_sum(ss) * (1.0f / DM) + EPS);
#pragma unroll
        for (int i = 0; i < 8; ++i) { const f32x4 gf = ((const f32x4*)F.final_norm)[64 * i + l2];
            ((f32x4*)hrow)[64 * i + l2] = (f32x4){y[4 * i] * rf * gf[0], y[4 * i + 1] * rf * gf[1], y[4 * i + 2] * rf * gf[2], y[4 * i + 3] * rf * gf[3]}; }
    }
#undef P6F_LOAD
#undef P6F_DEC
#undef P6F_DOTS
#undef P6F_AXPY
}
constexpr size_t WS_U = WS_XB;
constexpr size_t WS_SSZ = 256 * 1024;
__device__ __forceinline__ void p0_experts_fp6s(Frame& F) {
    const int lane = F.lane; float* ESC = (float*)(F.ws + WS_ESC);
    for (int row = F.gw; row < 2 * NEXP; row += F.NGW) {
        const bool dn = row < NEXP; const int e = dn ? row : row - NEXP;
        const float* src = (dn ? F.e_down : F.e_up) + (size_t)e * DM;
        unsigned char* dst = F.ws + (dn ? WS_ED : WS_EU) + ((size_t)(lane >> 3) * NEXP + e) * 192;
        LAS f32x4* rs = (LAS f32x4*)(F.lds + F.wave * 16640);
#pragma unroll
        for (int i = 0; i < 8; ++i) { const int idx = 64 * i + lane; f32x4 a = __builtin_nontemporal_load((const f32x4*)src + idx); if (dn) a = a * ((const f32x4*)F.ffn_norm)[idx];
            rs[idx + (idx >> 3)] = a; }
        LDS_WAIT(); asm volatile("" ::: "memory");
        f32x4 v[8]; float am = 0.f;
#pragma unroll
        for (int i = 0; i < 8; ++i) { const int idx = 8 * lane + i; const f32x4 a = rs[idx + (idx >> 3)];
            v[i] = a; am = fmaxf(am, fmaxf(fmaxf(fabsf(a[0]), fabsf(a[1])), fmaxf(fabsf(a[2]), fabsf(a[3])))); }
        LDS_WAIT(); asm volatile("" ::: "memory");
        am = wave_max(am); if (!(am > 0.f)) am = 1.0f;
        const float sc = 7.5f / am;
        if (lane == 0) ESC[row] = am * (1.0f / 7.5f);
        f32x16 x, y;
#pragma unroll
        for (int k = 0; k < 16; ++k) { x[k] = v[k >> 1][2 * (k & 1)] * sc; y[k] = v[k >> 1][2 * (k & 1) + 1] * sc; }
        const u32x6 p = __builtin_amdgcn_cvt_scalef32_2xpk16_fp6_f32(x, y, 1.0f);
        const int s = lane & 7;
        *(U3*)(dst + 12 * s) = (U3){p[0], p[1], p[2]};
        *(U3*)(dst + 96 + 12 * s) = (U3){p[3], p[4], p[5]};
    }
}
__device__ __forceinline__ float g8_sum(float v) { v += dppf<0xB1>(v); v += dppf<0x4E>(v); v += dppf<0x141>(v); return v; }
#define P6S_LOADN(BA, BB, N_, TAB, IT0, IDA_, IDB_) do { _Pragma("unroll") for (int q_ = 0; q_ < (N_); ++q_) { const int it_ = (IT0) + q_; const int e_ = __shfl((it_ < 8) ? (IDA_) : (IDB_), gq + 8 * (it_ & 7)); \
        const unsigned char* rp_ = (TAB) + (size_t)e_ * 192; BA[q_] = *(const v4u*)(rp_ + 16 * s); BB[q_] = *(const u32x2*)(rp_ + 128 + 8 * s); } } while (0)
#define P6S_DEC(BA, BB, q_) __builtin_amdgcn_cvt_scalef32_pk32_f32_fp6((u32x6){BA[q_].x, BA[q_].y, BA[q_].z, BA[q_].w, BB[q_].x, BB[q_].y}, 1.0f)
__device__ __forceinline__ void p6a_down(Frame& F) {
    const int lane = F.lane, gq = lane >> 3, s = lane & 7, x = F.bid & 7, wsl = (F.bid >> 3) * NWAVES + F.wave, nws = (F.G >> 3) * NWAVES;
    const unsigned char* TAB = F.ws + WS_ED + (size_t)x * NEXP * 192;
    const int* IDX = (const int*)(F.ws + WS_IDX); const float* ssq = (const float*)(F.ws + WS_SSQ); float* U = (float*)(F.ws + WS_U) + (size_t)x * T * 128;
    int t = wsl; if (t >= T) return;
    f32x4 hc[8], hx[8]; float sq, sqn = 0.f, r2; int idA, idB, idAn = 0, idBn = 0;
#define P6A_FETCH(HH, SQ_, TT, IA_, IB_) do { const float* hr_ = F.out + (size_t)(TT) * DM; _Pragma("unroll") for (int i = 0; i < 8; ++i) HH[i] = ((const f32x4*)hr_)[64 * x + 8 * s + i]; \
        SQ_ = __hip_atomic_load(ssq + (TT), __ATOMIC_RELAXED, __HIP_MEMORY_SCOPE_AGENT); IA_ = IDX[(size_t)(TT) * 128 + lane]; IB_ = IDX[(size_t)(TT) * 128 + 64 + lane]; } while (0)
#define P6S_DOT1(BA, BB, q_, IT_) do { const f32x32 w_ = P6S_DEC(BA, BB, q_); float p0_ = 0.f, p1_ = 0.f; \
        _Pragma("unroll") for (int i = 0; i < 8; ++i) { p0_ += hc[i][0] * w_[4 * i]; p1_ += hc[i][1] * w_[4 * i + 1]; p0_ += hc[i][2] * w_[4 * i + 2]; p1_ += hc[i][3] * w_[4 * i + 3]; } \
        const float d_ = g8_sum(p0_ + p1_) * r2; if (s == 0) U[(size_t)t * 128 + gq + 8 * (IT_)] = d_; \
        __builtin_amdgcn_sched_barrier(0); } while (0)
#define P6S_DOTS(BA, BB, IT0) do { P6S_DOT1(BA, BB, 0, (IT0)); P6S_DOT1(BA, BB, 1, (IT0) + 1); P6S_DOT1(BA, BB, 2, (IT0) + 2); P6S_DOT1(BA, BB, 3, (IT0) + 3); } while (0)
    P6A_FETCH(hc, sq, t, idA, idB); r2 = 1.0f / sqrtf(sq * (1.0f / DM) + EPS);
    int tn = t + nws; if (tn < T) P6A_FETCH(hx, sqn, tn, idAn, idBn);
    v4u A0[4], B0[4]; u32x2 A1[4], B1[4];
    P6S_LOADN(A0, A1, 4, TAB, 0, idA, idB);
#pragma unroll 1
    for (;;) {
        P6S_LOADN(B0, B1, 4, TAB, 4, idA, idB); P6S_DOTS(A0, A1, 0);
        P6S_LOADN(A0, A1, 4, TAB, 8, idA, idB); P6S_DOTS(B0, B1, 4);
        P6S_LOADN(B0, B1, 4, TAB, 12, idA, idB); P6S_DOTS(A0, A1, 8);
        const bool more = tn < T;
        if (more) P6S_LOADN(A0, A1, 4, TAB, 0, idAn, idBn);
        P6S_DOTS(B0, B1, 12);
        if (!more) break;
        t = tn; idA = idAn; idB = idBn; r2 = 1.0f / sqrtf(sqn * (1.0f / DM) + EPS);
#pragma unroll
        for (int i = 0; i < 8; ++i) hc[i] = hx[i];
        tn += nws; if (tn < T) P6A_FETCH(hx, sqn, tn, idAn, idBn);
    }
#undef P6S_DOTS
#undef P6S_DOT1
#undef P6A_FETCH
}
__device__ __forceinline__ void p6b_up(Frame& F) {
    const int lane = F.lane, gq = lane >> 3, s = lane & 7, x = F.bid & 7, wsl = (F.bid >> 3) * NWAVES + F.wave, nws = (F.G >> 3) * NWAVES;
    const unsigned char* TAB = F.ws + WS_EU + (size_t)x * NEXP * 192;
    const int* IDX = (const int*)(F.ws + WS_IDX); const float* GATE = (const float*)(F.ws + WS_GATE); const float* ESC = (const float*)(F.ws + WS_ESC);
    const float* U = (const float*)(F.ws + WS_U); float* ssz = (float*)(F.ws + WS_SSZ);
    int t = wsl; if (t >= T) return;
    int idA, idB, idAn = 0, idBn = 0; float cA, cB, gAn = 0.f, gBn = 0.f, uAn = 0.f, uBn = 0.f, sdA = 0.f, sdB = 0.f, suA = 0.f, suB = 0.f; f32x4 h4, h4n = {0.f, 0.f, 0.f, 0.f};
    const size_t zoff = 256 * x + 32 * s + 4 * gq;
#define P6B_FETCH1(TT) do { idAn = IDX[(size_t)(TT) * 128 + lane]; idBn = IDX[(size_t)(TT) * 128 + 64 + lane]; gAn = GATE[(size_t)(TT) * 128 + lane]; gBn = GATE[(size_t)(TT) * 128 + 64 + lane]; \
        uAn = 0.f; uBn = 0.f; _Pragma("unroll") for (int xx = 0; xx < 8; ++xx) { uAn += U[((size_t)xx * T + (TT)) * 128 + lane]; uBn += U[((size_t)xx * T + (TT)) * 128 + 64 + lane]; } \
        h4n = *(const f32x4*)(F.out + (size_t)(TT) * DM + zoff); } while (0)
#define P6B_FETCH2() do { sdA = ESC[idAn]; sdB = ESC[idBn]; suA = ESC[NEXP + idAn]; suB = ESC[NEXP + idBn]; } while (0)
#define P6B_COEF() do { cA = gAn * gelu_erf(uAn * sdA) * suA; cB = gBn * gelu_erf(uBn * sdB) * suB; } while (0)
#define P6_PIN16(Y, B_) asm volatile("" : "+v"(Y[B_]), "+v"(Y[B_ + 1]), "+v"(Y[B_ + 2]), "+v"(Y[B_ + 3]), "+v"(Y[B_ + 4]), "+v"(Y[B_ + 5]), "+v"(Y[B_ + 6]), "+v"(Y[B_ + 7]), \
        "+v"(Y[B_ + 8]), "+v"(Y[B_ + 9]), "+v"(Y[B_ + 10]), "+v"(Y[B_ + 11]), "+v"(Y[B_ + 12]), "+v"(Y[B_ + 13]), "+v"(Y[B_ + 14]), "+v"(Y[B_ + 15]))
#define P6S_AXPY1(BA, BB, q_, IT_, NXT_) do { const float ce_ = __shfl(((IT_) < 8) ? cA : cB, gq + 8 * ((IT_) & 7)); \
        const f32x32 w_ = P6S_DEC(BA, BB, q_); _Pragma("unroll") for (int i = 0; i < 32; ++i) y[i] += ce_ * w_[i]; \
        P6_PIN16(y, 0); P6_PIN16(y, 16); asm volatile("" : "+v"(NXT_)); } while (0)
#define P6S_AXPY(BA, BB, IT0) do { P6S_AXPY1(BA, BB, 0, (IT0), BA[1].x); P6S_AXPY1(BA, BB, 1, (IT0) + 1, pin_); } while (0)
    P6B_FETCH1(t); P6B_FETCH2(); P6B_COEF(); idA = idAn; idB = idBn; h4 = h4n;
    int tn = t + nws; if (tn < T) P6B_FETCH1(tn);
    v4u A0[2], B0[2]; u32x2 A1[2], B1[2];
    P6S_LOADN(A0, A1, 2, TAB, 0, idA, idB);
    const bool b2 = (gq & 4) != 0, b1 = (gq & 2) != 0, b0 = (gq & 1) != 0; int pin_ = 0;
#pragma unroll 1
    for (;;) {
        float y[32];
#pragma unroll
        for (int i = 0; i < 32; ++i) y[i] = 0.f;
        const bool more = tn < T;
        P6S_LOADN(B0, B1, 2, TAB, 2, idA, idB); P6S_AXPY(A0, A1, 0);
        P6S_LOADN(A0, A1, 2, TAB, 4, idA, idB); P6S_AXPY(B0, B1, 2);
        if (more) P6B_FETCH2();
        P6S_LOADN(B0, B1, 2, TAB, 6, idA, idB); P6S_AXPY(A0, A1, 4);
        P6S_LOADN(A0, A1, 2, TAB, 8, idA, idB); P6S_AXPY(B0, B1, 6);
        P6S_LOADN(B0, B1, 2, TAB, 10, idA, idB); P6S_AXPY(A0, A1, 8);
        P6S_LOADN(A0, A1, 2, TAB, 12, idA, idB); P6S_AXPY(B0, B1, 10);
        P6S_LOADN(B0, B1, 2, TAB, 14, idA, idB); P6S_AXPY(A0, A1, 12);
        if (more) P6S_LOADN(A0, A1, 2, TAB, 0, idAn, idBn);
        P6S_AXPY(B0, B1, 14);
        float k16[16], k8[8], k4[4];
#pragma unroll
        for (int j = 0; j < 16; ++j) { const float keep = b2 ? y[16 + j] : y[j], send = b2 ? y[j] : y[16 + j]; k16[j] = keep + __shfl_xor(send, 32); }
#pragma unroll
        for (int j = 0; j < 8; ++j) { const float keep = b1 ? k16[8 + j] : k16[j], send = b1 ? k16[j] : k16[8 + j]; k8[j] = keep + __shfl_xor(send, 16); }
#pragma unroll
        for (int j = 0; j < 4; ++j) { const float keep = b0 ? k8[4 + j] : k8[j], send = b0 ? k8[j] : k8[4 + j]; k4[j] = keep + __shfl_xor(send, 8); }
        const f32x4 z = {h4[0] + k4[0], h4[1] + k4[1], h4[2] + k4[2], h4[3] + k4[3]};
        *(f32x4*)(F.out + (size_t)t * DM + zoff) = z;
        const float ss = wave_sum((z[0] * z[0] + z[1] * z[1]) + (z[2] * z[2] + z[3] * z[3]));
        if (lane == 0) atomicAdd(ssz + t, ss);
        if (!more) break;
        P6B_COEF(); t = tn; idA = idAn; idB = idBn; h4 = h4n;
        tn += nws; if (tn < T) P6B_FETCH1(tn);
    }
#undef P6B_FETCH1
#undef P6B_FETCH2
#undef P6B_COEF
#undef P6S_AXPY
#undef P6S_AXPY1
#undef P6_PIN16
}
#undef P6S_LOADN
#undef P6S_DEC
__device__ __forceinline__ void p6c_norm(Frame& F) {
    const int lane = F.lane; const float* ssz = (const float*)(F.ws + WS_SSZ);
    for (int t = F.gw; t < T; t += F.NGW) {
        f32x4* row = (f32x4*)(F.out + (size_t)t * DM);
        const float rf = 1.0f / sqrtf(__hip_atomic_load(ssz + t, __ATOMIC_RELAXED, __HIP_MEMORY_SCOPE_AGENT) * (1.0f / DM) + EPS);
#pragma unroll
        for (int i = 0; i < 8; ++i) row[64 * i + lane] = row[64 * i + lane] * rf * ((const f32x4*)F.final_norm)[64 * i + lane];
    }
}
__device__ __forceinline__ void p6_rot(Frame& F) {
    const int lane = opq(F.lane), gq = lane >> 3, s = lane & 7, x0 = F.bid & 7;
    const int* IDX = (const int*)(F.ws + WS_IDX); const float* GATE = (const float*)(F.ws + WS_GATE); const float* ESC = (const float*)(F.ws + WS_ESC); const float* ssq = (const float*)(F.ws + WS_SSQ);
    typedef _Float16 h16x4 __attribute__((ext_vector_type(4)));
    LAS unsigned char* wl = F.lds + F.wave * 19520;
    LAS _Float16* LZ = (LAS _Float16*)wl;
    LAS unsigned short* LID = (LAS unsigned short*)(wl + 16384);
    LAS float* LDOT = (LAS float*)(wl + 17408);
    LAS float* LSS = (LAS float*)(wl + 19456);
    const bf16* HB = (const bf16*)(F.ws + WS_AO);
#pragma unroll 1
    for (int tbase = F.gw; tbase < T; tbase += 4 * F.NGW) {
#pragma unroll
    for (int j = 0; j < 4; ++j) { const int t = tbase + F.NGW * j; const bool ok = t < T;
        LID[j * 128 + lane] = (unsigned short)(ok ? IDX[(size_t)t * 128 + lane] : 0); LID[j * 128 + 64 + lane] = (unsigned short)(ok ? IDX[(size_t)t * 128 + 64 + lane] : 0);
        LDOT[j * 128 + lane] = 0.f; LDOT[j * 128 + 64 + lane] = 0.f; if (lane == 0) LSS[j] = 0.f; }
    LDS_WAIT(); asm volatile("" ::: "memory");
#define P6R_LOAD(BA, BB, TAB, IT0) do { _Pragma("unroll") for (int q_ = 0; q_ < 4; ++q_) { const int it_ = (IT0) + q_; const int e_ = __shfl((it_ < 8) ? idA : idB, gq + 8 * (it_ & 7)); \
        const unsigned char* rp_ = (TAB) + (size_t)e_ * 192; BA[q_] = *(const U3*)(rp_ + 12 * s); BB[q_] = *(const U3*)(rp_ + 96 + 12 * s); } } while (0)
#define P6R_DEC(BA, BB, q_) __builtin_amdgcn_cvt_scalef32_pk32_f32_fp6((u32x6){BA[q_].a, BA[q_].b, BA[q_].c, BB[q_].a, BB[q_].b, BB[q_].c}, 1.0f)
    {
    typedef __bf16 b16x2 __attribute__((ext_vector_type(2)));
    typedef __bf16 b16x32 __attribute__((ext_vector_type(32)));
#pragma unroll 1
    for (int k = 0; k < 8; ++k) {
        const int x = (x0 + k) & 7; const unsigned char* TAB = F.ws + WS_ED + (size_t)x * NEXP * 192;
#pragma unroll 1
        for (int j = 0; j < 4; ++j) {
            const int t = tbase + F.NGW * j; if (t >= T) break;
            const bf16* hrow = HB + (size_t)t * DM + 256 * x + 32 * s;
            unsigned hh[16];
#pragma unroll
            for (int i = 0; i < 4; ++i) { const v4u a = ((const v4u*)hrow)[i]; hh[4 * i] = a.x; hh[4 * i + 1] = a.y; hh[4 * i + 2] = a.z; hh[4 * i + 3] = a.w; }
            const int idA = LID[j * 128 + lane], idB = LID[j * 128 + 64 + lane];
            U3 A0[4], B0[4], A1[4], B1[4];
#define P6R_DOTS(BA, BB, IT0) do { _Pragma("unroll") for (int q_ = 0; q_ < 4; ++q_) { \
        const b16x32 w_ = __builtin_amdgcn_cvt_scalef32_pk32_bf16_fp6((u32x6){BA[q_].a, BA[q_].b, BA[q_].c, BB[q_].a, BB[q_].b, BB[q_].c}, 1.0f); float p0_ = 0.f, p1_ = 0.f; \
        _Pragma("unroll") for (int i = 0; i < 8; ++i) { p0_ = __builtin_amdgcn_fdot2_f32_bf16((b16x2){w_[4 * i], w_[4 * i + 1]}, __builtin_bit_cast(b16x2, hh[2 * i]), p0_, false); p1_ = __builtin_amdgcn_fdot2_f32_bf16((b16x2){w_[4 * i + 2], w_[4 * i + 3]}, __builtin_bit_cast(b16x2, hh[2 * i + 1]), p1_, false); } \
        const float d_ = g8_sum(p0_ + p1_); if (s == 0) { LAS float* dp_ = LDOT + j * 128 + gq + 8 * ((IT0) + q_); *dp_ = *dp_ + d_; } \
        __builtin_amdgcn_sched_barrier(0); } } while (0)
            P6R_LOAD(A0, A1, TAB, 0);
            P6R_LOAD(B0, B1, TAB, 4); P6R_DOTS(A0, A1, 0);
            P6R_LOAD(A0, A1, TAB, 8); P6R_DOTS(B0, B1, 4);
            P6R_LOAD(B0, B1, TAB, 12); P6R_DOTS(A0, A1, 8);
            P6R_DOTS(B0, B1, 12);
#undef P6R_DOTS
        }
    }
    }
    LDS_WAIT(); asm volatile("" ::: "memory");
#pragma unroll 1
    for (int j = 0; j < 4; ++j) {
        const int t = tbase + F.NGW * j; if (t >= T) break;
        const float r2 = 1.0f / sqrtf(__hip_atomic_load(ssq + t, __ATOMIC_RELAXED, __HIP_MEMORY_SCOPE_AGENT) * (1.0f / DM) + EPS);
        const int idA = LID[j * 128 + lane], idB = LID[j * 128 + 64 + lane];
        const float cA = GATE[(size_t)t * 128 + lane] * gelu_erf(LDOT[j * 128 + lane] * r2 * ESC[idA]) * ESC[NEXP + idA];
        const float cB = GATE[(size_t)t * 128 + 64 + lane] * gelu_erf(LDOT[j * 128 + 64 + lane] * r2 * ESC[idB]) * ESC[NEXP + idB];
        LDOT[j * 128 + lane] = cA; LDOT[j * 128 + 64 + lane] = cB;
    }
    LDS_WAIT(); asm volatile("" ::: "memory");
    const bool b0 = (gq & 1) != 0; int pin_ = 0;
#pragma unroll 1
    for (int k = 0; k < 8; ++k) {
        const int x = (x0 + k) & 7; const unsigned char* TAB = F.ws + WS_EU + (size_t)x * NEXP * 192;
#pragma unroll 1
        for (int j = 0; j < 4; ++j) {
            const int t = tbase + F.NGW * j; if (t >= T) break;
            const f32x2 hq = *(const f32x2*)(HB + (size_t)t * DM + 256 * x + 32 * s + 4 * gq); const unsigned hq0 = __float_as_uint(hq.x), hq1 = __float_as_uint(hq.y);
            const f32x4 h4 = {bflo(hq0), bfhi(hq0), bflo(hq1), bfhi(hq1)};
            const int idA = LID[j * 128 + lane], idB = LID[j * 128 + 64 + lane];
            const float cA = LDOT[j * 128 + lane], cB = LDOT[j * 128 + 64 + lane];
            f32x2 y2[16];
#pragma unroll
            for (int i = 0; i < 16; ++i) y2[i] = (f32x2){0.f, 0.f};
            U3 A0[4], B0[4], A1[4], B1[4];
#define P6R_PIN16(Y, B_) asm volatile("" : "+v"(Y[B_]), "+v"(Y[B_ + 1]), "+v"(Y[B_ + 2]), "+v"(Y[B_ + 3]), "+v"(Y[B_ + 4]), "+v"(Y[B_ + 5]), "+v"(Y[B_ + 6]), "+v"(Y[B_ + 7]))
#define P6R_AXPY1(BA, BB, q_, IT_, NXT_) do { const float ce_ = __shfl(((IT_) < 8) ? cA : cB, gq + 8 * ((IT_) & 7)); \
        const f32x32 w_ = P6R_DEC(BA, BB, q_); const f32x2 ce2_ = {ce_, ce_}; _Pragma("unroll") for (int i = 0; i < 16; ++i) y2[i] = __builtin_elementwise_fma((f32x2){w_[2 * i], w_[2 * i + 1]}, ce2_, y2[i]); \
        P6R_PIN16(y2, 0); P6R_PIN16(y2, 8); asm volatile("" : "+v"(NXT_)); } while (0)
#define P6R_AXPY(BA, BB, IT0) do { P6R_AXPY1(BA, BB, 0, (IT0), BA[1].a); P6R_AXPY1(BA, BB, 1, (IT0) + 1, BA[2].a); P6R_AXPY1(BA, BB, 2, (IT0) + 2, BA[3].a); P6R_AXPY1(BA, BB, 3, (IT0) + 3, pin_); } while (0)
            P6R_LOAD(A0, A1, TAB, 0);
            P6R_LOAD(B0, B1, TAB, 4); P6R_AXPY(A0, A1, 0);
            P6R_LOAD(A0, A1, TAB, 8); P6R_AXPY(B0, B1, 4);
            P6R_LOAD(B0, B1, TAB, 12); P6R_AXPY(A0, A1, 8);
            P6R_AXPY(B0, B1, 12);
#undef P6R_AXPY
#undef P6R_AXPY1
#undef P6R_PIN16
            float y[32], k16[16], k8[8], k4[4];
#pragma unroll
            for (int i = 0; i < 16; ++i) { y[2 * i] = y2[i].x; y[2 * i + 1] = y2[i].y; }
#pragma unroll
            for (int i = 0; i < 16; ++i) { const auto r_ = __builtin_amdgcn_permlane32_swap(__float_as_uint(y[i]), __float_as_uint(y[16 + i]), false, false); k16[i] = __uint_as_float(r_[0]) + __uint_as_float(r_[1]); }
#pragma unroll
            for (int i = 0; i < 8; ++i) { const auto r_ = __builtin_amdgcn_permlane16_swap(__float_as_uint(k16[i]), __float_as_uint(k16[8 + i]), false, false); k8[i] = __uint_as_float(r_[0]) + __uint_as_float(r_[1]); }
#pragma unroll
            for (int i = 0; i < 4; ++i) { const float keep = b0 ? k8[4 + i] : k8[i], send = b0 ? k8[i] : k8[4 + i]; k4[i] = keep + dppf<0x128>(send); }
            const f32x4 z = {h4[0] + k4[0], h4[1] + k4[1], h4[2] + k4[2], h4[3] + k4[3]};
            *(LAS h16x4*)(LZ + j * 2048 + 256 * x + 32 * s + 4 * gq) = (h16x4){(_Float16)z[0], (_Float16)z[1], (_Float16)z[2], (_Float16)z[3]};
            const float ss = wave_sum_fast((z[0] * z[0] + z[1] * z[1]) + (z[2] * z[2] + z[3] * z[3]));
            if (lane == 0) LSS[j] = LSS[j] + ss;
        }
    }
#undef P6R_LOAD
#undef P6R_DEC
    LDS_WAIT(); asm volatile("" ::: "memory");
#pragma unroll 1
    for (int j = 0; j < 4; ++j) {
        const int t = tbase + F.NGW * j; if (t >= T) break;
        f32x4* row = (f32x4*)(F.out + (size_t)t * DM);
        const float rf = 1.0f / sqrtf(LSS[j] * (1.0f / DM) + EPS);
#pragma unroll
        for (int i = 0; i < 8; ++i) { const h16x4 zv = *(const LAS h16x4*)(LZ + j * 2048 + 256 * i + 4 * lane); const f32x4 w = ((const f32x4*)F.final_norm)[64 * i + lane];
            row[64 * i + lane] = (f32x4){(float)zv[0] * rf * w[0], (float)zv[1] * rf * w[1], (float)zv[2] * rf * w[2], (float)zv[3] * rf * w[3]}; }
    }
    asm volatile("s_waitcnt vmcnt(0) lgkmcnt(0)" ::: "memory");
    }
}
typedef unsigned gu32;
#define XB_TMO      128
#define XB_XCNT(j)  (256  + 64 * (j))
#define XB_XSUB(j)  (1280 + 64 * (j))
#define XB_XGEN(j)  (2304 + 64 * (j))
#define XB_TOP      3328
#define XB_TOPGEN   3392
#define XCD_BAR_WORDS 3456
#define XB_SPIN_CAP (1u << 18)

__device__ __forceinline__ unsigned xb_ld(unsigned* p)              { return __hip_atomic_load(p, __ATOMIC_RELAXED, __HIP_MEMORY_SCOPE_AGENT); }
__device__ __forceinline__ unsigned xb_add(unsigned* p, unsigned v) { return __hip_atomic_fetch_add(p, v, __ATOMIC_RELAXED, __HIP_MEMORY_SCOPE_AGENT); }
__device__ __forceinline__ unsigned xb_xcc_id() { return (unsigned)__builtin_amdgcn_s_getreg((3 << 11) | 20) & 0xFu; }
#define XB_SPIN(cond, bar) do { unsigned _sp = 0; while (cond) { __builtin_amdgcn_s_sleep(1); \
    if ((++_sp & 255u) == 0u) { if (xb_ld(&(bar)[XB_TMO])) break; if (_sp > XB_SPIN_CAP) { atomicAdd(&(bar)[XB_TMO], 1u); break; } } } } while (0)

struct XcdBarrier {
    unsigned* bar; unsigned x;
    volatile LAS unsigned* st;
};

__device__ __forceinline__ XcdBarrier xcd_barrier_post(unsigned* bar, volatile LAS unsigned* st) {
    XcdBarrier b; b.bar = bar; b.x = xb_xcc_id(); b.st = st;
    if (threadIdx.x == 0) (void)xb_add(&bar[XB_XCNT(b.x)], 1u);
    return b;
}
__device__ __forceinline__ void xcd_barrier_complete(unsigned* bar, unsigned x, unsigned& nloc, unsigned& nx) {
    const unsigned G = gridDim.x * gridDim.y * gridDim.z;
    unsigned sum, cnt, mine, sp = 0u;
    for (;;) {
        sum = 0u; cnt = 0u; mine = 0u;
#pragma unroll
        for (unsigned j = 0; j < 16; ++j) { const unsigned c = xb_ld(&bar[XB_XCNT(j)]); sum += c; cnt += (c > 0u) ? 1u : 0u; mine = (j == x) ? c : mine; }
        if (sum == G) break;
        __builtin_amdgcn_s_sleep(1);
        if ((++sp & 255u) == 0u) { if (xb_ld(&bar[XB_TMO])) break; if (sp > XB_SPIN_CAP) { atomicAdd(&bar[XB_TMO], 1u); break; } }
    }
    nloc = mine > 0u ? mine : 1u; nx = cnt > 0u ? cnt : 1u;
}

__device__ __forceinline__ void xcd_barrier(const XcdBarrier& b) {
    asm volatile("s_waitcnt vmcnt(0)" ::: "memory");
    __syncthreads();
    if (threadIdx.x == 0) {
        unsigned* bar = b.bar;
        __builtin_amdgcn_s_waitcnt(0);
        unsigned nloc = b.st[0], nx = b.st[1];
        if (nloc == 0u) { xcd_barrier_complete(bar, b.x, nloc, nx); b.st[0] = nloc; b.st[1] = nx; }
        const unsigned old = xb_add(&bar[XB_XSUB(b.x)], 1u);
        const unsigned gen = old / nloc;
        if (old + 1u == (gen + 1u) * nloc) {
            __builtin_amdgcn_fence(__ATOMIC_RELEASE, "agent");
            asm volatile("s_waitcnt vmcnt(0)" ::: "memory");
            const unsigned og = xb_add(&bar[XB_TOP], 1u);
            const unsigned tg = og / nx;
            if (og + 1u == (tg + 1u) * nx) xb_add(&bar[XB_TOPGEN], 1u);
            else XB_SPIN(xb_ld(&bar[XB_TOPGEN]) == tg, bar);
            __builtin_amdgcn_fence(__ATOMIC_ACQUIRE, "agent");
            xb_add(&bar[XB_XGEN(b.x)], 1u);
            asm volatile("s_waitcnt vmcnt(0)" ::: "memory");
        } else {
            XB_SPIN(xb_ld(&bar[XB_XGEN(b.x)]) == gen, bar);
            __builtin_amdgcn_fence(__ATOMIC_ACQUIRE, "agent");
            asm volatile("s_waitcnt vmcnt(0)" ::: "memory");
        }
    }
    __syncthreads();
}

constexpr int NPH = 10;
struct Args { const float* in[13]; float* out; unsigned char* ws; int ph_lo, ph_hi; };
__global__ void __launch_bounds__(NWAVES * 64, 2) mk_fwd(Args a) {
    extern __shared__ __attribute__((aligned(16))) unsigned char lds[];
    cg::grid_group grid = cg::this_grid();
    Frame F;
    F.lds = (LAS unsigned char*)lds; F.tid = threadIdx.x; F.lane = F.tid & 63; F.wave = __builtin_amdgcn_readfirstlane(F.tid >> 6);
    F.G = gridDim.x; F.bid = blockIdx.x; F.gw = F.bid * NWAVES + F.wave; F.NGW = F.G * NWAVES;
    F.x = a.in[0]; F.attn_norm = a.in[1]; F.w_in = a.in[2]; F.sinks = a.in[3]; F.w_attn = a.in[4]; F.w_ret = a.in[5]; F.w_out = a.in[6]; F.ffn_norm = a.in[7];
    F.w_q = a.in[8]; F.sub_keys = a.in[9]; F.e_down = a.in[10]; F.e_up = a.in[11]; F.final_norm = a.in[12]; F.out = a.out; F.ws = a.ws;
    unsigned char* ws = a.ws;
    const int lo = a.ph_lo, hi = a.ph_hi;
#define IN(k) (lo <= (k) && (k) < hi)
    volatile LAS unsigned* MISC = (volatile LAS unsigned*)(F.lds + LDS_BYTES - 256);
    if (F.tid < 32) MISC[F.tid] = 0u;
    __syncthreads();
    XcdBarrier xbar = xcd_barrier_post((unsigned*)(ws + 16384), MISC + 8);
#define SEAM(k) do { if (IN(k) && IN((k) + 1)) { if (lo < 0) grid.sync(); else xcd_barrier(xbar); } } while (0)
    pg8::bf16_t* PROJ = (pg8::bf16_t*)(ws + WS_PROJ);
    float* KV = F.out;
    if (IN(0)) { p0_prologue(F); if (PEER_FP8 == 1) p0_experts_fp8(F); if (PEER_FP8 == 2) p0_experts_fp6(F); if (PEER_FP8 == 3) p0_experts_fp6s(F); }
    SEAM(0);
    if (IN(1)) {
        pg8::Gemm g{(const pg8::bf16_t*)(ws + WS_XB), (const pg8::bf16_t*)(ws + WS_WIN), T, NPROJ, GEMM1_FP8 ? DM / 2 : DM}; pg8::StaticOrder S; S.init(T, NPROJ, F.G, F.bid);
        pg8::EpiProj E{PROJ, (const float*)(ws + WS_R1), (const pg8::f32x4*)(ws + WS_ROPE), GEMM1_FP8 ? 1.0f / (G1_XS * G1_WS) : 0.0f};
        pg8::gemm_phase<pg8::EpiProj, pg8::StaticOrder, true, true, (GEMM1_FP8 != 0)>(F.lds, g, S, E);
    }
    SEAM(1);
    if (IN(2)) { p2_attn_mfma(F); p2_kv_mfma(F, KV); }
    SEAM(2);
    if (IN(3)) p2_scan(F, KV);
    SEAM(3);
    if (IN(4)) p2_retout_mfma(F, KV);
    SEAM(4);
    if (IN(5)) {
        constexpr float p3fix = P3_FP8 ? 1.0f / (P3_AS * G1_WS) : 1.0f;
        { pg8::Gemm g{(const pg8::bf16_t*)(ws + WS_AO), (const pg8::bf16_t*)(ws + WS_WA), T, DM, P3_FP8 ? 512 : 1024}; pg8::StaticOrder S; S.init(T, DM, F.G, F.bid);
          pg8::EpiGate1 E{(pg8::bf16_t*)F.out, PROJ, C_GA, p3fix};
          pg8::gemm_phase<pg8::EpiGate1, pg8::StaticOrder, true, true, (P3_FP8 != 0)>(F.lds, g, S, E); }
        { pg8::Gemm g{(const pg8::bf16_t*)(ws + WS_RO), (const pg8::bf16_t*)(ws + WS_WR), T, DM, P3_FP8 ? DM / 2 : DM}; pg8::StaticOrder S; S.init(T, DM, F.G, F.bid);
          pg8::EpiGate2 E{(const pg8::bf16_t*)F.out, PROJ, C_GT, (pg8::bf16_t*)(ws + WS_XB), p3fix, P4_FP8 ? P3_AS : 0.0f};
          pg8::gemm_phase<pg8::EpiGate2, pg8::StaticOrder, true, true, (P3_FP8 != 0)>(F.lds, g, S, E); }
    }
    SEAM(5);
    if (IN(6)) {
        pg8::Gemm g{(const pg8::bf16_t*)(ws + WS_XB), (const pg8::bf16_t*)(ws + WS_WO), T, DM, P4_FP8 ? DM / 2 : DM}; pg8::StaticOrder S; S.init(T, DM, F.G, F.bid);
        pg8::EpiHres E{F.x, (pg8::bf16_t*)(ws + WS_AO), (float*)(ws + WS_SSQ), P4_FP8 ? 1.0f / (P3_AS * G1_WS) : 1.0f};
        pg8::gemm_phase<pg8::EpiHres, pg8::StaticOrder, true, true, (P4_FP8 != 0)>(F.lds, g, S, E);
    }
    SEAM(6);
    if (IN(7)) {
        pg8::Gemm g{(const pg8::bf16_t*)(ws + WS_AO), (const pg8::bf16_t*)(ws + WS_WQ), T, DM, DM};
        if (F.G == (T / 256) * (DM / 256)) {
            pg8::StaticOrder S; S.init(T, DM, F.G, F.bid);
            EpiQryLds E{F, (const float*)(ws + WS_SSQ)};
            pg8::gemm_phase<EpiQryLds, pg8::StaticOrder, true, true>(F.lds, g, S, E);
        } else {
        pg8::StaticOrder S; S.init(T, DM, F.G, F.bid);
        pg8::EpiQry E{PROJ, (const float*)(ws + WS_SSQ)};
        pg8::gemm_phase<pg8::EpiQry, pg8::StaticOrder, true, true>(F.lds, g, S, E);
        asm volatile("s_waitcnt vmcnt(0)" ::: "memory"); __syncthreads();
        __builtin_amdgcn_fence(__ATOMIC_ACQUIRE, "agent"); asm volatile("s_waitcnt vmcnt(0)" ::: "memory"); __syncthreads();
        pg8::Unit uu; for (int i = 0; S.next(i, uu); ++i) p5_topk_v2(F, uu.pm, uu.pn);
        }
    }
    SEAM(8);
    if (PEER_FP8 == 3) {
        if (IN(9)) p6_rot(F);
    } else {
        if (IN(9)) { if (PEER_FP8 == 2) p6_peer_fp6(F); else p6_peer2<(PEER_FP8 == 1)>(F); }
    }
#undef IN
#undef SEAM
}
}

#ifndef MK_N_LAUNCHES
#define MK_N_LAUNCHES 1
#endif
extern "C" void kernel_launch(void* const* d_in, const int* in_sizes, int n_in, void* d_out, int out_size, void* d_ws, size_t ws_size, hipStream_t stream) {
    using namespace mk;
    static int grid = 0;
    if (grid == 0) {
        if (n_in != 13 || out_size != T * DM || ws_size < WS_END) { fprintf(stderr, "kernel_launch: unexpected problem (n_in %d, out %d, ws %zu)\n", n_in, out_size, ws_size); grid = -1; return; }
        int dev = 0, cus = 0, per_cu = 0;
        if (hipGetDevice(&dev) != hipSuccess || hipDeviceGetAttribute(&cus, hipDeviceAttributeMultiprocessorCount, dev) != hipSuccess) { grid = -1; return; }
        if (hipFuncSetAttribute((const void*)mk_fwd, hipFuncAttributeMaxDynamicSharedMemorySize, LDS_BYTES) != hipSuccess) { fprintf(stderr, "kernel_launch: hipFuncSetAttribute failed\n"); grid = -1; return; }
        if (hipOccupancyMaxActiveBlocksPerMultiprocessor(&per_cu, (const void*)mk_fwd, NWAVES * 64, LDS_BYTES) != hipSuccess || per_cu < 1) { fprintf(stderr, "kernel_launch: occupancy query says %d\n", per_cu); per_cu = 1; }
        (void)hipGetLastError();
        grid = cus * (per_cu < 1 ? 1 : per_cu);
        if (grid > 256) grid = 256;
    }
    if (grid < 0) return;
    (void)hipMemsetAsync((char*)d_ws + WS_CTL, 0, CTL_BYTES, stream);
    Args a{};
    for (int i = 0; i < 13; ++i) a.in[i] = (const float*)d_in[i];
    a.out = (float*)d_out; a.ws = (unsigned char*)d_ws;
#if MK_N_LAUNCHES == 1
    a.ph_lo = 0; a.ph_hi = NPH;
    void* args[] = {&a};
    hipError_t e = hipLaunchCooperativeKernel((const void*)mk_fwd, dim3(grid), dim3(NWAVES * 64), args, LDS_BYTES, stream);
    if (e != hipSuccess) fprintf(stderr, "kernel_launch: cooperative launch failed: %s (grid %d)\n", hipGetErrorString(e), grid);
#else
    for (int ph = 0; ph < NPH; ++ph) { a.ph_lo = ph; a.ph_hi = ph + 1; hipLaunchKernelGGL(mk_fwd, dim3(grid), dim3(NWAVES * 64), LDS_BYTES, stream, a); }
#endif
}
```

```cpp
#include <hip/hip_runtime.h>
#include <hip/hip_cooperative_groups.h>
#include <cstdio>
#include <cstdint>
namespace cg = cooperative_groups;
namespace pg8 {
#define PG8_LAS __attribute__((address_space(3)))
typedef unsigned short bf16_t;
typedef short bf16x8 __attribute__((ext_vector_type(8)));
typedef float f32x4 __attribute__((ext_vector_type(4)));
typedef unsigned u32x4 __attribute__((ext_vector_type(4)));
typedef unsigned u32x2 __attribute__((ext_vector_type(2)));
typedef int i32x4_t __attribute__((ext_vector_type(4)));
typedef int i32x8_t __attribute__((ext_vector_type(8)));
constexpr int BM = 256, BK = 64, HALF = 128, HTB = HALF * BK * 2  , STAGE_BYTES = 8 * HTB, NXCD = 8, WGM = 8;

__host__ __device__ __forceinline__ int lds_byte(int r, int c) { const int st = (r >> 4) * 2 + (c >> 5), rr = r & 15, cc = c & 31, ob = rr * 64 + cc * 2; return st * 1024 + (ob ^ (((ob >> 9) & 1) << 5)); }
__host__ __device__ __forceinline__ void stage_rc(int b, int& R, int& C) { const int st = b / 1024, sb = b % 1024, swz = sb ^ (((sb >> 9) & 1) << 5); R = (st >> 1) * 16 + swz / 64; C = (st & 1) * 32 + (swz % 64) / 2; }
__host__ __device__ __forceinline__ int perm32(int rho) { const int n = rho >> 4, i = rho & 15; return 8 * (i >> 2) + 4 * n + (i & 3); }

struct Unit { int pm, pn; };
struct Gemm { const bf16_t* A; const bf16_t* Bt; int M, N, K; };

struct StaticOrder {
    int nM, nN, nwg, G, c, ilv;
    __host__ __device__ void init(int M, int N, int G_, int c_) { nM = M / BM; nN = N / BM; nwg = nM * nN; G = G_; c = c_; ilv = 0; }
    __host__ __device__ __forceinline__ bool next(int i, Unit& u) const {
        const long L = (long)i * G + c; if (L >= nwg) return false;
        int wgid = (int)L; { const int q = nwg / NXCD, r = nwg % NXCD, xcd = wgid % NXCD, off = wgid / NXCD; wgid = (xcd < r ? xcd * (q + 1) : r * (q + 1) + (xcd - r) * q) + off; }
        const int nig = WGM * nN, gid = wgid / nig, fm = gid * WGM, gsz = (nM - fm) < WGM ? (nM - fm) : WGM;
        u.pm = fm + ((wgid % nig) % gsz); u.pn = (wgid % nig) / gsz;
        if (ilv) { const int hN = nN >> 1; u.pn = (u.pn < hN) ? 2 * u.pn : 2 * (u.pn - hN) + 1; u.pn += ilv - 1; if (u.pn >= nN) u.pn -= nN; }
        return true;
    }
    __device__ __forceinline__ void a_ready(const Unit&) const {}
    __device__ __forceinline__ void done(const Unit&) const {}
};

typedef __bf16 b16x2cv __attribute__((ext_vector_type(2)));
typedef float f32x2cv __attribute__((ext_vector_type(2)));
__device__ __forceinline__ unsigned cvt_pk_bf16(float lo, float hi) { const b16x2cv r = __builtin_convertvector((f32x2cv){lo, hi}, b16x2cv); return __builtin_bit_cast(unsigned, r); }
typedef float f32x2 __attribute__((ext_vector_type(2)));
__device__ __forceinline__ f32x2 gelu_pk(f32x2 v) {
    const f32x2 av = __builtin_elementwise_abs(v), d = av * 0.2316418882f + 1.0f;
    f32x2 t; t.x = __builtin_amdgcn_rcpf(d.x); t.y = __builtin_amdgcn_rcpf(d.y);
    f32x2 q = t * 0.5307027145f + (-0.7265760135f); q = q * t + 0.7107068705f; q = q * t + (-0.142248368f); q = q * t + 0.127414796f; q = q * t;
    const f32x2 s = (v * v) * (-0.72134752044f);
    f32x2 e; e.x = __builtin_amdgcn_exp2f(s.x); e.y = __builtin_amdgcn_exp2f(s.y);
    const f32x2 m = v * (q * e), r = v - m;
    f32x2 o; o.x = v.x < 0.f ? m.x : r.x; o.y = v.y < 0.f ? m.y : r.y; return o;
}

__device__ __forceinline__ unsigned pk4_i8e(float a, float b, float c, float d) {
    a = fminf(fmaxf(a, -127.f), 127.f); b = fminf(fmaxf(b, -127.f), 127.f); c = fminf(fmaxf(c, -127.f), 127.f); d = fminf(fmaxf(d, -127.f), 127.f);
    const unsigned q0 = __float_as_uint(a + 12582912.0f), q1 = __float_as_uint(b + 12582912.0f), q2 = __float_as_uint(c + 12582912.0f), q3 = __float_as_uint(d + 12582912.0f);
    return __builtin_amdgcn_perm(__builtin_amdgcn_perm(q3, q2, 0x0c0c0400u), __builtin_amdgcn_perm(q1, q0, 0x0c0c0400u), 0x05040100u);
}
constexpr float QA_SCALE = 0.08838834764831845f * 1.4426950408889634f;
constexpr float KR_SCALE = 0.08838834764831845f;
constexpr int NPROJ = 11776;
__device__ __forceinline__ f32x4 rope4(f32x4 v, f32x4 cs) {
    f32x4 o; o[0] = v[0] * cs[0] - v[1] * cs[1]; o[1] = v[1] * cs[0] + v[0] * cs[1]; o[2] = v[2] * cs[2] - v[3] * cs[3]; o[3] = v[3] * cs[2] + v[2] * cs[3]; return o;
}
__device__ __forceinline__ float sigm(float x) { return __builtin_amdgcn_rcpf(1.0f + __builtin_amdgcn_exp2f(x * -1.4426950408889634f)); }
struct EpiProj {
    static constexpr bool PERM = true, AFTER_DRAIN = false; static constexpr int MID = 0;
    bf16_t* O; const float* r1; const f32x4* rope; float fixed;
    __device__ __forceinline__ void operator()(const f32x4 (&acc)[2][2][4][2], const Unit& u, int wr, int wc, int fr, int fq) const {
        asm volatile("" : "+v"(fr), "+v"(fq));
        const int colt = u.pn * BM;
        int mode; float sc = 1.f;
        if (colt < 1024) { mode = 1; sc = QA_SCALE; } else if (colt < 1280) mode = 1; else if (colt < 1536) mode = 0;
        else if (colt < 2560) mode = 1; else if (colt < 3584) { mode = 1; sc = KR_SCALE; } else if (colt < 5632) mode = 0;
        else if (colt < 7680) mode = 0  ; else mode = 3;
        const int row0 = u.pm * BM + wr * 64 + fr, col0 = colt + wc * 32 + 8 * fq;
        const int g8off = ((colt < 9728) ? 7680 : 9728) - col0;
        float rsv[2][4];
#pragma unroll
        for (int ai = 0; ai < 2; ++ai)
#pragma unroll
            for (int m = 0; m < 4; ++m) rsv[ai][m] = (fixed != 0.f) ? fixed : r1[row0 + ai * HALF + m * 16];
#pragma unroll
        for (int ai = 0; ai < 2; ++ai)
#pragma unroll
            for (int m = 0; m < 4; ++m) {
                const int row = row0 + ai * HALF + m * 16; const float rs = rsv[ai][m] * sc;
                bf16_t* rowp = O + (size_t)row * NPROJ + col0;
                f32x4 cs0 = {1.f, 0.f, 1.f, 0.f}, cs1 = {1.f, 0.f, 1.f, 0.f};
                if (mode == 1) { const f32x4* rp = rope + (size_t)(row & 4095) * 32 + 8 * wc + 2 * fq; cs0 = rp[0]; cs1 = rp[1]; }
#pragma unroll
                for (int bj = 0; bj < 2; ++bj) {
                    f32x4 v0 = acc[ai][bj][m][0] * rs, v1 = acc[ai][bj][m][1] * rs;
                    if (mode == 1) { v0 = rope4(v0, cs0); v1 = rope4(v1, cs1); }
                    else if (mode == 2) {
#pragma unroll
                        for (int i = 0; i < 4; ++i) { v0[i] = v0[i] * sigm(v0[i]); v1[i] = v1[i] * sigm(v1[i]); } }
                    else if (mode == 3) {
#pragma unroll
                        for (int i = 0; i < 4; ++i) { v0[i] = sigm(v0[i]); v1[i] = sigm(v1[i]); } }
                    if (mode == 3) {
                        u32x2 w8;
#define PKU8(a_, b_, c_, d_) __builtin_amdgcn_perm(__builtin_amdgcn_perm(__float_as_uint(fmaf((d_), 255.f, 8388608.0f)), __float_as_uint(fmaf((c_), 255.f, 8388608.0f)), 0x0c0c0400u), __builtin_amdgcn_perm(__float_as_uint(fmaf((b_), 255.f, 8388608.0f)), __float_as_uint(fmaf((a_), 255.f, 8388608.0f)), 0x0c0c0400u), 0x05040100u)
                        w8.x = PKU8(v0[0], v0[1], v0[2], v0[3]); w8.y = PKU8(v1[0], v1[1], v1[2], v1[3]);
#undef PKU8
                        *(u32x2*)((unsigned char*)rowp + g8off + bj * HALF) = w8;
                    } else {
                    u32x4 w; w.x = cvt_pk_bf16(v0[0], v0[1]); w.y = cvt_pk_bf16(v0[2], v0[3]); w.z = cvt_pk_bf16(v1[0], v1[1]); w.w = cvt_pk_bf16(v1[2], v1[3]);
                    *(u32x4*)(rowp + bj * HALF) = w; } }
            }
    }
};
__device__ __forceinline__ float bf_lo(unsigned u) { return __uint_as_float(u << 16); }
__device__ __forceinline__ float bf_hi(unsigned u) { return __uint_as_float(u & 0xffff0000u); }
struct EpiGate1 {
    static constexpr bool PERM = true, AFTER_DRAIN = false; static constexpr int MID = 0;
    bf16_t* TMP; const bf16_t* G; int gcol; float fixed;
    __device__ __forceinline__ void operator()(const f32x4 (&acc)[2][2][4][2], const Unit& u, int wr, int wc, int fr, int fq) const {
        const int row0 = u.pm * BM + wr * 64 + fr, col0 = u.pn * BM + wc * 32 + 8 * fq;
#pragma unroll
        for (int ai = 0; ai < 2; ++ai)
#pragma unroll
            for (int m = 0; m < 4; ++m) { const int row = row0 + ai * HALF + m * 16;
#pragma unroll
                for (int bj = 0; bj < 2; ++bj) { const int col = col0 + bj * HALF;
                    const u32x4 g = *(const u32x4*)(G + (size_t)row * NPROJ + gcol + col);
                    f32x4 v0 = acc[ai][bj][m][0] * fixed, v1 = acc[ai][bj][m][1] * fixed;
                    v0[0] *= bf_lo(g.x); v0[1] *= bf_hi(g.x); v0[2] *= bf_lo(g.y); v0[3] *= bf_hi(g.y);
                    v1[0] *= bf_lo(g.z); v1[1] *= bf_hi(g.z); v1[2] *= bf_lo(g.w); v1[3] *= bf_hi(g.w);
                    u32x4 w; w.x = cvt_pk_bf16(v0[0], v0[1]); w.y = cvt_pk_bf16(v0[2], v0[3]); w.z = cvt_pk_bf16(v1[0], v1[1]); w.w = cvt_pk_bf16(v1[2], v1[3]);
                    *(u32x4*)(TMP + (size_t)row * 2048 + col) = w; } }
    }
};
struct EpiGate2 {
    static constexpr bool PERM = true, AFTER_DRAIN = false; static constexpr int MID = 0;
    const bf16_t* TMP; const bf16_t* G; int gcol; bf16_t* MG; float fixed; float out8;
    __device__ __forceinline__ void operator()(const f32x4 (&acc)[2][2][4][2], const Unit& u, int wr, int wc, int fr, int fq) const {
        const int row0 = u.pm * BM + wr * 64 + fr, col0 = u.pn * BM + wc * 32 + 8 * fq;
#pragma unroll
        for (int ai = 0; ai < 2; ++ai)
#pragma unroll
            for (int m = 0; m < 4; ++m) { const int row = row0 + ai * HALF + m * 16;
#pragma unroll
                for (int bj = 0; bj < 2; ++bj) { const int col = col0 + bj * HALF;
                    const u32x4 g = *(const u32x4*)(G + (size_t)row * NPROJ + gcol + col);
                    const u32x4 tq = *(const u32x4*)(TMP + (size_t)row * 2048 + col); const f32x4 t0 = {bf_lo(tq.x), bf_hi(tq.x), bf_lo(tq.y), bf_hi(tq.y)}, t1 = {bf_lo(tq.z), bf_hi(tq.z), bf_lo(tq.w), bf_hi(tq.w)};
                    f32x4 v0 = acc[ai][bj][m][0] * fixed, v1 = acc[ai][bj][m][1] * fixed;
                    v0[0] = t0[0] + v0[0] * bf_lo(g.x); v0[1] = t0[1] + v0[1] * bf_hi(g.x); v0[2] = t0[2] + v0[2] * bf_lo(g.y); v0[3] = t0[3] + v0[3] * bf_hi(g.y);
                    v1[0] = t1[0] + v1[0] * bf_lo(g.z); v1[1] = t1[1] + v1[1] * bf_hi(g.z); v1[2] = t1[2] + v1[2] * bf_lo(g.w); v1[3] = t1[3] + v1[3] * bf_hi(g.w);
                    if (out8 != 0.f) { v0 = v0 * out8; v1 = v1 * out8;
#pragma unroll
                        for (int i = 0; i < 4; ++i) { v0[i] = fminf(fmaxf(v0[i], -448.f), 448.f); v1[i] = fminf(fmaxf(v1[i], -448.f), 448.f); }
                        int p0 = 0, p1 = 0; p0 = __builtin_amdgcn_cvt_pk_fp8_f32(v0[0], v0[1], p0, false); p0 = __builtin_amdgcn_cvt_pk_fp8_f32(v0[2], v0[3], p0, true);
                        p1 = __builtin_amdgcn_cvt_pk_fp8_f32(v1[0], v1[1], p1, false); p1 = __builtin_amdgcn_cvt_pk_fp8_f32(v1[2], v1[3], p1, true);
                        f32x2 o; o.x = __builtin_bit_cast(float, p0); o.y = __builtin_bit_cast(float, p1); *(f32x2*)((unsigned char*)MG + (size_t)row * 2048 + col) = o; }
                    else { u32x4 w; w.x = cvt_pk_bf16(v0[0], v0[1]); w.y = cvt_pk_bf16(v0[2], v0[3]); w.z = cvt_pk_bf16(v1[0], v1[1]); w.w = cvt_pk_bf16(v1[2], v1[3]);
                    *(u32x4*)(MG + (size_t)row * 2048 + col) = w; } } }
    }
};
struct EpiMerge {
    static constexpr bool PERM = true, AFTER_DRAIN = false; static constexpr int MID = 8;
    const bf16_t* G; int gca, gct; bf16_t* MG; float fixed; float out8;
    __device__ __forceinline__ void mid(f32x4 (&acc)[2][2][4][2], const Unit& u, int wr, int wc, int fr, int fq) const {
        asm volatile("" : "+v"(fr), "+v"(fq));
        const int row0 = u.pm * BM + wr * 64 + fr, col0 = u.pn * BM + wc * 32 + 8 * fq;
#pragma unroll
        for (int ai = 0; ai < 2; ++ai) {
            u32x2 ga[4][2], gt[4][2];
#pragma unroll
            for (int m = 0; m < 4; ++m)
#pragma unroll
                for (int bj = 0; bj < 2; ++bj) { const bf16_t* gp = G + (size_t)(row0 + ai * HALF + m * 16) * NPROJ; const int cc = col0 + bj * HALF; ga[m][bj] = *(const u32x2*)((const unsigned char*)(gp + gca) + cc); gt[m][bj] = *(const u32x2*)((const unsigned char*)(gp + gct) + cc); }
#pragma unroll
            for (int m = 0; m < 4; ++m)
#pragma unroll
                for (int bj = 0; bj < 2; ++bj) { const u32x2 a = ga[m][bj], t = gt[m][bj];
                    f32x4& v0 = acc[ai][bj][m][0]; f32x4& v1 = acc[ai][bj][m][1];
#pragma unroll
                    for (int i = 0; i < 4; ++i) {
                        v0[i] *= (float)((a.x >> (8 * i)) & 0xffu) * __builtin_amdgcn_rcpf(fmaxf((float)((t.x >> (8 * i)) & 0xffu), 0.25f));
                        v1[i] *= (float)((a.y >> (8 * i)) & 0xffu) * __builtin_amdgcn_rcpf(fmaxf((float)((t.y >> (8 * i)) & 0xffu), 0.25f)); } }
        }
    }
    __device__ __forceinline__ void operator()(const f32x4 (&acc)[2][2][4][2], const Unit& u, int wr, int wc, int fr, int fq) const {
        asm volatile("" : "+v"(fr), "+v"(fq));
        const int row0 = u.pm * BM + wr * 64 + fr, col0 = u.pn * BM + wc * 32 + 8 * fq;
#pragma unroll
        for (int ai = 0; ai < 2; ++ai)
#pragma unroll
            for (int m = 0; m < 4; ++m) { const int row = row0 + ai * HALF + m * 16;
#pragma unroll
                for (int bj = 0; bj < 2; ++bj) { const int col = col0 + bj * HALF;
                    const u32x2 g = *(const u32x2*)((const unsigned char*)(G + (size_t)row * NPROJ + gct) + col);
                    f32x4 v0 = acc[ai][bj][m][0] * (fixed * (1.0f / 255.0f)), v1 = acc[ai][bj][m][1] * (fixed * (1.0f / 255.0f));
#pragma unroll
                    for (int i = 0; i < 4; ++i) { v0[i] *= fmaxf((float)((g.x >> (8 * i)) & 0xffu), 0.25f); v1[i] *= fmaxf((float)((g.y >> (8 * i)) & 0xffu), 0.25f); }
                    if (out8 != 0.f) { v0 = v0 * out8; v1 = v1 * out8;
#pragma unroll
                        for (int i = 0; i < 4; ++i) { v0[i] = fminf(fmaxf(v0[i], -448.f), 448.f); v1[i] = fminf(fmaxf(v1[i], -448.f), 448.f); }
                        int p0 = 0, p1 = 0; p0 = __builtin_amdgcn_cvt_pk_fp8_f32(v0[0], v0[1], p0, false); p0 = __builtin_amdgcn_cvt_pk_fp8_f32(v0[2], v0[3], p0, true);
                        p1 = __builtin_amdgcn_cvt_pk_fp8_f32(v1[0], v1[1], p1, false); p1 = __builtin_amdgcn_cvt_pk_fp8_f32(v1[2], v1[3], p1, true);
                        f32x2 o; o.x = __builtin_bit_cast(float, p0); o.y = __builtin_bit_cast(float, p1); *(f32x2*)((unsigned char*)MG + (size_t)row * 2048 + col) = o; }
                    else { u32x4 w; w.x = cvt_pk_bf16(v0[0], v0[1]); w.y = cvt_pk_bf16(v0[2], v0[3]); w.z = cvt_pk_bf16(v1[0], v1[1]); w.w = cvt_pk_bf16(v1[2], v1[3]);
                    *(u32x4*)(MG + (size_t)row * 2048 + col) = w; } } }
    }
};
constexpr long HB8_OFF = 32l << 20;
struct EpiHres {
    static constexpr bool PERM = true, AFTER_DRAIN = false; static constexpr int MID = 0;
    const unsigned char* X8; const float* xs; bf16_t* Hb; float* ssq; float fixed; float h8s;
    __device__ __forceinline__ void operator()(const f32x4 (&acc)[2][2][4][2], const Unit& u, int wr, int wc, int fr, int fq) const {
        const int row0 = u.pm * BM + wr * 64 + fr, col0 = u.pn * BM + wc * 32 + 8 * fq;
#pragma unroll
        for (int ai = 0; ai < 2; ++ai)
#pragma unroll
            for (int m = 0; m < 4; ++m) { const int row = row0 + ai * HALF + m * 16; float ss = 0.f; const float xsc = xs[row];
#pragma unroll
                for (int bj = 0; bj < 2; ++bj) { const size_t off = (size_t)row * 2048 + col0 + bj * HALF;
                    const u32x2 xq = *(const u32x2*)(X8 + off);
                    f32x4 x0, x1;
#pragma unroll
                    for (int i = 0; i < 4; ++i) { x0[i] = (float)((int)(xq.x << (24 - 8 * i)) >> 24) * xsc; x1[i] = (float)((int)(xq.y << (24 - 8 * i)) >> 24) * xsc; }
                    const f32x4 v0 = acc[ai][bj][m][0] * fixed + x0, v1 = acc[ai][bj][m][1] * fixed + x1;
                    u32x4 w; w.x = cvt_pk_bf16(v0[0], v0[1]); w.y = cvt_pk_bf16(v0[2], v0[3]); w.z = cvt_pk_bf16(v1[0], v1[1]); w.w = cvt_pk_bf16(v1[2], v1[3]);
                    if (h8s == 0.f) *(u32x4*)(Hb + off) = w;
                    if (h8s != 0.f) { u32x2 q8; q8.x = pk4_i8e(v0[0] * h8s, v0[1] * h8s, v0[2] * h8s, v0[3] * h8s); q8.y = pk4_i8e(v1[0] * h8s, v1[1] * h8s, v1[2] * h8s, v1[3] * h8s); *(u32x2*)((unsigned char*)Hb + HB8_OFF + off) = q8; }
                    ss += (v0[0] * v0[0] + v0[1] * v0[1]) + (v0[2] * v0[2] + v0[3] * v0[3]) + (v1[0] * v1[0] + v1[1] * v1[1]) + (v1[2] * v1[2] + v1[3] * v1[3]); }
                ss += __shfl_xor(ss, 16); ss += __shfl_xor(ss, 32);
                if (fq == 0) atomicAdd(ssq + row, ss); }
    }
};
struct EpiQry {
    static constexpr bool PERM = true, AFTER_DRAIN = false; static constexpr int MID = 0;
    bf16_t* Q; const float* ssq; float fixed;
    __device__ __forceinline__ void operator()(const f32x4 (&acc)[2][2][4][2], const Unit& u, int wr, int wc, int fr, int fq) const {
        const int row0 = u.pm * BM + wr * 64 + fr, col0 = u.pn * BM + wc * 32 + 8 * fq;
#pragma unroll
        for (int ai = 0; ai < 2; ++ai)
#pragma unroll
            for (int m = 0; m < 4; ++m) { const int row = row0 + ai * HALF + m * 16;
                const float rs = 1.0f / sqrtf(__hip_atomic_load(ssq + row, __ATOMIC_RELAXED, __HIP_MEMORY_SCOPE_AGENT) * (1.0f / 2048.0f) + 1e-6f) * fixed;
#pragma unroll
                for (int bj = 0; bj < 2; ++bj) { const f32x4 v0 = acc[ai][bj][m][0] * rs, v1 = acc[ai][bj][m][1] * rs;
                    u32x4 w; w.x = cvt_pk_bf16(v0[0], v0[1]); w.y = cvt_pk_bf16(v0[2], v0[3]); w.z = cvt_pk_bf16(v1[0], v1[1]); w.w = cvt_pk_bf16(v1[2], v1[3]);
                    *(u32x4*)(Q + (size_t)row * 2048 + col0 + bj * HALF) = w; } }
    }
};

template <class Epi, class Sched, bool ALIGN_EPI = false, bool SP2 = false, int FP8 = 0>
__device__ __forceinline__ void gemm_phase(PG8_LAS unsigned char* lds, const Gemm g, const Sched& S, const Epi& E) {
    const int tid = threadIdx.x, wid = __builtin_amdgcn_readfirstlane(tid >> 6), lane = tid & 63, wr = wid >> 2, wc = wid & 3, fr = lane & 15, fq = lane >> 4;
    const int K = g.K, nt = K / BK;
    unsigned voffA[2], voffB[2];
#pragma unroll
    for (int i = 0; i < 2; ++i) { int R, C; stage_rc(tid * 16 + i * 8192, R, C); const int Rb = Epi::PERM ? ((R & ~31) + perm32(R & 31)) : R;
        voffA[i] = (unsigned)(R * K + C) * 2u; voffB[i] = (unsigned)(Rb * K + C) * 2u; }
    const size_t kstep = (size_t)(BK * 2);
    const size_t hstep = (size_t)HALF * K * 2;
    const size_t tstep = 2 * hstep;
    const unsigned ldsw = (unsigned)wid * 1024u;
    const int aoff = lds_byte(wr * 64 + fr, fq * 8), boff = lds_byte(wc * 32 + fr, fq * 8);
#define PG8_SA(b, h) (((b) * 2 + (h)) * HTB)
#define PG8_SB(b, h) ((4 + (b) * 2 + (h)) * HTB)
#define PG8_STAGE(bufoff, gbase, voff) do { _Pragma("unroll") for (int _i = 0; _i < 2; ++_i) \
        __builtin_amdgcn_global_load_lds((const unsigned*)((const char*)(gbase) + (voff)[_i]), (PG8_LAS unsigned*)(lds + (bufoff) + ldsw + _i * 8192), 16, 0, 0); } while (0)
#define PG8_LD8(p_) ({ const i32x4_t lo_ = *(const PG8_LAS i32x4_t*)(p_), hi_ = *(const PG8_LAS i32x4_t*)((p_) + 1024); (i32x8_t){lo_[0], lo_[1], lo_[2], lo_[3], hi_[0], hi_[1], hi_[2], hi_[3]}; })
#define PG8_LDA(dst, b, h) do { if constexpr (FP8) { _Pragma("unroll") for (int m = 0; m < 4; ++m) dst##8[m] = PG8_LD8(lds + PG8_SA(b, h) + aoff + m * 2048); } \
        else { _Pragma("unroll") for (int m = 0; m < 4; ++m) _Pragma("unroll") for (int k = 0; k < 2; ++k) dst[m][k] = *(const PG8_LAS bf16x8*)(lds + PG8_SA(b, h) + aoff + m * 2048 + k * 1024); } } while (0)
#define PG8_LDB(dst, b, h) do { if constexpr (FP8) { _Pragma("unroll") for (int n = 0; n < 2; ++n) dst##8[n] = PG8_LD8(lds + PG8_SB(b, h) + boff + n * 2048); } \
        else { _Pragma("unroll") for (int n = 0; n < 2; ++n) _Pragma("unroll") for (int k = 0; k < 2; ++k) dst[n][k] = *(const PG8_LAS bf16x8*)(lds + PG8_SB(b, h) + boff + n * 2048 + k * 1024); } } while (0)
#define PG8_MMA(ai, bj, At, Bt) do { __builtin_amdgcn_s_setprio(1); \
        if constexpr (FP8 == 2) {   \
            _Pragma("unroll") for (int m = 0; m < 4; ++m) _Pragma("unroll") for (int n = 0; n < 2; ++n) { \
                const i32x4_t alo_ = {At##8[m][0], At##8[m][1], At##8[m][2], At##8[m][3]}, blo_ = {Bt##8[n][0], Bt##8[n][1], Bt##8[n][2], Bt##8[n][3]}; \
                asm volatile("v_mfma_i32_16x16x64_i8 %0, %1, %2, %0" : "+v"(acc[ai][bj][m][n]) : "v"(blo_), "v"(alo_)); } \
            _Pragma("unroll") for (int m = 0; m < 4; ++m) _Pragma("unroll") for (int n = 0; n < 2; ++n) { \
                const i32x4_t ahi_ = {At##8[m][4], At##8[m][5], At##8[m][6], At##8[m][7]}, bhi_ = {Bt##8[n][4], Bt##8[n][5], Bt##8[n][6], Bt##8[n][7]}; \
                asm volatile("v_mfma_i32_16x16x64_i8 %0, %1, %2, %0" : "+v"(acc[ai][bj][m][n]) : "v"(bhi_), "v"(ahi_)); } } \
        else if constexpr (FP8 == 1) { _Pragma("unroll") for (int m = 0; m < 4; ++m) _Pragma("unroll") for (int n = 0; n < 2; ++n) \
            asm volatile("v_mfma_scale_f32_16x16x128_f8f6f4 %0, %1, %2, %0, %3, %3 op_sel_hi:[0,0,0]" : "+v"(acc[ai][bj][m][n]) : "v"(Bt##8[n]), "v"(At##8[m]), "v"(one_scale)); } \
              \
        else { _Pragma("unroll") for (int m = 0; m < 4; ++m) _Pragma("unroll") for (int n = 0; n < 2; ++n) _Pragma("unroll") for (int k = 0; k < 2; ++k) \
            acc[ai][bj][m][n] = __builtin_amdgcn_mfma_f32_16x16x32_bf16(Bt[n][k], At[m][k], acc[ai][bj][m][n], 0, 0, 0); } \
        __builtin_amdgcn_s_setprio(0); } while (0)
#define PG8_WAIT_V(n) asm volatile("s_waitcnt vmcnt(" #n ")" ::: "memory")
#define PG8_WAIT_L(n) asm volatile("s_waitcnt lgkmcnt(" #n ")" ::: "memory")
#define PG8_BAR __builtin_amdgcn_s_barrier()
#define PG8_SCHED __builtin_amdgcn_sched_barrier(0)
    Unit cur, nxt; int ui = 0;
    if (!S.next(0, cur)) return;
    f32x4 acc[2][2][4][2];
#pragma unroll
    for (int a = 0; a < 2; ++a)
#pragma unroll
        for (int b = 0; b < 2; ++b)
#pragma unroll
            for (int m = 0; m < 4; ++m)
#pragma unroll
                for (int n = 0; n < 2; ++n) acc[a][b][m][n] = (f32x4){0.f, 0.f, 0.f, 0.f};
    int one_scale = 0x7f7f7f7f; asm volatile("" : "+v"(one_scale));
    bf16x8 At[4][2], B0[2][2], B1[2][2]; i32x8_t At8[4], B08[2], B18[2];
    const char* cA = (const char*)g.A + (size_t)cur.pm * tstep; const char* cB = (const char*)g.Bt + (size_t)cur.pn * tstep;
    S.a_ready(cur);
    if constexpr (SP2) {
        PG8_STAGE(PG8_SB(0, 0), cB, voffB); PG8_STAGE(PG8_SB(0, 1), cB + hstep, voffB); PG8_STAGE(PG8_SA(0, 0), cA, voffA); PG8_STAGE(PG8_SA(0, 1), cA + hstep, voffA);
        if (wr == 1) PG8_BAR;
        PG8_WAIT_V(2); PG8_BAR;
        PG8_STAGE(PG8_SB(1, 0), cB + kstep, voffB); PG8_STAGE(PG8_SA(1, 0), cA + kstep, voffA); PG8_STAGE(PG8_SB(1, 1), cB + hstep + kstep, voffB);
        PG8_WAIT_V(6); PG8_BAR;
    } else {
        PG8_STAGE(PG8_SB(0, 0), cB, voffB); PG8_STAGE(PG8_SA(0, 0), cA, voffA); PG8_STAGE(PG8_SB(0, 1), cB + hstep, voffB); PG8_STAGE(PG8_SA(0, 1), cA + hstep, voffA);
        if (wr == 1) PG8_BAR;
        PG8_WAIT_V(4); PG8_BAR;
        PG8_STAGE(PG8_SB(1, 0), cB + kstep, voffB); PG8_STAGE(PG8_SA(1, 0), cA + kstep, voffA); PG8_STAGE(PG8_SB(1, 1), cB + hstep + kstep, voffB);
        PG8_WAIT_V(6); PG8_BAR;
    }
    for (;;) {
        const bool has_next = S.next(ui + 1, nxt);
        const char* nA = has_next ? (const char*)g.A + (size_t)nxt.pm * tstep : cA; const char* nB = has_next ? (const char*)g.Bt + (size_t)nxt.pn * tstep : cB;
        for (int t = 0; t < nt; t += 2) {
            if constexpr (Epi::MID > 0) { if (t == Epi::MID) {
                if constexpr (FP8) asm volatile("s_nop 15\n\ts_nop 15\n\ts_nop 7" ::: "memory");
                E.mid(acc, cur, wr, wc, fr, fq);
                if constexpr (FP8) asm volatile("s_nop 7" ::: "memory"); } }
            const bool last = (t == nt - 2);
            const char* a1 = cA + (size_t)(t + 1) * kstep;
            const char* a2 = last ? nA : cA + (size_t)(t + 2) * kstep; const char* b2 = last ? nB : cB + (size_t)(t + 2) * kstep;
            const char* a3 = a2 + kstep; const char* b3 = b2 + kstep;
            if (last && has_next) S.a_ready(nxt);
            if constexpr (SP2) {
            PG8_LDB(B0, 0, 0); PG8_LDB(B1, 0, 1); PG8_SCHED; PG8_LDA(At, 0, 0); PG8_STAGE(PG8_SA(1, 1), a1 + hstep, voffA);
            PG8_WAIT_V(8); PG8_WAIT_L(0); PG8_BAR; PG8_MMA(0, 0, At, B0); PG8_MMA(0, 1, At, B1); PG8_BAR; PG8_SCHED;
            PG8_LDA(At, 0, 1); PG8_STAGE(PG8_SB(0, 0), b2, voffB); PG8_STAGE(PG8_SB(0, 1), b2 + hstep, voffB); PG8_STAGE(PG8_SA(0, 0), a2, voffA);
            PG8_WAIT_V(8); PG8_WAIT_L(0); PG8_BAR; PG8_MMA(1, 0, At, B0); PG8_MMA(1, 1, At, B1); PG8_BAR; PG8_SCHED;
            PG8_LDB(B0, 1, 0); PG8_LDB(B1, 1, 1); PG8_SCHED; PG8_LDA(At, 1, 0); PG8_STAGE(PG8_SA(0, 1), a2 + hstep, voffA);
            PG8_WAIT_V(8); PG8_WAIT_L(0); PG8_BAR; PG8_MMA(0, 0, At, B0); PG8_MMA(0, 1, At, B1); PG8_BAR; PG8_SCHED;
            PG8_LDA(At, 1, 1); PG8_STAGE(PG8_SB(1, 0), b3, voffB); PG8_STAGE(PG8_SB(1, 1), b3 + hstep, voffB); PG8_STAGE(PG8_SA(1, 0), a3, voffA);
            PG8_WAIT_V(8); PG8_WAIT_L(0); PG8_BAR; PG8_MMA(1, 0, At, B0); PG8_MMA(1, 1, At, B1); PG8_BAR; PG8_SCHED;
            } else {
            PG8_LDB(B0, 0, 0); PG8_SCHED; PG8_LDA(At, 0, 0); PG8_STAGE(PG8_SA(1, 1), a1 + hstep, voffA);
            PG8_WAIT_L(8); PG8_BAR; PG8_WAIT_L(0); PG8_MMA(0, 0, At, B0); PG8_BAR; PG8_SCHED;
            PG8_LDB(B1, 0, 1); PG8_STAGE(PG8_SB(0, 0), b2, voffB);
            PG8_BAR; PG8_WAIT_L(0); PG8_MMA(0, 1, At, B1); PG8_BAR;
            PG8_LDA(At, 0, 1); PG8_STAGE(PG8_SA(0, 0), a2, voffA);
            PG8_BAR; PG8_WAIT_L(0); PG8_MMA(1, 0, At, B0); PG8_BAR; PG8_SCHED;
            PG8_STAGE(PG8_SB(0, 1), b2 + hstep, voffB);
            PG8_WAIT_V(6); PG8_BAR; PG8_MMA(1, 1, At, B1); PG8_BAR;
            PG8_LDB(B0, 1, 0); PG8_SCHED; PG8_LDA(At, 1, 0); PG8_STAGE(PG8_SA(0, 1), a2 + hstep, voffA);
            PG8_WAIT_L(8); PG8_BAR; PG8_WAIT_L(0); PG8_MMA(0, 0, At, B0); PG8_BAR; PG8_SCHED;
            PG8_LDB(B1, 1, 1); PG8_STAGE(PG8_SB(1, 0), b3, voffB);
            PG8_BAR; PG8_WAIT_L(0); PG8_MMA(0, 1, At, B1); PG8_BAR;
            PG8_LDA(At, 1, 1); PG8_STAGE(PG8_SA(1, 0), a3, voffA);
            PG8_BAR; PG8_WAIT_L(0); PG8_MMA(1, 0, At, B0); PG8_BAR; PG8_SCHED;
            PG8_STAGE(PG8_SB(1, 1), b3 + hstep, voffB);
            PG8_WAIT_V(6); PG8_BAR; PG8_MMA(1, 1, At, B1); PG8_BAR;
            }
        }
        if constexpr (ALIGN_EPI) { if (wr == 0) PG8_BAR; }
        if constexpr (FP8) { asm volatile("s_nop 15\n\ts_nop 15\n\ts_nop 7" ::: "memory");
#pragma unroll
            for (int a = 0; a < 2; ++a)
#pragma unroll
                for (int b = 0; b < 2; ++b)
#pragma unroll
                    for (int m = 0; m < 4; ++m) asm volatile("" : "+v"(acc[a][b][m][0]), "+v"(acc[a][b][m][1])); }
        if constexpr (FP8 == 2) {
#pragma unroll
            for (int a = 0; a < 2; ++a)
#pragma unroll
                for (int b = 0; b < 2; ++b)
#pragma unroll
                    for (int m = 0; m < 4; ++m)
#pragma unroll
                        for (int n = 0; n < 2; ++n) { f32x4 v = acc[a][b][m][n]; v[0] = (float)__float_as_int(v[0]); v[1] = (float)__float_as_int(v[1]); v[2] = (float)__float_as_int(v[2]); v[3] = (float)__float_as_int(v[3]); acc[a][b][m][n] = v; } }
        if constexpr (!Epi::AFTER_DRAIN) { E(acc, cur, wr, wc, fr, fq); S.done(cur); }
        if (!has_next) break;
#pragma unroll
        for (int a = 0; a < 2; ++a)
#pragma unroll
            for (int b = 0; b < 2; ++b)
#pragma unroll
                for (int m = 0; m < 4; ++m)
#pragma unroll
                    for (int n = 0; n < 2; ++n) { acc[a][b][m][n] = (f32x4){0.f, 0.f, 0.f, 0.f}; if constexpr (FP8) asm volatile("" : "+v"(acc[a][b][m][n])); }
        cur = nxt; cA = nA; cB = nB; ++ui;
        if constexpr (ALIGN_EPI) { if (wr == 1) PG8_BAR; }
    }
    PG8_WAIT_V(0);
    if constexpr (!ALIGN_EPI) { if (wr == 0) PG8_BAR; }
    PG8_BAR;
    if constexpr (Epi::AFTER_DRAIN) { E.fused(acc, cur, wr, wc, fr, fq, lds, wid, lane); S.done(cur); }
#undef PG8_SA
#undef PG8_SB
#undef PG8_STAGE
#undef PG8_LDA
#undef PG8_LDB
#undef PG8_MMA
#undef PG8_LD8
#undef PG8_WAIT_V
#undef PG8_WAIT_L
#undef PG8_BAR
#undef PG8_SCHED
}
}
#ifndef PEER_FP8
#define PEER_FP8 3
#endif
#define PEER_FP8_P0 (PEER_FP8 != 0)
namespace mk {
typedef unsigned short bf16;
typedef unsigned v4u __attribute__((ext_vector_type(4)));
typedef float f32x4 __attribute__((ext_vector_type(4)));
typedef float f32x2 __attribute__((ext_vector_type(2)));
#define LAS __attribute__((address_space(3)))
constexpr int T = 8192, DM = 2048, SEQ = 4096, NPROJ = 11776, NEXP = 16384, NWAVES = 8;
constexpr int C_QA = 0, C_KA = 1024, C_VA = 1280, C_QR = 1536, C_KR = 2560, C_VR = 3584, C_GR = 5632, C_GA = 7680, C_GT = 9728;
constexpr float EPS = 1e-6f, LOG2E = 1.4426950408889634f;
constexpr size_t MiB = 1u << 20;
constexpr size_t WS_CTL = 0, CTL_BYTES = 1 * MiB;
constexpr size_t WS_SSQ = 512 * 1024, WS_R1 = 768 * 1024;
constexpr size_t WS_ROPE = 1 * MiB;
constexpr size_t WS_SK = 3 * MiB;
constexpr size_t WS_WIN = 4 * MiB;
constexpr size_t WS_WA = 50 * MiB, WS_WR = 54 * MiB, WS_WO = 62 * MiB, WS_WQ = 70 * MiB;
constexpr size_t WS_ED = 78 * MiB, WS_EU = 142 * MiB;
constexpr size_t WS_MG8 = 222 * MiB, WS_XS = 800 * 1024;
constexpr size_t WS_XB = 206 * MiB;
constexpr size_t WS_PROJ = 238 * MiB;
constexpr size_t WS_AO = 422 * MiB, WS_RO = 438 * MiB;
constexpr size_t WS_IDX = 470 * MiB, WS_GATE = 474 * MiB, WS_END = 478 * MiB;
constexpr int LDS_BYTES = 156672;
__constant__ float INV_FREQ[64] = {
1.000000000e+00f, 8.659643531e-01f, 7.498942018e-01f, 6.493816376e-01f, 5.623413324e-01f, 4.869675338e-01f, 4.216965139e-01f, 3.651741147e-01f, 3.162277639e-01f, 2.738419771e-01f, 2.371373922e-01f, 2.053525001e-01f, 1.778279394e-01f, 1.539926529e-01f, 1.333521456e-01f, 1.154782027e-01f, 1.000000015e-01f, 8.659642935e-02f, 7.498941571e-02f, 6.493816525e-02f, 5.623412877e-02f, 4.869675264e-02f, 4.216964915e-02f, 3.651741147e-02f, 3.162277862e-02f, 2.738419734e-02f, 2.371373586e-02f, 2.053524926e-02f, 1.778279431e-02f, 1.539926510e-02f, 1.333521493e-02f, 1.154781971e-02f, 9.999999776e-03f, 8.659643121e-03f, 7.498942316e-03f, 6.493816618e-03f, 5.623413250e-03f, 4.869675264e-03f, 4.216964822e-03f, 3.651741426e-03f, 3.162277862e-03f, 2.738419687e-03f, 2.371373819e-03f, 2.053525066e-03f, 1.778279431e-03f, 1.539926627e-03f, 1.333521446e-03f, 1.154781901e-03f, 1.000000047e-03f, 8.659643354e-04f, 7.498941850e-04f, 6.493816618e-04f, 5.623413017e-04f, 4.869675031e-04f, 4.216965463e-04f, 3.651741135e-04f, 3.162277862e-04f, 2.738419571e-04f, 2.371373848e-04f, 2.053525241e-04f, 1.778279402e-04f, 1.539926452e-04f, 1.333521504e-04f, 1.154782076e-04f};
__constant__ float LOG2G[8] = {-4.58036896131247886e-02f, -2.27200765000835289e-02f, -1.13153132278341461e-02f, -5.64656314114206272e-03f, -2.82051906237866263e-03f, -1.40957025467135363e-03f, -7.04612976589372706e-04f, -3.52263471629021385e-04f};

__device__ __forceinline__ unsigned f2bf(float f) { unsigned u = __builtin_bit_cast(unsigned, f); return (u + 0x7fffu + ((u >> 16) & 1u)) >> 16; }
__device__ __forceinline__ unsigned pk2(float lo, float hi) { return f2bf(lo) | (f2bf(hi) << 16); }
__device__ __forceinline__ float bflo(unsigned u) { return __uint_as_float(u << 16); }
__device__ __forceinline__ float bfhi(unsigned u) { return __uint_as_float(u & 0xffff0000u); }
__device__ __forceinline__ float bf2f(bf16 b) { return __uint_as_float((unsigned)b << 16); }
typedef __bf16 bf16x2_t __attribute__((ext_vector_type(2)));
__device__ __forceinline__ float dot2(unsigned a, unsigned b, float c) { return __builtin_amdgcn_fdot2_f32_bf16(__builtin_bit_cast(bf16x2_t, a), __builtin_bit_cast(bf16x2_t, b), c, false); }
__device__ __forceinline__ float dot8(v4u a, v4u b, float c) { c = dot2(a.x, b.x, c); c = dot2(a.y, b.y, c); c = dot2(a.z, b.z, c); c = dot2(a.w, b.w, c); return c; }
__device__ __forceinline__ float wave_sum(float v) {
#pragma unroll
    for (int o = 1; o < 64; o <<= 1) v += __shfl_xor(v, o);
    return v;
}
__device__ __forceinline__ float wave_max(float v) {
#pragma unroll
    for (int o = 1; o < 64; o <<= 1) v = fmaxf(v, __shfl_xor(v, o));
    return v;
}
__device__ __forceinline__ int wave_min_i(int v) {
#pragma unroll
    for (int o = 1; o < 64; o <<= 1) { const int w = __shfl_xor(v, o); v = w < v ? w : v; }
    return v;
}
__device__ __forceinline__ float rdlane(float v, int l) { return __uint_as_float((unsigned)__builtin_amdgcn_readlane((int)__float_as_uint(v), l)); }
__device__ __forceinline__ int rdlane_i(int v, int l) { return __builtin_amdgcn_readlane(v, l); }
#define LDS_WAIT() asm volatile("s_waitcnt lgkmcnt(0)" ::: "memory")

__device__ __forceinline__ int opq(int v) { asm volatile("" : "+v"(v)); return v; }
struct Frame {
    LAS unsigned char* lds; int tid, lane, wave, G, bid, gw, NGW;
    const float *x, *attn_norm, *w_in, *sinks, *w_attn, *w_ret, *w_out, *ffn_norm, *w_q, *sub_keys, *e_down, *e_up, *final_norm;
    float* out; unsigned char* ws;
};
__device__ __forceinline__ int proj_dst_col(int n) {
    const bool rope = (n < 1280) || (n >= 1536 && n < 3584);
    if (!rope) return n;
    const int hb = n & ~127, d = n & 127;
    return hb + ((d & 63) << 1) + (d >> 6);
}
__device__ __forceinline__ void p0_transpose_item(const float* W, int K, int N, const float* g, bf16* WT, bool perm, LAS float* scr, int item, int lane) {
    const int nblk = N / 64, kb = item / nblk, nb = item % nblk, k0 = 64 * kb, n0 = 64 * nb;
    const int lr = lane >> 4, lc = (lane & 15) * 4;
#pragma unroll 4
    for (int i = 0; i < 16; ++i) { const int kk = 4 * i + lr; f32x4 w = __builtin_nontemporal_load((const f32x4*)(W + (size_t)(k0 + kk) * N + n0 + lc)); if (g) w = w * g[k0 + kk];
        LAS float* d = scr + kk * 65 + lc; d[0] = w[0]; d[1] = w[1]; d[2] = w[2]; d[3] = w[3]; }
    LDS_WAIT(); asm volatile("" ::: "memory");
    const int c = lane & 7;
#pragma unroll
    for (int j = 0; j < 8; ++j) { const int n = (lane >> 3) + 8 * j; const LAS float* s = scr + (8 * c) * 65 + n;
        v4u o; o.x = pk2(s[0 * 65], s[1 * 65]); o.y = pk2(s[2 * 65], s[3 * 65]); o.z = pk2(s[4 * 65], s[5 * 65]); o.w = pk2(s[6 * 65], s[7 * 65]);
        int nd = n0 + n; if (perm) nd = proj_dst_col(nd);
        *(v4u*)(WT + (size_t)nd * K + k0 + 8 * c) = o; }
    LDS_WAIT(); asm volatile("" ::: "memory");
}
#ifndef GEMM1_FP8
#define GEMM1_FP8 1
#endif
#ifndef P3_FP8
#define P3_FP8 1
#endif
#ifndef P4_FP8
#define P4_FP8 1
#endif
#ifndef P3_FUSED
#define P3_FUSED 1
#endif
constexpr int P3_PITCH = P3_FUSED ? 3072 : 0;
constexpr float P3_AS = 16.0f;
#ifndef P5_I8
#define P5_I8 1
#endif
constexpr float P5_HS = 16.0f;
constexpr size_t WS_HB8 = 454 * MiB;                              static_assert(WS_HB8 == 422 * MiB + (size_t)pg8::HB8_OFF, "int8 h offset");
#ifndef GEMM1_I8
#define GEMM1_I8 1
#endif
constexpr float I8_WS = 1000.0f;
__device__ __forceinline__ unsigned pk4_i8(float a, float b, float c, float d) {
    a = fminf(fmaxf(a, -127.f), 127.f); b = fminf(fmaxf(b, -127.f), 127.f); c = fminf(fmaxf(c, -127.f), 127.f); d = fminf(fmaxf(d, -127.f), 127.f);
    const unsigned q0 = __float_as_uint(a + 12582912.0f), q1 = __float_as_uint(b + 12582912.0f), q2 = __float_as_uint(c + 12582912.0f), q3 = __float_as_uint(d + 12582912.0f);
    return __builtin_amdgcn_perm(__builtin_amdgcn_perm(q3, q2, 0x0c0c0400u), __builtin_amdgcn_perm(q1, q0, 0x0c0c0400u), 0x05040100u);
}
constexpr float G1_XS = 16.0f, G1_WS = 1024.0f;
__device__ __forceinline__ unsigned pk4_fp8(float a, float b, float c, float d) {
    a = fminf(fmaxf(a, -448.f), 448.f); b = fminf(fmaxf(b, -448.f), 448.f); c = fminf(fmaxf(c, -448.f), 448.f); d = fminf(fmaxf(d, -448.f), 448.f);
    int pw = 0; pw = __builtin_amdgcn_cvt_pk_fp8_f32(a, b, pw, false); pw = __builtin_amdgcn_cvt_pk_fp8_f32(c, d, pw, true); return (unsigned)pw;
}
__device__ __forceinline__ void p0_transpose_item_fp8(const float* W, int K, int N, const float* g, float scale, unsigned char* WT, bool perm, LAS float* scr, int item, int lane, int pitch = 0, bool i8 = false) {
    const int nblk = N / 64, kb = item / nblk, nb = item % nblk, k0 = 64 * kb, n0 = 64 * nb;
    const int lr = lane >> 4, lc = (lane & 15) * 4;
#pragma unroll 4
    for (int i = 0; i < 16; ++i) { const int kk = 4 * i + lr; f32x4 w = __builtin_nontemporal_load((const f32x4*)(W + (size_t)(k0 + kk) * N + n0 + lc)); w = w * ((g ? g[k0 + kk] : 1.0f) * scale);
        LAS float* d = scr + kk * 65 + lc; d[0] = w[0]; d[1] = w[1]; d[2] = w[2]; d[3] = w[3]; }
    LDS_WAIT(); asm volatile("" ::: "memory");
    const int c = lane & 7;
#pragma unroll
    for (int j = 0; j < 8; ++j) { const int n = (lane >> 3) + 8 * j; const LAS float* s = scr + (8 * c) * 65 + n;
        f32x2 o; if (i8) { o.x = __uint_as_float(pk4_i8(s[0 * 65], s[1 * 65], s[2 * 65], s[3 * 65])); o.y = __uint_as_float(pk4_i8(s[4 * 65], s[5 * 65], s[6 * 65], s[7 * 65])); }
        else { o.x = __uint_as_float(pk4_fp8(s[0 * 65], s[1 * 65], s[2 * 65], s[3 * 65])); o.y = __uint_as_float(pk4_fp8(s[4 * 65], s[5 * 65], s[6 * 65], s[7 * 65])); }
        int nd = n0 + n; if (perm) nd = proj_dst_col(nd);
        *(f32x2*)(WT + (size_t)nd * (pitch ? pitch : K) + k0 + 8 * c) = o; }
    LDS_WAIT(); asm volatile("" ::: "memory");
}
__device__ __forceinline__ void sincos_acc(float xf, float& sn, float& cs) {
    const double x = (double)xf;
    const double q = __builtin_rint(x * 0.63661977236758134308);
    const double r = __builtin_fma(-q, 1.57079632679489661923, x) - q * 6.123233995736766e-17;
    const double r2 = r * r;
    double s = -1.0 / 6227020800.0; s = s * r2 + 1.0 / 39916800.0; s = -s; s = s * r2 + 1.0 / 362880.0; s = -s;
    double ps = 1.0 / 6227020800.0;
    ps = ps * r2 - 1.0 / 39916800.0; ps = ps * r2 + 1.0 / 362880.0; ps = ps * r2 - 1.0 / 5040.0; ps = ps * r2 + 1.0 / 120.0; ps = ps * r2 - 1.0 / 6.0; ps = ps * r2 + 1.0;
    const double sv = ps * r;
    double pc = -1.0 / 87178291200.0;
    pc = pc * r2 + 1.0 / 479001600.0; pc = pc * r2 - 1.0 / 3628800.0; pc = pc * r2 + 1.0 / 40320.0; pc = pc * r2 - 1.0 / 720.0; pc = pc * r2 + 1.0 / 24.0; pc = pc * r2 - 0.5; pc = pc * r2 + 1.0;
    (void)s;
    const int qi = ((int)q) & 3;
    const double so = (qi == 0) ? sv : (qi == 1) ? pc : (qi == 2) ? -sv : -pc;
    const double co = (qi == 0) ? pc : (qi == 1) ? -sv : (qi == 2) ? -pc : sv;
    sn = (float)so; cs = (float)co;
}
__device__ __forceinline__ v4u pack8(f32x4 a, f32x4 b) { v4u o; o.x = pk2(a[0], a[1]); o.y = pk2(a[2], a[3]); o.z = pk2(b[0], b[1]); o.w = pk2(b[2], b[3]); return o; }

__device__ __forceinline__ void p0_prologue(Frame& F) {
    LAS float* scr = (LAS float*)(F.lds + F.wave * 16640);
    unsigned char* ws = F.ws;
    const int lane = opq(F.lane);
    constexpr int I_IN = (DM / 64) * (NPROJ / 64), I_A = (1024 / 64) * (DM / 64), I_S = (DM / 64) * (DM / 64);
    constexpr int NITEMS = I_IN + I_A + 3 * I_S;
    for (int it = F.gw; it < NITEMS; it += F.NGW) {
        int r = it;
        if (r < I_IN) { if (GEMM1_FP8) p0_transpose_item_fp8(F.w_in, DM, NPROJ, F.attn_norm, GEMM1_I8 ? I8_WS : G1_WS, ws + WS_WIN, true, scr, r, lane, 0, GEMM1_I8 != 0);
                        else p0_transpose_item(F.w_in, DM, NPROJ, F.attn_norm, (bf16*)(ws + WS_WIN), true, scr, r, lane); continue; } r -= I_IN;
        if (r < I_A) { if (P3_FP8) p0_transpose_item_fp8(F.w_attn, 1024, DM, nullptr, G1_WS, ws + WS_WA, false, scr, r, lane, P3_PITCH); else p0_transpose_item(F.w_attn, 1024, DM, nullptr, (bf16*)(ws + WS_WA), false, scr, r, lane); continue; } r -= I_A;
        if (r < I_S) { if (P3_FP8) p0_transpose_item_fp8(F.w_ret, DM, DM, nullptr, G1_WS, P3_FUSED ? ws + WS_WA + 1024 : ws + WS_WR, false, scr, r, lane, P3_PITCH); else p0_transpose_item(F.w_ret, DM, DM, nullptr, (bf16*)(ws + WS_WR), false, scr, r, lane); continue; } r -= I_S;
        if (r < I_S) { if (P4_FP8) p0_transpose_item_fp8(F.w_out, DM, DM, nullptr, G1_WS, ws + WS_WO, false, scr, r, lane); else p0_transpose_item(F.w_out, DM, DM, nullptr, (bf16*)(ws + WS_WO), false, scr, r, lane); continue; } r -= I_S;
        if (P5_I8) p0_transpose_item_fp8(F.w_q, DM, DM, F.ffn_norm, I8_WS, ws + WS_WQ, false, scr, r, lane, 0, true); else p0_transpose_item(F.w_q, DM, DM, F.ffn_norm, (bf16*)(ws + WS_WQ), false, scr, r, lane);
    }
    for (int row = F.gw; row < (PEER_FP8_P0 ? 0 : 2 * NEXP); row += F.NGW) {
        const float* src = (row < NEXP) ? F.e_down + (size_t)row * DM : F.e_up + (size_t)(row - NEXP) * DM;
        bf16* dst = (row < NEXP) ? (bf16*)(ws + WS_ED) + (size_t)row * DM : (bf16*)(ws + WS_EU) + (size_t)(row - NEXP) * DM;
        const f32x4* s4 = (const f32x4*)src;
#pragma unroll
        for (int j = 0; j < 4; ++j) { const f32x4 a = s4[128 * j + 2 * lane], b = s4[128 * j + 2 * lane + 1]; *(v4u*)(dst + 512 * j + 8 * lane) = pack8(a, b); }
    }
    for (int m = F.gw; m < T; m += F.NGW) {
        const f32x4* s4 = (const f32x4*)(F.x + (size_t)m * DM); float ss = 0.f; f32x4 xa[4], xb[4];
#pragma unroll
        for (int j = 0; j < 4; ++j) { const f32x4 a = __builtin_nontemporal_load(s4 + 128 * j + 2 * lane), b = __builtin_nontemporal_load(s4 + 128 * j + 2 * lane + 1); xa[j] = a; xb[j] = b;
            ss += (a[0] * a[0] + a[1] * a[1]) + (a[2] * a[2] + a[3] * a[3]) + (b[0] * b[0] + b[1] * b[1]) + (b[2] * b[2] + b[3] * b[3]); }
        ss = wave_sum(ss);
        const float r1v = 1.0f / sqrtf(ss * (1.0f / DM) + EPS);
        if (GEMM1_FP8 && GEMM1_I8) {
            float mx = 0.f;
#pragma unroll
            for (int j = 0; j < 4; ++j) mx = fmaxf(mx, fmaxf(fmaxf(fmaxf(fabsf(xa[j][0]), fabsf(xa[j][1])), fmaxf(fabsf(xa[j][2]), fabsf(xa[j][3]))), fmaxf(fmaxf(fabsf(xb[j][0]), fabsf(xb[j][1])), fmaxf(fabsf(xb[j][2]), fabsf(xb[j][3])))));
            mx = wave_max(mx); if (!(mx > 0.f)) mx = 1.0f;
            const float qs = 127.0f / mx;
            if (lane == 0) { ((float*)(ws + WS_R1))[m] = r1v * mx * (1.0f / 127.0f) * (1.0f / I8_WS); ((float*)(ws + WS_XS))[m] = mx * (1.0f / 127.0f); }
            unsigned char* dst = ws + WS_XB + (size_t)m * DM;
#pragma unroll
            for (int j = 0; j < 4; ++j) { const f32x4 a = xa[j] * qs, b = xb[j] * qs; f32x2 o; o.x = __uint_as_float(pk4_i8(a[0], a[1], a[2], a[3])); o.y = __uint_as_float(pk4_i8(b[0], b[1], b[2], b[3]));
                *(f32x2*)(dst + 512 * j + 8 * lane) = o; }
            continue;
        }
        if (lane == 0) ((float*)(ws + WS_R1))[m] = r1v;
        if (GEMM1_FP8) { unsigned char* dst = ws + WS_XB + (size_t)m * DM; const float sc = r1v * G1_XS;
#pragma unroll
            for (int j = 0; j < 4; ++j) { const f32x4 a = xa[j] * sc, b = xb[j] * sc; f32x2 o; o.x = __uint_as_float(pk4_fp8(a[0], a[1], a[2], a[3])); o.y = __uint_as_float(pk4_fp8(b[0], b[1], b[2], b[3]));
                *(f32x2*)(dst + 512 * j + 8 * lane) = o; }
        } else { bf16* dst = (bf16*)(ws + WS_XB) + (size_t)m * DM;
#pragma unroll
            for (int j = 0; j < 4; ++j) *(v4u*)(dst + 512 * j + 8 * lane) = pack8(xa[j], xb[j]); }
    }
    for (int c = F.gw; c < 2 * 8 * 128 * 128 / 512; c += F.NGW) {
        const f32x4* s4 = (const f32x4*)(F.sub_keys + (size_t)c * 512); const f32x4 a = s4[2 * lane], b = s4[2 * lane + 1];
        *(v4u*)((bf16*)(ws + WS_SK) + (size_t)c * 512 + 8 * lane) = pack8(a, b);
    }
    for (int c = F.gw; c < SEQ * 64 / 64; c += F.NGW) {
        const int e = c * 64 + lane, pos = e >> 6, i = e & 63; const float ang = (float)pos * INV_FREQ[i];
        float sn, cs; sincos_acc(ang, sn, cs);
        ((f32x2*)(ws + WS_ROPE))[e] = (f32x2){cs, sn};
    }
}

__device__ __forceinline__ void p2_attn_naive(Frame& F) {
    const bf16* PROJ = (const bf16*)(F.ws + WS_PROJ); bf16* AO = (bf16*)(F.ws + WS_AO); const int lane = F.lane;
    for (int it = F.gw; it < T * 8; it += F.NGW) {
        const int t = it >> 3, h = it & 7, pos = t & 4095, kvh = h >> 2;
        const v4u* qr = (const v4u*)(PROJ + (size_t)t * NPROJ + C_QA + h * 128);
        v4u q[16];
#pragma unroll
        for (int i = 0; i < 16; ++i) q[i] = qr[i];
        float s[2];
#pragma unroll
        for (int half = 0; half < 2; ++half) {
            const int sp = pos - 127 + lane + 64 * half; float acc = -1e30f;
            if (sp >= 0) { const v4u* kr = (const v4u*)(PROJ + (size_t)(t - pos + sp) * NPROJ + C_KA + kvh * 128); acc = 0.f;
#pragma unroll
                for (int i = 0; i < 16; ++i) acc = dot8(q[i], kr[i], acc); }
            s[half] = acc;
        }
        const float sink = F.sinks[h] * LOG2E;
        const float m = wave_max(fmaxf(fmaxf(s[0], s[1]), sink));
        const float p0 = exp2f(s[0] - m), p1 = exp2f(s[1] - m);
        const float l = wave_sum(p0 + p1) + exp2f(sink - m);
        float o0 = 0.f, o1 = 0.f;
        for (int j = 0; j < 128; ++j) {
            const int sp = pos - 127 + j; if (sp < 0) continue;
            const float pj = rdlane(j < 64 ? p0 : p1, j & 63);
            const unsigned vv = *(const unsigned*)(PROJ + (size_t)(t - pos + sp) * NPROJ + C_VA + kvh * 128 + 2 * lane);
            o0 += pj * bflo(vv); o1 += pj * bfhi(vv);
        }
        const float inv = 1.0f / l;
        *(unsigned*)(AO + (size_t)t * 1024 + h * 128 + 2 * lane) = pk2(o0 * inv, o1 * inv);
    }
}
__device__ __forceinline__ void p2_kv_naive(Frame& F, float* KV) {
    const bf16* PROJ = (const bf16*)(F.ws + WS_PROJ);
    for (int u = F.bid; u < 512; u += F.G) {
        const int b = u >> 8, h = (u >> 5) & 7, n = u & 31; const size_t t0 = (size_t)b * SEQ + n * 128; const float l2g = LOG2G[h];
        for (int de = F.tid; de < 32768; de += 512) {
            const int d = de >> 8, e = de & 255; float acc = 0.f;
            for (int k = 0; k < 128; ++k) {
                const float kk = bf2f(PROJ[(t0 + k) * NPROJ + C_KR + h * 128 + d]) * exp2f((float)(127 - k) * l2g);
                acc += kk * bf2f(PROJ[(t0 + k) * NPROJ + C_VR + h * 256 + e]);
            }
            KV[((size_t)u * 128 + d) * 256 + e] = acc;
        }
    }
}
__device__ __forceinline__ void p2_scan(Frame& F, float* KV) {
    bf16* S = (bf16*)KV;
    for (int c = F.bid * 512 + F.tid; c < 16 * 32768 / 4; c += F.G * 512) {
        const int bh = c >> 13, de = (c & 8191) * 4; const float cd = exp2f(128.0f * LOG2G[bh & 7]); float s0 = 0.f, s1 = 0.f, s2 = 0.f, s3 = 0.f;
#pragma unroll 1
        for (int n0 = 0; n0 < 32; n0 += 16) {
            unsigned long long v[16];
#pragma unroll
            for (int q = 0; q < 16; ++q) v[q] = *(const unsigned long long*)(S + ((size_t)(bh * 32 + n0 + q) * 32768 + de));
#pragma unroll
            for (int q = 0; q < 16; ++q) { const unsigned lo = (unsigned)v[q], hi = (unsigned)(v[q] >> 32);
                *(unsigned long long*)(S + ((size_t)(bh * 32 + n0 + q) * 32768 + de)) = (unsigned long long)pk2(s0, s1) | ((unsigned long long)pk2(s2, s3) << 32);
                s0 = s0 * cd + bflo(lo); s1 = s1 * cd + bfhi(lo); s2 = s2 * cd + bflo(hi); s3 = s3 * cd + bfhi(hi); } }
    }
}
__device__ __forceinline__ void p2_retout_naive(Frame& F, const float* KV) {
    const bf16* PROJ = (const bf16*)(F.ws + WS_PROJ); bf16* RO = (bf16*)(F.ws + WS_RO); const int lane = F.lane;
    for (int it = F.gw; it < T * 8; it += F.NGW) {
        const int t = it >> 3, h = it & 7, c = t & 127, t0 = t - c, b = t >> 12, n = (t & 4095) >> 7, u = (b * 8 + h) * 32 + n; const float l2g = LOG2G[h];
        const v4u* qr = (const v4u*)(PROJ + (size_t)t * NPROJ + C_QR + h * 128);
        v4u q[16];
#pragma unroll
        for (int i = 0; i < 16; ++i) q[i] = qr[i];
        float s[2];
#pragma unroll
        for (int half = 0; half < 2; ++half) {
            const int k = lane + 64 * half; float acc = 0.f;
            if (k <= c) { const v4u* kr = (const v4u*)(PROJ + (size_t)(t0 + k) * NPROJ + C_KR + h * 128);
#pragma unroll
                for (int i = 0; i < 16; ++i) acc = dot8(q[i], kr[i], acc);
                acc *= exp2f((float)(c - k) * l2g); }
            s[half] = acc;
        }
        float o[4] = {0.f, 0.f, 0.f, 0.f};
        for (int k = 0; k <= c; ++k) {
            const float sk = rdlane(k < 64 ? s[0] : s[1], k & 63); const bf16* vr = PROJ + (size_t)(t0 + k) * NPROJ + C_VR + h * 256 + lane;
#pragma unroll
            for (int j = 0; j < 4; ++j) o[j] += sk * bf2f(vr[64 * j]);
        }
        float oc[4] = {0.f, 0.f, 0.f, 0.f};
        const float* st = KV + (size_t)u * 32768 + lane;
#pragma unroll
        for (int i = 0; i < 16; ++i) {
            const unsigned w[4] = {q[i].x, q[i].y, q[i].z, q[i].w};
#pragma unroll
            for (int jj = 0; jj < 4; ++jj) {
                const float qlo = bflo(w[jj]), qhi = bfhi(w[jj]); const int d = 8 * i + 2 * jj;
#pragma unroll
                for (int j = 0; j < 4; ++j) { oc[j] += qlo * st[(size_t)d * 256 + 64 * j]; oc[j] += qhi * st[(size_t)(d + 1) * 256 + 64 * j]; }
            }
        }
        const float qd = exp2f((float)(c + 1) * l2g);
#pragma unroll
        for (int j = 0; j < 4; ++j) o[j] += qd * oc[j];
        const float mu = wave_sum((o[0] + o[1]) + (o[2] + o[3])) * (1.0f / 256.0f);
        float vs = 0.f;
#pragma unroll
        for (int j = 0; j < 4; ++j) { o[j] -= mu; vs += o[j] * o[j]; }
        const float rs = 1.0f / sqrtf(wave_sum(vs) * (1.0f / 256.0f) + EPS);
        const bf16* gr = PROJ + (size_t)t * NPROJ + C_GR + h * 256 + lane; bf16* orow = RO + (size_t)t * DM + h * 256 + lane;
#pragma unroll
        for (int j = 0; j < 4; ++j) orow[64 * j] = (bf16)f2bf(o[j] * rs * bf2f(gr[64 * j]));
    }
}
typedef short bf16x8 __attribute__((ext_vector_type(8)));
typedef short s16x4 __attribute__((ext_vector_type(4)));
#define MFMA16(a, b, c) __builtin_amdgcn_mfma_f32_16x16x32_bf16((a), (b), (c), 0, 0, 0)
__device__ __forceinline__ s16x4 tr16(const LAS unsigned char* p) { return __builtin_amdgcn_ds_read_tr16_b64_v4i16((LAS s16x4*)p); }
__device__ __forceinline__ bf16x8 cat8(s16x4 a, s16x4 b) { return (bf16x8){a[0], a[1], a[2], a[3], b[0], b[1], b[2], b[3]}; }
__device__ __forceinline__ v4u scale8(v4u v, float s) { v4u o; o.x = pk2(bflo(v.x) * s, bfhi(v.x) * s); o.y = pk2(bflo(v.y) * s, bfhi(v.y) * s); o.z = pk2(bflo(v.z) * s, bfhi(v.z) * s); o.w = pk2(bflo(v.w) * s, bfhi(v.w) * s); return o; }

__device__ __forceinline__ void p2_kv_mfma(Frame& F, float* KV) {
    const bf16* PROJ = (const bf16*)(F.ws + WS_PROJ);
    const int tid = opq(F.tid), lane = tid & 63, w = F.wave, g = lane >> 4, fr = lane & 15, q = fr >> 2, p = fr & 3;
    constexpr int PV = 528, PK = 272, VS = 0, KS = 128 * 528;
    LAS unsigned char* lds = F.lds;
    for (int u = F.bid; u < 512; u += F.G) {
        const int b = u >> 8, h = (u >> 5) & 7, n = u & 31; const size_t t0 = (size_t)b * SEQ + n * 128; const float l2g = LOG2G[h];
#pragma unroll
        for (int i = 0; i < 8; ++i) { const int c = tid + 512 * i, row = c >> 5, ch = c & 31;
            const v4u v = *(const v4u*)(PROJ + (t0 + row) * NPROJ + C_VR + h * 256 + ch * 8); *(LAS v4u*)(lds + VS + row * PV + ch * 16) = v; }
#pragma unroll
        for (int i = 0; i < 4; ++i) { const int c = tid + 512 * i, row = c >> 4, ch = c & 15;
            const v4u v = *(const v4u*)(PROJ + (t0 + row) * NPROJ + C_KR + h * 128 + ch * 8);
            *(LAS v4u*)(lds + KS + row * PK + ch * 16) = scale8(v, exp2f((float)(127 - row) * l2g)); }
        __syncthreads();
        f32x4 acc[8][2];
#pragma unroll
        for (int dt = 0; dt < 8; ++dt) { acc[dt][0] = (f32x4){0.f, 0.f, 0.f, 0.f}; acc[dt][1] = (f32x4){0.f, 0.f, 0.f, 0.f}; }
#pragma unroll
        for (int ks = 0; ks < 4; ++ks) {
            bf16x8 Bf[2];
#pragma unroll
            for (int ei = 0; ei < 2; ++ei) { const LAS unsigned char* ap = lds + VS + (32 * ks + 8 * g + q) * PV + (16 * (2 * w + ei) + 4 * p) * 2; Bf[ei] = cat8(tr16(ap), tr16(ap + 4 * PV)); }
#pragma unroll
            for (int dt = 0; dt < 8; ++dt) { const LAS unsigned char* ap = lds + KS + (32 * ks + 8 * g + q) * PK + (16 * dt + 4 * p) * 2; const bf16x8 Af = cat8(tr16(ap), tr16(ap + 4 * PK));
                acc[dt][0] = MFMA16(Af, Bf[0], acc[dt][0]); acc[dt][1] = MFMA16(Af, Bf[1], acc[dt][1]); }
        }
#pragma unroll
        for (int dt = 0; dt < 8; ++dt)
#pragma unroll
            for (int ei = 0; ei < 2; ++ei) { const int e = 16 * (2 * w + ei) + fr; const f32x4 a = acc[dt][ei];
                *(unsigned long long*)((bf16*)KV + ((size_t)u * 256 + e) * 128 + 16 * dt + 4 * g) = (unsigned long long)pk2(a[0], a[1]) | ((unsigned long long)pk2(a[2], a[3]) << 32); }
        __syncthreads();
    }
}
__device__ __forceinline__ float silu_f(float x) { return x * __builtin_amdgcn_rcpf(1.0f + __builtin_amdgcn_exp2f(x * -1.4426950408889634f)); }
__device__ __forceinline__ void p2_retout_mfma(Frame& F, const float* KV) {
    const bf16* PROJ = (const bf16*)(F.ws + WS_PROJ); bf16* RO = (bf16*)(F.ws + WS_RO);
    const int tid = opq(F.tid), lane = tid & 63, w = F.wave, g = lane >> 4, fr = lane & 15, q = fr >> 2, p = fr & 3;
    constexpr int P1 = 272, PV = 528, KS = 0, VS = 128 * 272, STS = 0;
    LAS unsigned char* lds = F.lds;
    for (int u = F.bid; u < 512; u += F.G) {
        const int b = u >> 8, h = (u >> 5) & 7, n = u & 31; const size_t t0 = (size_t)b * SEQ + n * 128; const float l2g = LOG2G[h];
        v4u kreg[4], vreg[8];
#pragma unroll
        for (int i = 0; i < 4; ++i) { const int c = tid + 512 * i, row = c >> 4, ch = c & 15; kreg[i] = *(const v4u*)(PROJ + (t0 + row) * NPROJ + C_KR + h * 128 + ch * 8); }
#pragma unroll
        for (int i = 0; i < 8; ++i) { const int c = tid + 512 * i, row = c >> 5, ch = c & 31; vreg[i] = *(const v4u*)(PROJ + (t0 + row) * NPROJ + C_VR + h * 256 + ch * 8); }
#pragma unroll
        for (int i = 0; i < 8; ++i) { const int c = tid + 512 * i, row = c >> 4, ch = c & 15;
            *(LAS v4u*)(lds + STS + row * P1 + ch * 16) = *(const v4u*)((const bf16*)KV + ((size_t)u * 256 + row) * 128 + ch * 8); }
        bf16x8 qf[4];
#pragma unroll
        for (int ds = 0; ds < 4; ++ds) qf[ds] = *(const bf16x8*)(PROJ + (t0 + 16 * w + fr) * NPROJ + C_QR + h * 128 + 32 * ds + 8 * g);
        __syncthreads();
        f32x4 acc[16];
#pragma unroll
        for (int et = 0; et < 16; ++et) { acc[et] = (f32x4){0.f, 0.f, 0.f, 0.f};
#pragma unroll
            for (int ds = 0; ds < 4; ++ds) { const bf16x8 A = *(const LAS bf16x8*)(lds + STS + (16 * et + fr) * P1 + (32 * ds + 8 * g) * 2); acc[et] = MFMA16(A, qf[ds], acc[et]); } }
        const int c = 16 * w + fr; const float qd = exp2f((float)(c + 1) * l2g);
#pragma unroll
        for (int et = 0; et < 16; ++et) acc[et] = acc[et] * qd;
        __syncthreads();
#pragma unroll
        for (int i = 0; i < 4; ++i) { const int cc = tid + 512 * i, row = cc >> 4, ch = cc & 15; *(LAS v4u*)(lds + KS + row * P1 + ch * 16) = kreg[i]; }
#pragma unroll
        for (int i = 0; i < 8; ++i) { const int cc = tid + 512 * i, row = cc >> 5, ch = cc & 31; *(LAS v4u*)(lds + VS + row * PV + ch * 16) = vreg[i]; }
        __syncthreads();
        float dq[4]; bool mk[4];
#pragma unroll
        for (int r = 0; r < 4; ++r) { dq[r] = exp2f((float)(fr - 4 * g - r) * l2g); mk[r] = (fr - 4 * g - r) >= 0; }
#pragma unroll 1
        for (int i2 = 0; 2 * i2 <= w; ++i2) {
            const int k0 = 2 * i2, k1 = 2 * i2 + 1;
            f32x4 s0 = {0.f, 0.f, 0.f, 0.f}, s1 = {0.f, 0.f, 0.f, 0.f};
#pragma unroll
            for (int ds = 0; ds < 4; ++ds) { const bf16x8 A0 = *(const LAS bf16x8*)(lds + KS + (16 * k0 + fr) * P1 + (32 * ds + 8 * g) * 2); s0 = MFMA16(A0, qf[ds], s0); }
            if (k1 <= w) {
#pragma unroll
                for (int ds = 0; ds < 4; ++ds) { const bf16x8 A1 = *(const LAS bf16x8*)(lds + KS + (16 * k1 + fr) * P1 + (32 * ds + 8 * g) * 2); s1 = MFMA16(A1, qf[ds], s1); } }
            const float tf0 = exp2f((float)(16 * (w - k0)) * l2g), tf1 = (k1 <= w) ? exp2f((float)(16 * (w - k1)) * l2g) : 0.f;
            const bool d0 = (k0 == w), d1 = (k1 == w);
#pragma unroll
            for (int r = 0; r < 4; ++r) { s0[r] = (!d0 || mk[r]) ? s0[r] * (dq[r] * tf0) : 0.f; s1[r] = (!d1 || mk[r]) ? s1[r] * (dq[r] * tf1) : 0.f; }
            v4u bp; bp.x = pk2(s0[0], s0[1]); bp.y = pk2(s0[2], s0[3]); bp.z = pk2(s1[0], s1[1]); bp.w = pk2(s1[2], s1[3]);
            const bf16x8 Bp = __builtin_bit_cast(bf16x8, bp);
            const int k1c = (k1 <= 7) ? k1 : 7;
            const LAS unsigned char* va0 = lds + VS + (16 * k0 + 4 * g + q) * PV + (4 * p) * 2; const LAS unsigned char* va1 = lds + VS + (16 * k1c + 4 * g + q) * PV + (4 * p) * 2;
#pragma unroll
            for (int et = 0; et < 16; ++et) { const s16x4 a0 = tr16(va0 + 32 * et), a1 = tr16(va1 + 32 * et);
                acc[et] = MFMA16(cat8(a0, a1), Bp, acc[et]); }
        }
        float sm = 0.f;
#pragma unroll
        for (int et = 0; et < 16; ++et) sm += (acc[et][0] + acc[et][1]) + (acc[et][2] + acc[et][3]);
        sm += __shfl_xor(sm, 16); sm += __shfl_xor(sm, 32);
        const float mu = sm * (1.0f / 256.0f); float vs = 0.f;
#pragma unroll
        for (int et = 0; et < 16; ++et) { acc[et] = acc[et] - mu; vs += (acc[et][0] * acc[et][0] + acc[et][1] * acc[et][1]) + (acc[et][2] * acc[et][2] + acc[et][3] * acc[et][3]); }
        vs += __shfl_xor(vs, 16); vs += __shfl_xor(vs, 32);
        const float rs = 1.0f / sqrtf(vs * (1.0f / 256.0f) + EPS);
        const size_t t = t0 + c;
#pragma unroll
        for (int et = 0; et < 16; ++et) { const int e0 = 16 * et + 4 * g;
            const unsigned long long gg = *(const unsigned long long*)(PROJ + t * NPROJ + C_GR + h * 256 + e0); const unsigned glo = (unsigned)gg, ghi = (unsigned)(gg >> 32);
            if (P3_FP8) { const float rq = rs * P3_AS; *(unsigned*)(P3_FUSED ? (unsigned char*)(F.ws + WS_AO) + t * 3072 + 1024 + h * 256 + e0 : (unsigned char*)RO + t * DM + h * 256 + e0) = pk4_fp8(acc[et][0] * rq * silu_f(bflo(glo)), acc[et][1] * rq * silu_f(bfhi(glo)), acc[et][2] * rq * silu_f(bflo(ghi)), acc[et][3] * rq * silu_f(bfhi(ghi))); }
            else { const unsigned o0 = pk2(acc[et][0] * rs * bflo(glo), acc[et][1] * rs * bfhi(glo)), o1 = pk2(acc[et][2] * rs * bflo(ghi), acc[et][3] * rs * bfhi(ghi));
            *(unsigned long long*)(RO + t * DM + h * 256 + e0) = (unsigned long long)o0 | ((unsigned long long)o1 << 32); } }
        __syncthreads();
    }
}
__device__ __forceinline__ void p2_attn_mfma(Frame& F) {
    const bf16* PROJ = (const bf16*)(F.ws + WS_PROJ); bf16* AO = (bf16*)(F.ws + WS_AO);
    const int tid = opq(F.tid), lane = tid & 63, w = F.wave, g = lane >> 4, fr = lane & 15, q = fr >> 2, p = fr & 3;
    constexpr int PK = 272, KS = 0, VS = 192 * 272;
    LAS unsigned char* lds = F.lds;
    for (int u = F.bid; u < 256; u += F.G) {
        const int b = u >> 7, kvh = (u >> 6) & 1, qb = u & 63, q0 = qb * 64; const size_t tb = (size_t)b * SEQ;
#pragma unroll
        for (int i = 0; i < 6; ++i) { const int c = tid + 512 * i, row = c >> 4, ch = c & 15, kp = q0 - 128 + row;
            v4u kv = {0u, 0u, 0u, 0u}, vv = {0u, 0u, 0u, 0u};
            if (kp >= 0) { kv = *(const v4u*)(PROJ + (tb + kp) * NPROJ + C_KA + kvh * 128 + ch * 8); vv = *(const v4u*)(PROJ + (tb + kp) * NPROJ + C_VA + kvh * 128 + ch * 8); }
            *(LAS v4u*)(lds + KS + row * PK + ch * 16) = kv; *(LAS v4u*)(lds + VS + row * PK + ch * 16) = vv; }
        __syncthreads();
        const int hq = w >> 1, qh = w & 1, h = kvh * 4 + hq; const float sink = F.sinks[h] * LOG2E;
#pragma unroll 1
        for (int qt = 0; qt < 2; ++qt) {
            const int qpos = q0 + 32 * qh + 16 * qt + fr;
            bf16x8 qf[4];
#pragma unroll
            for (int ds = 0; ds < 4; ++ds) qf[ds] = *(const bf16x8*)(PROJ + (tb + qpos) * NPROJ + C_QA + h * 128 + 32 * ds + 8 * g);
            const int rb = 32 * qh + 16 * qt;
            f32x4 s[10]; float m = sink;
#pragma unroll
            for (int j = 0; j < 9; ++j) { s[j] = (f32x4){0.f, 0.f, 0.f, 0.f};
#pragma unroll
                for (int ds = 0; ds < 4; ++ds) { const bf16x8 A = *(const LAS bf16x8*)(lds + KS + (rb + 16 * j + fr) * PK + (32 * ds + 8 * g) * 2); s[j] = MFMA16(A, qf[ds], s[j]); } }
            s[9] = (f32x4){-1e30f, -1e30f, -1e30f, -1e30f};
#pragma unroll
            for (int r = 0; r < 4; ++r) { const int dd = fr - 4 * g - r; s[0][r] = (dd < 0) ? s[0][r] : -1e30f; s[8][r] = (dd >= 0) ? s[8][r] : -1e30f; }
            if (q0 < 128) {
#pragma unroll
                for (int j = 0; j < 9; ++j)
#pragma unroll
                    for (int r = 0; r < 4; ++r) { const int kp = q0 - 128 + rb + 16 * j + 4 * g + r; s[j][r] = (kp >= 0) ? s[j][r] : -1e30f; } }
#pragma unroll
            for (int j = 0; j < 9; ++j) m = fmaxf(m, fmaxf(fmaxf(s[j][0], s[j][1]), fmaxf(s[j][2], s[j][3])));
            m = fmaxf(m, __shfl_xor(m, 16)); m = fmaxf(m, __shfl_xor(m, 32));
            float l = 0.f;
#pragma unroll
            for (int j = 0; j < 10; ++j)
#pragma unroll
                for (int r = 0; r < 4; ++r) { s[j][r] = __builtin_amdgcn_exp2f(s[j][r] - m); l += s[j][r]; }
            l += __shfl_xor(l, 16); l += __shfl_xor(l, 32); l += __builtin_amdgcn_exp2f(sink - m);
            f32x4 o[8];
#pragma unroll
            for (int dt = 0; dt < 8; ++dt) o[dt] = (f32x4){0.f, 0.f, 0.f, 0.f};
#pragma unroll
            for (int st = 0; st < 5; ++st) {
                v4u bp; bp.x = pk2(s[2 * st][0], s[2 * st][1]); bp.y = pk2(s[2 * st][2], s[2 * st][3]); bp.z = pk2(s[2 * st + 1][0], s[2 * st + 1][1]); bp.w = pk2(s[2 * st + 1][2], s[2 * st + 1][3]);
                const bf16x8 Bp = __builtin_bit_cast(bf16x8, bp);
                const LAS unsigned char* va = lds + VS + (rb + 32 * st + 4 * g + q) * PK + (4 * p) * 2;
                const int o1 = (st < 4) ? 16 * PK : 0;
#pragma unroll
                for (int dt = 0; dt < 8; ++dt) { const s16x4 a0 = tr16(va + 32 * dt), a1 = tr16(va + o1 + 32 * dt); o[dt] = MFMA16(cat8(a0, a1), Bp, o[dt]); }
            }
            const float inv = 1.0f / l;
#pragma unroll
            for (int dt = 0; dt < 8; ++dt) {
                if (P3_FP8) { const float is = inv * P3_AS; *(unsigned*)((unsigned char*)AO + (tb + qpos) * (P3_FUSED ? 3072 : 1024) + h * 128 + 16 * dt + 4 * g) = pk4_fp8(o[dt][0] * is, o[dt][1] * is, o[dt][2] * is, o[dt][3] * is); }
                else { const unsigned o0 = pk2(o[dt][0] * inv, o[dt][1] * inv), o1 = pk2(o[dt][2] * inv, o[dt][3] * inv);
                *(unsigned long long*)(AO + (tb + qpos) * 1024 + h * 128 + 16 * dt + 4 * g) = (unsigned long long)o0 | ((unsigned long long)o1 << 32); } }
        }
        __syncthreads();
    }
}
template <int CTRL> __device__ __forceinline__ float dppf(float v) { return __builtin_bit_cast(float, __builtin_amdgcn_update_dpp(0, __builtin_bit_cast(int, v), CTRL, 0xF, 0xF, true)); }
template <int CTRL> __device__ __forceinline__ int dppi(int v) { return __builtin_amdgcn_update_dpp(0, v, CTRL, 0xF, 0xF, true); }
__device__ __forceinline__ float g16_max(float v) { v = fmaxf(v, dppf<0xB1>(v)); v = fmaxf(v, dppf<0x4E>(v)); v = fmaxf(v, dppf<0x141>(v)); v = fmaxf(v, dppf<0x140>(v)); return v; }
__device__ __forceinline__ float g16_sum(float v) { v += dppf<0xB1>(v); v += dppf<0x4E>(v); v += dppf<0x141>(v); v += dppf<0x140>(v); return v; }
__device__ __forceinline__ int g16_min(int v) { v = min(v, dppi<0xB1>(v)); v = min(v, dppi<0x4E>(v)); v = min(v, dppi<0x141>(v)); v = min(v, dppi<0x140>(v)); return v; }
__constant__ unsigned char CAND_SLOT[64] = {
    0, 1, 2, 3, 4, 5, 6, 7, 8, 9, 10, 11, 12, 13, 14, 15,
    16, 17, 18, 19, 20, 21, 22, 23, 32, 33, 34, 35, 36, 48, 49, 50,
    51, 64, 65, 66, 80, 81, 96, 97, 112, 113, 128, 144, 160, 176, 192, 208,
    224, 240, 255, 255, 255, 255, 255, 255, 255, 255, 255, 255, 255, 255, 255, 255};
__device__ __forceinline__ void p5_topk_mfma(Frame& F) {
    const bf16* QRY = (const bf16*)(F.ws + WS_PROJ); const bf16* SK = (const bf16*)(F.ws + WS_SK);
    int* IDX = (int*)(F.ws + WS_IDX); float* GATE = (float*)(F.ws + WS_GATE);
    const int lane = opq(F.lane), w = F.wave, g = lane >> 4, fr = lane & 15;
    LAS unsigned char* lds = F.lds;
    int cslot[4];
#pragma unroll
    for (int s = 0; s < 4; ++s) cslot[s] = CAND_SLOT[16 * s + fr];
    for (int u = F.bid; u < 1024; u += F.G) {
        const int tbk = u >> 3, h = u & 7, pp = w >> 2, tt = w & 3;
        bf16x8 af[4];
#pragma unroll
        for (int ds = 0; ds < 4; ++ds) af[ds] = *(const bf16x8*)(QRY + (size_t)(64 * tbk + 16 * tt + fr) * DM + h * 256 + pp * 128 + 32 * ds + 8 * g);
        f32x4 sc[8];
#pragma unroll
        for (int nt = 0; nt < 8; ++nt) { sc[nt] = (f32x4){0.f, 0.f, 0.f, 0.f};
#pragma unroll
            for (int ds = 0; ds < 4; ++ds) { const bf16x8 Bk = *(const bf16x8*)(SK + (size_t)((pp * 8 + h) * 128 + 16 * nt + fr) * 128 + 32 * ds + 8 * g); sc[nt] = MFMA16(af[ds], Bk, sc[nt]); } }
#pragma unroll
        for (int r = 0; r < 4; ++r) {
            float v[8];
#pragma unroll
            for (int nt = 0; nt < 8; ++nt) v[nt] = sc[nt][r];
            float tv = 0.f; int ti = 0;
#pragma unroll 1
            for (int rd = 0; rd < 16; ++rd) {
                float lm = fmaxf(fmaxf(fmaxf(v[0], v[1]), fmaxf(v[2], v[3])), fmaxf(fmaxf(v[4], v[5]), fmaxf(v[6], v[7])));
                const float mx = g16_max(lm);
                int li = 1 << 20;
#pragma unroll
                for (int nt = 7; nt >= 0; --nt) li = (v[nt] == mx) ? (16 * nt + fr) : li;
                const int wi = g16_min(li);
#pragma unroll
                for (int nt = 0; nt < 8; ++nt) v[nt] = (wi == 16 * nt + fr) ? -INFINITY : v[nt];
                if (fr == rd) { tv = mx; ti = wi; }
            }
            const int tok = 16 * tt + 4 * g + r;
            *(LAS f32x2*)(lds + ((tok * 2 + pp) * 16 + fr) * 8) = (f32x2){tv, __int_as_float(ti)};
        }
        __syncthreads();
#pragma unroll 1
        for (int tk = 0; tk < 2; ++tk) {
            const int tok = 8 * w + 2 * g + tk;
            const LAS f32x2* La = (const LAS f32x2*)(lds + (tok * 2 + 0) * 128); const LAS f32x2* Lb = (const LAS f32x2*)(lds + (tok * 2 + 1) * 128);
            float cv[4];
#pragma unroll
            for (int s = 0; s < 4; ++s) { const int ij = cslot[s]; cv[s] = (ij == 255) ? -INFINITY : La[(ij >> 4) & 15].x + Lb[ij & 15].x; }
            float bs = 0.f, m0 = 0.f; int be = 0;
#pragma unroll 1
            for (int rd = 0; rd < 16; ++rd) {
                const float lm = fmaxf(fmaxf(cv[0], cv[1]), fmaxf(cv[2], cv[3]));
                const float mx = g16_max(lm);
                int li = 1 << 20;
#pragma unroll
                for (int s = 3; s >= 0; --s) li = (cv[s] == mx && cslot[s] < li) ? cslot[s] : li;
                const int wf = g16_min(li);
#pragma unroll
                for (int s = 0; s < 4; ++s) cv[s] = (cslot[s] == wf) ? -INFINITY : cv[s];
                if (rd == 0) m0 = mx;
                if (fr == rd) { bs = mx; be = wf; }
            }
            const int ex_id = __float_as_int(La[(be >> 4) & 15].y) * 128 + __float_as_int(Lb[be & 15].y);
            const float ex = __expf(bs - m0); const float sum = g16_sum(ex);
            const size_t o = (size_t)(64 * tbk + tok) * 128 + h * 16 + fr;
            IDX[o] = ex_id; GATE[o] = ex / sum;
        }
        __syncthreads();
    }
}
__device__ __forceinline__ int f2sort(float f) { const int i = __float_as_int(f); return i ^ ((i >> 31) & 0x7fffffff); }
__device__ __forceinline__ float sort2f(int k) { return __int_as_float(k ^ ((k >> 31) & 0x7fffffff)); }
__device__ __forceinline__ int g16_max_i(int v) { v = max(v, dppi<0xB1>(v)); v = max(v, dppi<0x4E>(v)); v = max(v, dppi<0x141>(v)); v = max(v, dppi<0x140>(v)); return v; }
#define TK_CE(a, b) do { const int hi_ = max((a), (b)), lo_ = min((a), (b)); (a) = hi_; (b) = lo_; } while (0)
constexpr int QL_OFF = 86016, QL_PITCH = 528;
__device__ __forceinline__ void p5_topk_v2(Frame& F, int tile_pm = -1, int tile_pn = 0, int half = -1, bool load_keys = true) {
    const bf16* QRY = (const bf16*)(F.ws + WS_PROJ); const bf16* SK = (const bf16*)(F.ws + WS_SK);
    int* IDX = (int*)(F.ws + WS_IDX); float* GATE = (float*)(F.ws + WS_GATE);
    const int lane = opq(F.lane), w = F.wave, g = lane >> 4, fr = lane & 15;
    LAS unsigned char* lds = F.lds + 69632;
    LAS unsigned char* kl = F.lds;
    const bool keys_in_lds = (tile_pm >= 0) || (F.G & 7) == 0;
    if (keys_in_lds && load_keys) { const int hh = (tile_pm >= 0) ? tile_pn : (F.bid & 7);
#pragma unroll
        for (int i = 0; i < 8; ++i) { const int c = F.tid + 512 * i, row = c >> 4, ch = c & 15, pq = row >> 7, n = row & 127;
            *(LAS v4u*)(kl + row * 272 + ch * 16) = *(const v4u*)(SK + (size_t)((pq * 8 + hh) * 128 + n) * 128 + ch * 8); }
        __syncthreads(); }
    int cslot[4];
#pragma unroll
    for (int s = 0; s < 4; ++s) cslot[s] = CAND_SLOT[16 * s + fr];
    const int u_first = (tile_pm >= 0) ? (32 * tile_pm + (half > 0 ? 16 : 0) + tile_pn) : F.bid, u_step = (tile_pm >= 0) ? 8 : F.G, u_end = (tile_pm >= 0) ? (32 * tile_pm + (half == 0 ? 16 : 32)) : 1024;
    for (int u = u_first; u < u_end; u += u_step) {
        const int tbk = u >> 3, h = u & 7, pp = w >> 2, tt = w & 3;
        bf16x8 af[4];
#pragma unroll
        for (int ds = 0; ds < 4; ++ds) { if (half >= 0) af[ds] = *(const LAS bf16x8*)(F.lds + QL_OFF + (64 * (tbk & 1) + 16 * tt + fr) * QL_PITCH + (pp * 128 + 32 * ds + 8 * g) * 2);
            else af[ds] = *(const bf16x8*)(QRY + (size_t)(64 * tbk + 16 * tt + fr) * DM + h * 256 + pp * 128 + 32 * ds + 8 * g); }
        f32x4 sc[8];
#pragma unroll
        for (int nt = 0; nt < 8; ++nt) { sc[nt] = (f32x4){0.f, 0.f, 0.f, 0.f};
#pragma unroll
            for (int ds = 0; ds < 4; ++ds) { bf16x8 Bk;
                if (keys_in_lds) Bk = *(const LAS bf16x8*)(kl + (pp * 128 + 16 * nt + fr) * 272 + (32 * ds + 8 * g) * 2);
                else Bk = *(const bf16x8*)(SK + (size_t)((pp * 8 + h) * 128 + 16 * nt + fr) * 128 + 32 * ds + 8 * g);
                sc[nt] = MFMA16(af[ds], Bk, sc[nt]); } }
        int k[4][8];
#pragma unroll
        for (int r = 0; r < 4; ++r) {
#pragma unroll
            for (int nt = 0; nt < 8; ++nt) k[r][nt] = (f2sort(sc[nt][r]) & ~127) | (127 - (16 * nt + fr));
            TK_CE(k[r][0], k[r][1]); TK_CE(k[r][2], k[r][3]); TK_CE(k[r][4], k[r][5]); TK_CE(k[r][6], k[r][7]);
            TK_CE(k[r][0], k[r][2]); TK_CE(k[r][1], k[r][3]); TK_CE(k[r][4], k[r][6]); TK_CE(k[r][5], k[r][7]);
            TK_CE(k[r][1], k[r][2]); TK_CE(k[r][5], k[r][6]);
            TK_CE(k[r][0], k[r][4]); TK_CE(k[r][1], k[r][5]); TK_CE(k[r][2], k[r][6]); TK_CE(k[r][3], k[r][7]);
            TK_CE(k[r][2], k[r][4]); TK_CE(k[r][3], k[r][5]);
            TK_CE(k[r][1], k[r][2]); TK_CE(k[r][3], k[r][4]); TK_CE(k[r][5], k[r][6]);
        }
        int res[4] = {0, 0, 0, 0};
#pragma unroll 1
        for (int rd = 0; rd < 16; ++rd) {
#pragma unroll
            for (int r = 0; r < 4; ++r) {
                const int mx = g16_max_i(k[r][0]); const bool win = (k[r][0] == mx);
#pragma unroll
                for (int i = 0; i < 7; ++i) k[r][i] = win ? k[r][i + 1] : k[r][i];
                k[r][7] = win ? (int)0x80000000 : k[r][7];
                res[r] = (fr == rd) ? mx : res[r];
            }
        }
#pragma unroll
        for (int r = 0; r < 4; ++r) { const int tok = 16 * tt + 4 * g + r;
            *(LAS f32x2*)(lds + ((tok * 2 + pp) * 16 + fr) * 8) = (f32x2){sort2f(res[r] & ~127), __int_as_float(127 - (res[r] & 127))}; }
        __syncthreads();
        int c[2][4];
#pragma unroll
        for (int tk = 0; tk < 2; ++tk) { const int tok = 8 * w + 2 * g + tk;
            const LAS f32x2* La = (const LAS f32x2*)(lds + (tok * 2 + 0) * 128); const LAS f32x2* Lb = (const LAS f32x2*)(lds + (tok * 2 + 1) * 128);
#pragma unroll
            for (int s = 0; s < 4; ++s) { const int ij = cslot[s]; c[tk][s] = (ij == 255) ? (int)0x80000000 : ((f2sort(La[(ij >> 4) & 15].x + Lb[ij & 15].x) & ~255) | (255 - ij)); }
            TK_CE(c[tk][0], c[tk][1]); TK_CE(c[tk][2], c[tk][3]); TK_CE(c[tk][0], c[tk][2]); TK_CE(c[tk][1], c[tk][3]); TK_CE(c[tk][1], c[tk][2]); }
        int rs2[2] = {0, 0}, m0[2] = {0, 0};
#pragma unroll 1
        for (int rd = 0; rd < 16; ++rd) {
#pragma unroll
            for (int tk = 0; tk < 2; ++tk) {
                const int mx = g16_max_i(c[tk][0]); const bool win = (c[tk][0] == mx);
                c[tk][0] = win ? c[tk][1] : c[tk][0]; c[tk][1] = win ? c[tk][2] : c[tk][1]; c[tk][2] = win ? c[tk][3] : c[tk][2]; c[tk][3] = win ? (int)0x80000000 : c[tk][3];
                rs2[tk] = (fr == rd) ? mx : rs2[tk]; m0[tk] = (rd == 0) ? mx : m0[tk];
            }
        }
#pragma unroll
        for (int tk = 0; tk < 2; ++tk) { const int tok = 8 * w + 2 * g + tk;
            const LAS f32x2* La = (const LAS f32x2*)(lds + (tok * 2 + 0) * 128); const LAS f32x2* Lb = (const LAS f32x2*)(lds + (tok * 2 + 1) * 128);
            const int flat = 255 - (rs2[tk] & 255);
            const int ex_id = __float_as_int(La[(flat >> 4) & 15].y) * 128 + __float_as_int(Lb[flat & 15].y);
            const float ex = __expf(sort2f(rs2[tk] & ~255) - sort2f(m0[tk] & ~255)); const float sum = g16_sum(ex);
            const size_t o = (size_t)(64 * tbk + tok) * 128 + h * 16 + fr;
            IDX[o] = ex_id; GATE[o] = ex / sum; }
        __syncthreads();
    }
}
__device__ __forceinline__ void p5_topk_naive(Frame& F) {
    const bf16* QRY = (const bf16*)(F.ws + WS_PROJ); const bf16* SK = (const bf16*)(F.ws + WS_SK);
    int* IDX = (int*)(F.ws + WS_IDX); float* GATE = (float*)(F.ws + WS_GATE); const int lane = F.lane;
    LAS float* wts = (LAS float*)(F.lds + F.wave * 512); LAS int* wti = (LAS int*)(F.lds + F.wave * 512 + 128);
    LAS float* wbs = (LAS float*)(F.lds + F.wave * 512 + 256); LAS int* wbi = (LAS int*)(F.lds + F.wave * 512 + 320);
    for (int it = F.gw; it < T * 8; it += F.NGW) {
        const int t = it >> 3, h = it & 7;
#pragma unroll
        for (int p = 0; p < 2; ++p) {
            const v4u* qr = (const v4u*)(QRY + (size_t)t * DM + h * 256 + p * 128);
            v4u q[16];
#pragma unroll
            for (int i = 0; i < 16; ++i) q[i] = qr[i];
            float v[2];
#pragma unroll
            for (int half = 0; half < 2; ++half) { const v4u* kr = (const v4u*)(SK + ((size_t)((p * 8 + h) * 128 + lane + 64 * half)) * 128); float acc = 0.f;
#pragma unroll
                for (int i = 0; i < 16; ++i) acc = dot8(q[i], kr[i], acc);
                v[half] = acc; }
#pragma unroll
            for (int r = 0; r < 16; ++r) {
                const float bv = fmaxf(v[0], v[1]); const int bi = (v[0] >= v[1]) ? lane : lane + 64;
                const float mx = wave_max(bv);
                const int widx = wave_min_i(bv == mx ? bi : 1 << 20);
                if (lane == 0) { wts[p * 16 + r] = mx; wti[p * 16 + r] = widx; }
                if (lane == (widx & 63)) { if (widx < 64) v[0] = -INFINITY; else v[1] = -INFINITY; }
            }
        }
        LDS_WAIT(); asm volatile("" ::: "memory");
        float cv[4];
        const float tb = wts[16 + (lane & 15)];
#pragma unroll
        for (int qq = 0; qq < 4; ++qq) cv[qq] = wts[(lane >> 4) + 4 * qq] + tb;
#pragma unroll
        for (int r = 0; r < 16; ++r) {
            float bv = cv[0]; int bf = lane;
#pragma unroll
            for (int qq = 1; qq < 4; ++qq) if (cv[qq] > bv) { bv = cv[qq]; bf = lane + 64 * qq; }
            const float mx = wave_max(bv);
            const int fmin = wave_min_i(bv == mx ? bf : 1 << 20);
            if (lane == 0) { wbs[r] = mx; wbi[r] = wti[fmin >> 4] * 128 + wti[16 + (fmin & 15)]; }
            if (lane == (fmin & 63)) {
#pragma unroll
                for (int qq = 0; qq < 4; ++qq) if ((fmin >> 6) == qq) cv[qq] = -INFINITY; }
        }
        LDS_WAIT(); asm volatile("" ::: "memory");
        const float bs = (lane < 16) ? wbs[lane] : -INFINITY; const float bmax = wbs[0];
        const float ex = (lane < 16) ? __expf(bs - bmax) : 0.f; const float sum = wave_sum(ex);
        if (lane < 16) { IDX[(size_t)t * 128 + h * 16 + lane] = wbi[lane]; GATE[(size_t)t * 128 + h * 16 + lane] = ex / sum; }
        LDS_WAIT(); asm volatile("" ::: "memory");
    }
}
__device__ __forceinline__ float gelu_erf(float v) { return 0.5f * v * (1.0f + erff(v * 0.70710678118654752f)); }
__device__ __forceinline__ void p6_peer(Frame& F) {
    const bf16* ED = (const bf16*)(F.ws + WS_ED); const bf16* EU = (const bf16*)(F.ws + WS_EU);
    const int* IDX = (const int*)(F.ws + WS_IDX); const float* GATE = (const float*)(F.ws + WS_GATE); const float* ssq = (const float*)(F.ws + WS_SSQ);
    const int lane = F.lane;
    for (int t = F.gw; t < T; t += F.NGW) {
        float* hrow = F.out + (size_t)t * DM;
        const float r2 = 1.0f / sqrtf(__hip_atomic_load(ssq + t, __ATOMIC_RELAXED, __HIP_MEMORY_SCOPE_AGENT) * (1.0f / DM) + EPS);
        v4u hn[4];
#pragma unroll
        for (int j = 0; j < 4; ++j) { const f32x4 a = ((const f32x4*)hrow)[128 * j + 2 * lane], b = ((const f32x4*)hrow)[128 * j + 2 * lane + 1];
            const f32x4 ga = ((const f32x4*)F.ffn_norm)[128 * j + 2 * lane], gb = ((const f32x4*)F.ffn_norm)[128 * j + 2 * lane + 1];
            hn[j] = pack8(a * r2 * ga, b * r2 * gb); }
        const int id0 = IDX[(size_t)t * 128 + lane], id1 = IDX[(size_t)t * 128 + 64 + lane];
        const float g0 = GATE[(size_t)t * 128 + lane], g1 = GATE[(size_t)t * 128 + 64 + lane];
        float c0 = 0.f, c1 = 0.f;
#pragma unroll 1
        for (int e0 = 0; e0 < 128; e0 += 4) {
            float part[4];
#pragma unroll
            for (int ee = 0; ee < 4; ++ee) { const int e = e0 + ee; const int row = rdlane_i(e < 64 ? id0 : id1, e & 63);
                const v4u* rp = (const v4u*)(ED + (size_t)row * DM) + lane; float acc = 0.f;
#pragma unroll
                for (int j = 0; j < 4; ++j) acc = dot8(hn[j], rp[64 * j], acc);
                part[ee] = acc; }
#pragma unroll
            for (int ee = 0; ee < 4; ++ee) { const int e = e0 + ee; const float uu = wave_sum(part[ee]); const float cc = gelu_erf(uu);
                if (lane == (e & 63)) { if (e < 64) c0 = cc * g0; else c1 = cc * g1; } }
        }
        f32x4 y[8];
#pragma unroll
        for (int j = 0; j < 8; ++j) y[j] = (f32x4){0.f, 0.f, 0.f, 0.f};
#pragma unroll 1
        for (int e0 = 0; e0 < 128; e0 += 4) {
#pragma unroll
            for (int ee = 0; ee < 4; ++ee) { const int e = e0 + ee; const int row = rdlane_i(e < 64 ? id0 : id1, e & 63); const float ce = rdlane(e < 64 ? c0 : c1, e & 63);
                const v4u* rp = (const v4u*)(EU + (size_t)row * DM) + lane;
#pragma unroll
                for (int j = 0; j < 4; ++j) { const v4u w = rp[64 * j];
                    y[2 * j][0] += ce * bflo(w.x); y[2 * j][1] += ce * bfhi(w.x); y[2 * j][2] += ce * bflo(w.y); y[2 * j][3] += ce * bfhi(w.y);
                    y[2 * j + 1][0] += ce * bflo(w.z); y[2 * j + 1][1] += ce * bfhi(w.z); y[2 * j + 1][2] += ce * bflo(w.w); y[2 * j + 1][3] += ce * bfhi(w.w); } }
        }
        float ss = 0.f;
#pragma unroll
        for (int j = 0; j < 4; ++j) { const f32x4 a = ((const f32x4*)hrow)[128 * j + 2 * lane], b = ((const f32x4*)hrow)[128 * j + 2 * lane + 1];
            y[2 * j] += a; y[2 * j + 1] += b;
            const f32x4 u0 = y[2 * j], u1 = y[2 * j + 1];
            ss += (u0[0] * u0[0] + u0[1] * u0[1]) + (u0[2] * u0[2] + u0[3] * u0[3]) + (u1[0] * u1[0] + u1[1] * u1[1]) + (u1[2] * u1[2] + u1[3] * u1[3]); }
        const float rf = 1.0f / sqrtf(wave_sum(ss) * (1.0f / DM) + EPS);
#pragma unroll
        for (int j = 0; j < 4; ++j) { const f32x4 ga = ((const f32x4*)F.final_norm)[128 * j + 2 * lane], gb = ((const f32x4*)F.final_norm)[128 * j + 2 * lane + 1];
            ((f32x4*)hrow)[128 * j + 2 * lane] = y[2 * j] * rf * ga; ((f32x4*)hrow)[128 * j + 2 * lane + 1] = y[2 * j + 1] * rf * gb; }
    }
}

#ifndef PEER_FP8
#define PEER_FP8 1
#endif
constexpr size_t WS_ESC = WS_SK + 512 * 1024;
__device__ __forceinline__ float wave_sum_fast(float v) { v = g16_sum(v); v += __shfl_xor(v, 16); v += __shfl_xor(v, 32); return v; }
template <bool FP8> __device__ __forceinline__ void p6_peer2(Frame& F) {
    constexpr int NCH = FP8 ? 2 : 4, ROWB = FP8 ? 2048 : 4096, NR = FP8 ? 4 : 2;
    const unsigned char* ED = F.ws + WS_ED; const unsigned char* EU = F.ws + WS_EU; const float* ESC = (const float*)(F.ws + WS_ESC);
    const int* IDX = (const int*)(F.ws + WS_IDX); const float* GATE = (const float*)(F.ws + WS_GATE); const float* ssq = (const float*)(F.ws + WS_SSQ);
    const int lane = F.lane;
#define P6_LOAD(BUF, TAB, E0) do { _Pragma("unroll") for (int ee = 0; ee < NR; ++ee) { const int e_ = (E0) + ee; const int row_ = rdlane_i(e_ < 64 ? id0 : id1, e_ & 63); \
        const v4u* rp_ = (const v4u*)((TAB) + (size_t)row_ * ROWB) + lane; _Pragma("unroll") for (int j = 0; j < NCH; ++j) BUF[ee][j] = rp_[64 * j]; } } while (0)
#define P6_DOTS(BUF, E0) do { _Pragma("unroll") for (int ee = 0; ee < NR; ++ee) { const int e_ = (E0) + ee; float part_; \
        if constexpr (FP8) { f32x2 acc_ = {0.f, 0.f}; \
            _Pragma("unroll") for (int j = 0; j < 2; ++j) { const unsigned wd_[4] = {BUF[ee][j].x, BUF[ee][j].y, BUF[ee][j].z, BUF[ee][j].w}; \
                _Pragma("unroll") for (int k = 0; k < 4; ++k) { acc_ = __builtin_elementwise_fma(hf[8 * j + 2 * k], __builtin_amdgcn_cvt_pk_f32_fp8((int)wd_[k], false), acc_); \
                    acc_ = __builtin_elementwise_fma(hf[8 * j + 2 * k + 1], __builtin_amdgcn_cvt_pk_f32_fp8((int)wd_[k], true), acc_); } } \
            part_ = acc_.x + acc_.y; \
        } else { part_ = 0.f; _Pragma("unroll") for (int j = 0; j < NCH; ++j) part_ = dot8(hn[j & 3], BUF[ee][j], part_); } \
        float uu_ = wave_sum_fast(part_); \
        if constexpr (FP8) { const int row_ = rdlane_i(e_ < 64 ? id0 : id1, e_ & 63); uu_ *= ESC[row_]; } \
        const float cc_ = gelu_erf(uu_); \
        if (lane == (e_ & 63)) { if (e_ < 64) c0 = cc_ * g0; else c1 = cc_ * g1; } \
        asm volatile("" ::: "memory"); } } while (0)
#define P6_AXPY(BUF, E0) do { _Pragma("unroll") for (int ee = 0; ee < NR; ++ee) { const int e_ = (E0) + ee; float ce_ = rdlane(e_ < 64 ? c0 : c1, e_ & 63); \
        if constexpr (FP8) { const int row_ = rdlane_i(e_ < 64 ? id0 : id1, e_ & 63); ce_ *= ESC[NEXP + row_]; const f32x2 ce2_ = {ce_, ce_}; \
            _Pragma("unroll") for (int j = 0; j < 2; ++j) { const unsigned wd_[4] = {BUF[ee][j].x, BUF[ee][j].y, BUF[ee][j].z, BUF[ee][j].w}; \
                _Pragma("unroll") for (int k = 0; k < 4; ++k) { f32x2 lo_ = {y[4 * j + k][0], y[4 * j + k][1]}, hi_ = {y[4 * j + k][2], y[4 * j + k][3]}; \
                    lo_ = __builtin_elementwise_fma(ce2_, __builtin_amdgcn_cvt_pk_f32_fp8((int)wd_[k], false), lo_); hi_ = __builtin_elementwise_fma(ce2_, __builtin_amdgcn_cvt_pk_f32_fp8((int)wd_[k], true), hi_); \
                    y[4 * j + k] = (f32x4){lo_.x, lo_.y, hi_.x, hi_.y}; } } \
        } else { _Pragma("unroll") for (int j = 0; j < NCH; ++j) { const v4u w_ = BUF[ee][j]; const int a_ = (2 * j) & 7, b_ = (2 * j + 1) & 7; \
                y[a_][0] += ce_ * bflo(w_.x); y[a_][1] += ce_ * bfhi(w_.x); y[a_][2] += ce_ * bflo(w_.y); y[a_][3] += ce_ * bfhi(w_.y); \
                y[b_][0] += ce_ * bflo(w_.z); y[b_][1] += ce_ * bfhi(w_.z); y[b_][2] += ce_ * bflo(w_.w); y[b_][3] += ce_ * bfhi(w_.w); } } } } while (0)
#pragma unroll 1
    for (int t = F.gw; t < T; t += F.NGW) {
        float* hrow = F.out + (size_t)t * DM;
        const float r2 = 1.0f / sqrtf(__hip_atomic_load(ssq + t, __ATOMIC_RELAXED, __HIP_MEMORY_SCOPE_AGENT) * (1.0f / DM) + EPS);
        v4u hn[4]; f32x2 hf[16];
        if constexpr (FP8) {
#pragma unroll
            for (int j = 0; j < 2; ++j)
#pragma unroll
                for (int k = 0; k < 4; ++k) { const f32x4 a = ((const f32x4*)hrow)[256 * j + 4 * lane + k] * r2 * ((const f32x4*)F.ffn_norm)[256 * j + 4 * lane + k];
                    hf[8 * j + 2 * k] = (f32x2){a[0], a[1]}; hf[8 * j + 2 * k + 1] = (f32x2){a[2], a[3]}; }
        } else {
#pragma unroll
            for (int j = 0; j < 4; ++j) { const f32x4 a = ((const f32x4*)hrow)[128 * j + 2 * lane], b = ((const f32x4*)hrow)[128 * j + 2 * lane + 1];
                const f32x4 ga = ((const f32x4*)F.ffn_norm)[128 * j + 2 * lane], gb = ((const f32x4*)F.ffn_norm)[128 * j + 2 * lane + 1];
                hn[j] = pack8(a * r2 * ga, b * r2 * gb); }
        }
        const int id0 = IDX[(size_t)t * 128 + lane], id1 = IDX[(size_t)t * 128 + 64 + lane];
        const float g0 = GATE[(size_t)t * 128 + lane], g1 = GATE[(size_t)t * 128 + 64 + lane];
        float c0 = 0.f, c1 = 0.f;
        v4u A[NR][NCH], B[NR][NCH];
        P6_LOAD(A, ED, 0);
#pragma unroll 1
        for (int e0 = 0; e0 < 128; e0 += 2 * NR) {
            P6_LOAD(B, ED, e0 + NR);
            P6_DOTS(A, e0);
            if (e0 + 2 * NR < 128) P6_LOAD(A, ED, e0 + 2 * NR);
            P6_DOTS(B, e0 + NR);
        }
        f32x4 y[8];
#pragma unroll
        for (int j = 0; j < 8; ++j) y[j] = (f32x4){0.f, 0.f, 0.f, 0.f};
        P6_LOAD(A, EU, 0);
#pragma unroll 1
        for (int e0 = 0; e0 < 128; e0 += 2 * NR) {
            P6_LOAD(B, EU, e0 + NR);
            P6_AXPY(A, e0);
            if (e0 + 2 * NR < 128) P6_LOAD(A, EU, e0 + 2 * NR);
            P6_AXPY(B, e0 + NR);
        }
        float ss = 0.f;
#pragma unroll
        for (int j = 0; j < 8; ++j) { const int fi = FP8 ? (256 * (j >> 2) + 4 * lane + (j & 3)) : (128 * (j >> 1) + 2 * lane + (j & 1));
            y[j] += ((const f32x4*)hrow)[fi]; ss += (y[j][0] * y[j][0] + y[j][1] * y[j][1]) + (y[j][2] * y[j][2] + y[j][3] * y[j][3]); }
        const float rf = 1.0f / sqrtf(wave_sum(ss) * (1.0f / DM) + EPS);
#pragma unroll
        for (int j = 0; j < 8; ++j) { const int fi = FP8 ? (256 * (j >> 2) + 4 * lane + (j & 3)) : (128 * (j >> 1) + 2 * lane + (j & 1));
            ((f32x4*)hrow)[fi] = y[j] * rf * ((const f32x4*)F.final_norm)[fi]; }
    }
#undef P6_LOAD
#undef P6_DOTS
#undef P6_AXPY
}
__device__ __forceinline__ void p0_experts_fp8(Frame& F) {
    const int lane = F.lane; float* ESC = (float*)(F.ws + WS_ESC);
    for (int row = F.gw; row < 2 * NEXP; row += F.NGW) {
        const float* src = (row < NEXP) ? F.e_down + (size_t)row * DM : F.e_up + (size_t)(row - NEXP) * DM;
        unsigned char* dst = (row < NEXP) ? F.ws + WS_ED + (size_t)row * 2048 : F.ws + WS_EU + (size_t)(row - NEXP) * 2048;
        f32x4 v[8]; float am = 0.f;
#pragma unroll
        for (int j = 0; j < 2; ++j)
#pragma unroll
            for (int k = 0; k < 4; ++k) { const f32x4 a = ((const f32x4*)src)[256 * j + 4 * lane + k]; v[4 * j + k] = a;
                am = fmaxf(am, fmaxf(fmaxf(fabsf(a[0]), fabsf(a[1])), fmaxf(fabsf(a[2]), fabsf(a[3])))); }
        am = wave_max(am); if (!(am > 0.f)) am = 1.0f;
        const float sc = 448.0f / am;
        if (lane == 0) ESC[row] = am * (1.0f / 448.0f);
#pragma unroll
        for (int j = 0; j < 2; ++j) { v4u o;
#pragma unroll
            for (int k = 0; k < 4; ++k) { const f32x4 a = v[4 * j + k] * sc; int pw = 0; pw = __builtin_amdgcn_cvt_pk_fp8_f32(a[0], a[1], pw, false); pw = __builtin_amdgcn_cvt_pk_fp8_f32(a[2], a[3], pw, true);
                if (k == 0) o.x = (unsigned)pw; else if (k == 1) o.y = (unsigned)pw; else if (k == 2) o.z = (unsigned)pw; else o.w = (unsigned)pw; }
            *(v4u*)(dst + 1024 * j + 16 * lane) = o; }
    }
}
typedef float f32x16 __attribute__((ext_vector_type(16)));
typedef float f32x32 __attribute__((ext_vector_type(32)));
typedef unsigned u32x6 __attribute__((ext_vector_type(6)));
typedef unsigned u32x2 __attribute__((ext_vector_type(2)));
struct EpiQryLds {
    static constexpr bool PERM = true, AFTER_DRAIN = true; static constexpr int MID = 0;
    Frame& F; const float* ssq; float fixed;
    __device__ __forceinline__ void operator()(const pg8::f32x4 (&)[2][2][4][2], const pg8::Unit&, int, int, int, int) const {}
    __device__ __forceinline__ void fused(const pg8::f32x4 (&acc)[2][2][4][2], const pg8::Unit& u, int wr, int wc, int fr, int fq, LAS unsigned char* lds, int, int) const {
        const int upm = __builtin_amdgcn_readfirstlane(u.pm), upn = __builtin_amdgcn_readfirstlane(u.pn);
        v4u pk[2][4][2];
#pragma unroll
        for (int half = 0; half < 2; ++half)
#pragma unroll
            for (int m = 0; m < 4; ++m) { const int rl = wr * 64 + 16 * m + fr;
                const float rs = fixed / sqrtf(__hip_atomic_load(ssq + upm * 256 + 128 * half + rl, __ATOMIC_RELAXED, __HIP_MEMORY_SCOPE_AGENT) * (1.0f / DM) + EPS);
#pragma unroll
                for (int bj = 0; bj < 2; ++bj) { const pg8::f32x4 v0 = acc[half][bj][m][0] * rs, v1 = acc[half][bj][m][1] * rs;
                    v4u w; w.x = pg8::cvt_pk_bf16(v0[0], v0[1]); w.y = pg8::cvt_pk_bf16(v0[2], v0[3]); w.z = pg8::cvt_pk_bf16(v1[0], v1[1]); w.w = pg8::cvt_pk_bf16(v1[2], v1[3]); pk[half][m][bj] = w; } }
#pragma unroll
        for (int half = 0; half < 2; ++half) {
#pragma unroll
            for (int m = 0; m < 4; ++m)
#pragma unroll
                for (int bj = 0; bj < 2; ++bj) *(LAS v4u*)(lds + QL_OFF + (wr * 64 + 16 * m + fr) * QL_PITCH + (128 * bj + 32 * wc + 8 * fq) * 2) = pk[half][m][bj];
            __syncthreads();
            p5_topk_v2(F, upm, upn, half, half == 0);
            __syncthreads();
        }
    }
};
struct __attribute__((packed, aligned(4))) U3 { unsigned a, b, c; };
__device__ __forceinline__ void p0_experts_fp6(Frame& F) {
    const int lane = F.lane; float* ESC = (float*)(F.ws + WS_ESC);
    for (int row = F.gw; row < 2 * NEXP; row += F.NGW) {
        const float* src = (row < NEXP) ? F.e_down + (size_t)row * DM : F.e_up + (size_t)(row - NEXP) * DM;
        unsigned char* dst = (row < NEXP) ? F.ws + WS_ED + (size_t)row * 1536 : F.ws + WS_EU + (size_t)(row - NEXP) * 1536;
        f32x4 v[8]; float am = 0.f;
#pragma unroll
        for (int i = 0; i < 8; ++i) { const f32x4 a = ((const f32x4*)src)[64 * i + lane]; v[i] = a;
            am = fmaxf(am, fmaxf(fmaxf(fabsf(a[0]), fabsf(a[1])), fmaxf(fabsf(a[2]), fabsf(a[3])))); }
        am = wave_max(am); if (!(am > 0.f)) am = 1.0f;
        const float sc = 7.5f / am;
        if (lane == 0) ESC[row] = am * (1.0f / 7.5f);
        f32x16 x, y;
#pragma unroll
        for (int k = 0; k < 16; ++k) { x[k] = v[k >> 1][2 * (k & 1)] * sc; y[k] = v[k >> 1][2 * (k & 1) + 1] * sc; }
        const u32x6 p = __builtin_amdgcn_cvt_scalef32_2xpk16_fp6_f32(x, y, 1.0f);
        *(v4u*)(dst + 16 * lane) = (v4u){p[0], p[1], p[2], p[3]};
        *(u32x2*)(dst + 1024 + 8 * lane) = (u32x2){p[4], p[5]};
    }
}
__device__ __forceinline__ void p6_peer_fp6(Frame& F) {
    constexpr int ROWB = 1536, NR = 4;
    const unsigned char* ED = F.ws + WS_ED; const unsigned char* EU = F.ws + WS_EU; const float* ESC = (const float*)(F.ws + WS_ESC);
    const int* IDX = (const int*)(F.ws + WS_IDX); const float* GATE = (const float*)(F.ws + WS_GATE); const float* ssq = (const float*)(F.ws + WS_SSQ);
    const int lane = F.lane;
#define P6F_LOAD(BA, BB, TAB, E0) do { _Pragma("unroll") for (int ee = 0; ee < NR; ++ee) { const int e_ = (E0) + ee; const int row_ = rdlane_i(e_ < 64 ? id0 : id1, e_ & 63); \
        const unsigned char* rp_ = (TAB) + (size_t)row_ * ROWB; BA[ee] = *(const v4u*)(rp_ + 16 * lane); BB[ee] = *(const u32x2*)(rp_ + 1024 + 8 * lane); } } while (0)
#define P6F_DEC(BA, BB, ee) __builtin_amdgcn_cvt_scalef32_pk32_f32_fp6((u32x6){BA[ee].x, BA[ee].y, BA[ee].z, BA[ee].w, BB[ee].x, BB[ee].y}, 1.0f)
#define P6F_DOTS(BA, BB, E0) do { _Pragma("unroll") for (int ee = 0; ee < NR; ++ee) { const int e_ = (E0) + ee; const f32x32 w_ = P6F_DEC(BA, BB, ee); \
        float p0_ = 0.f, p1_ = 0.f; _Pragma("unroll") for (int i = 0; i < 16; ++i) { p0_ += hf[2 * i] * w_[2 * i]; p1_ += hf[2 * i + 1] * w_[2 * i + 1]; } \
        const int row_ = rdlane_i(e_ < 64 ? id0 : id1, e_ & 63); const float uu_ = wave_sum_fast(p0_ + p1_) * ESC[row_]; \
        const float cc_ = gelu_erf(uu_); \
        if (lane == (e_ & 63)) { if (e_ < 64) c0 = cc_ * g0; else c1 = cc_ * g1; } \
        __builtin_amdgcn_sched_barrier(0); } } while (0)
#define P6F_AXPY(BA, BB, E0) do { _Pragma("unroll") for (int ee = 0; ee < NR; ++ee) { const int e_ = (E0) + ee; const int row_ = rdlane_i(e_ < 64 ? id0 : id1, e_ & 63); \
        const float ce_ = rdlane(e_ < 64 ? c0 : c1, e_ & 63) * ESC[NEXP + row_]; const f32x32 w_ = P6F_DEC(BA, BB, ee); \
        _Pragma("unroll") for (int i = 0; i < 32; ++i) y[i] += ce_ * w_[i]; __builtin_amdgcn_sched_barrier(0); } } while (0)
#pragma unroll 1
    for (int t = F.gw; t < T; t += F.NGW) {
        float* hrow = F.out + (size_t)t * DM;
        const float r2 = 1.0f / sqrtf(__hip_atomic_load(ssq + t, __ATOMIC_RELAXED, __HIP_MEMORY_SCOPE_AGENT) * (1.0f / DM) + EPS);
        int ln = lane; asm volatile("" : "+v"(ln));
        float hf[32];
#pragma unroll
        for (int i = 0; i < 8; ++i) { const f32x4 a = ((const f32x4*)hrow)[64 * i + ln] * r2 * ((const f32x4*)F.ffn_norm)[64 * i + ln];
            hf[4 * i] = a[0]; hf[4 * i + 1] = a[1]; hf[4 * i + 2] = a[2]; hf[4 * i + 3] = a[3]; }
        const int id0 = IDX[(size_t)t * 128 + lane], id1 = IDX[(size_t)t * 128 + 64 + lane];
        const float g0 = GATE[(size_t)t * 128 + lane], g1 = GATE[(size_t)t * 128 + 64 + lane];
        float c0 = 0.f, c1 = 0.f;
        v4u A0[NR], B0[NR]; u32x2 A1[NR], B1[NR];
        P6F_LOAD(A0, A1, ED, 0);
#pragma unroll 1
        for (int e0 = 0; e0 < 128; e0 += 2 * NR) {
            P6F_LOAD(B0, B1, ED, e0 + NR);
            P6F_DOTS(A0, A1, e0);
            if (e0 + 2 * NR < 128) P6F_LOAD(A0, A1, ED, e0 + 2 * NR);
            P6F_DOTS(B0, B1, e0 + NR);
        }
        float y[32];
#pragma unroll
        for (int i = 0; i < 32; ++i) y[i] = 0.f;
        P6F_LOAD(A0, A1, EU, 0);
#pragma unroll 1
        for (int e0 = 0; e0 < 128; e0 += 2 * NR) {
            P6F_LOAD(B0, B1, EU, e0 + NR);
            P6F_AXPY(A0, A1, e0);
            if (e0 + 2 * NR < 128) P6F_LOAD(A0, A1, EU, e0 + 2 * NR);
            P6F_AXPY(B0, B1, e0 + NR);
        }
        float ss = 0.f; int l2 = lane; asm volatile("" : "+v"(l2));
#pragma unroll
        for (int i = 0; i < 8; ++i) { const f32x4 a = ((const f32x4*)hrow)[64 * i + l2];
            y[4 * i] += a[0]; y[4 * i + 1] += a[1]; y[4 * i + 2] += a[2]; y[4 * i + 3] += a[3];
            ss += (y[4 * i] * y[4 * i] + y[4 * i + 1] * y[4 * i + 1]) + (y[4 * i + 2] * y[4 * i + 2] + y[4 * i + 3] * y[4 * i + 3]); }
        const float rf = 1.0f / sqrtf(wave_sum(ss) * (1.0f / DM) + EPS);
#pragma unroll
        for (int i = 0; i < 8; ++i) { const f32x4 gf = ((const f32x4*)F.final_norm)[64 * i + l2];
            ((f32x4*)hrow)[64 * i + l2] = (f32x4){y[4 * i] * rf * gf[0], y[4 * i + 1] * rf * gf[1], y[4 * i + 2] * rf * gf[2], y[4 * i + 3] * rf * gf[3]}; }
    }
#undef P6F_LOAD
#undef P6F_DEC
#undef P6F_DOTS
#undef P6F_AXPY
}
constexpr size_t WS_U = WS_XB;
constexpr size_t WS_SSZ = 256 * 1024;
__device__ __forceinline__ void p0_exp_load(const Frame& F, int row, int lane, f32x4 (&a)[8]) {
    const bool dn = row < NEXP; const int e = dn ? row : row - NEXP;
    const f32x4* src = (const f32x4*)((dn ? F.e_down : F.e_up) + (size_t)e * DM);
#pragma unroll
    for (int i = 0; i < 8; ++i) a[i] = __builtin_nontemporal_load(src + 64 * i + lane);
}
__device__ __forceinline__ void p0_exp_conv(Frame& F, int row, int lane, const f32x4 (&a)[8], const f32x4 (&g)[8]) {
    const bool dn = row < NEXP; const int e = dn ? row : row - NEXP;
    float* ESC = (float*)(F.ws + WS_ESC);
    unsigned char* dst = F.ws + (dn ? WS_ED : WS_EU) + ((size_t)(lane >> 3) * NEXP + e) * 192;
    LAS f32x4* rs = (LAS f32x4*)(F.lds + F.wave * 16640);
#pragma unroll
    for (int i = 0; i < 8; ++i) { const int idx = 64 * i + lane; f32x4 w = a[i]; if (dn) w = w * g[i];
        rs[idx + (idx >> 3)] = w; }
    LDS_WAIT(); asm volatile("" ::: "memory");
    f32x4 v[8]; float am = 0.f;
#pragma unroll
    for (int i = 0; i < 8; ++i) { const int idx = 8 * lane + i; const f32x4 w = rs[idx + (idx >> 3)];
        v[i] = w; am = fmaxf(am, fmaxf(fmaxf(fabsf(w[0]), fabsf(w[1])), fmaxf(fabsf(w[2]), fabsf(w[3])))); }
    LDS_WAIT(); asm volatile("" ::: "memory");
    am = wave_max(am); if (!(am > 0.f)) am = 1.0f;
    if (dn) {
        const float sq = 127.0f / am;
        if (lane == 0) ESC[row] = am * (1.0f / 127.0f);
        unsigned d[8];
#pragma unroll
        for (int i = 0; i < 8; ++i) { const unsigned q0 = __float_as_uint(fmaf(v[i][0], sq, 12582912.0f)), q1 = __float_as_uint(fmaf(v[i][1], sq, 12582912.0f)), q2 = __float_as_uint(fmaf(v[i][2], sq, 12582912.0f)), q3 = __float_as_uint(fmaf(v[i][3], sq, 12582912.0f));
            d[i] = __builtin_amdgcn_perm(__builtin_amdgcn_perm(q3, q2, 0x0c0c0400u), __builtin_amdgcn_perm(q1, q0, 0x0c0c0400u), 0x05040100u); }
        unsigned char* d8 = F.ws + WS_ED + ((size_t)(lane >> 2) * NEXP + e) * 128 + 32 * (lane & 3);
        *(v4u*)d8 = (v4u){d[0], d[1], d[2], d[3]}; *(v4u*)(d8 + 16) = (v4u){d[4], d[5], d[6], d[7]};
        return;
    }
    const float sc = 7.5f / am;
    if (lane == 0) ESC[row] = am * (1.0f / 7.5f);
    f32x16 x, y;
#pragma unroll
    for (int k = 0; k < 16; ++k) { x[k] = v[k >> 1][2 * (k & 1)] * sc; y[k] = v[k >> 1][2 * (k & 1) + 1] * sc; }
    const u32x6 p = __builtin_amdgcn_cvt_scalef32_2xpk16_fp6_f32(x, y, 1.0f);
    const int s = lane & 7;
    *(U3*)(dst + 12 * s) = (U3){p[0], p[1], p[2]};
    *(U3*)(dst + 96 + 12 * s) = (U3){p[3], p[4], p[5]};
}
constexpr int P0_DEFER = 6144;
__device__ __forceinline__ int p0_defer_rows(int G) { return (((T / 256) * (NPROJ / 256)) % G != 0) ? P0_DEFER : 0; }
__device__ __forceinline__ void p0_experts_fp6s(Frame& F, int row0, int NR, int widx, int step) {
    const int lane = F.lane;
    f32x4 g[8];
#pragma unroll
    for (int i = 0; i < 8; ++i) g[i] = ((const f32x4*)F.ffn_norm)[64 * i + lane];
    f32x4 a[8], b[8];
    int row = row0 + widx;
    if (row < NR) p0_exp_load(F, row, lane, a);
    while (row < NR) {
        const int r2 = row + step, r3 = r2 + step;
        p0_exp_load(F, r2 < NR ? r2 : row, lane, b);
        p0_exp_conv(F, row, lane, a, g);
        p0_exp_load(F, r3 < NR ? r3 : row, lane, a);
        if (r2 < NR) p0_exp_conv(F, r2, lane, b, g);
        row = r3;
    }
}
__device__ __forceinline__ float g8_sum(float v) { v += dppf<0xB1>(v); v += dppf<0x4E>(v); v += dppf<0x141>(v); return v; }
#define P6S_LOADN(BA, BB, N_, TAB, IT0, IDA_, IDB_) do { _Pragma("unroll") for (int q_ = 0; q_ < (N_); ++q_) { const int it_ = (IT0) + q_; const int e_ = __shfl((it_ < 8) ? (IDA_) : (IDB_), gq + 8 * (it_ & 7)); \
        const unsigned char* rp_ = (TAB) + (size_t)e_ * 192; BA[q_] = *(const v4u*)(rp_ + 16 * s); BB[q_] = *(const u32x2*)(rp_ + 128 + 8 * s); } } while (0)
#define P6S_DEC(BA, BB, q_) __builtin_amdgcn_cvt_scalef32_pk32_f32_fp6((u32x6){BA[q_].x, BA[q_].y, BA[q_].z, BA[q_].w, BB[q_].x, BB[q_].y}, 1.0f)
__device__ __forceinline__ void p6a_down(Frame& F) {
    const int lane = F.lane, gq = lane >> 3, s = lane & 7, x = F.bid & 7, wsl = (F.bid >> 3) * NWAVES + F.wave, nws = (F.G >> 3) * NWAVES;
    const unsigned char* TAB = F.ws + WS_ED + (size_t)x * NEXP * 192;
    const int* IDX = (const int*)(F.ws + WS_IDX); const float* ssq = (const float*)(F.ws + WS_SSQ); float* U = (float*)(F.ws + WS_U) + (size_t)x * T * 128;
    int t = wsl; if (t >= T) return;
    f32x4 hc[8], hx[8]; float sq, sqn = 0.f, r2; int idA, idB, idAn = 0, idBn = 0;
#define P6A_FETCH(HH, SQ_, TT, IA_, IB_) do { const float* hr_ = F.out + (size_t)(TT) * DM; _Pragma("unroll") for (int i = 0; i < 8; ++i) HH[i] = ((const f32x4*)hr_)[64 * x + 8 * s + i]; \
        SQ_ = __hip_atomic_load(ssq + (TT), __ATOMIC_RELAXED, __HIP_MEMORY_SCOPE_AGENT); IA_ = IDX[(size_t)(TT) * 128 + lane]; IB_ = IDX[(size_t)(TT) * 128 + 64 + lane]; } while (0)
#define P6S_DOT1(BA, BB, q_, IT_) do { const f32x32 w_ = P6S_DEC(BA, BB, q_); float p0_ = 0.f, p1_ = 0.f; \
        _Pragma("unroll") for (int i = 0; i < 8; ++i) { p0_ += hc[i][0] * w_[4 * i]; p1_ += hc[i][1] * w_[4 * i + 1]; p0_ += hc[i][2] * w_[4 * i + 2]; p1_ += hc[i][3] * w_[4 * i + 3]; } \
        const float d_ = g8_sum(p0_ + p1_) * r2; if (s == 0) U[(size_t)t * 128 + gq + 8 * (IT_)] = d_; \
        __builtin_amdgcn_sched_barrier(0); } while (0)
#define P6S_DOTS(BA, BB, IT0) do { P6S_DOT1(BA, BB, 0, (IT0)); P6S_DOT1(BA, BB, 1, (IT0) + 1); P6S_DOT1(BA, BB, 2, (IT0) + 2); P6S_DOT1(BA, BB, 3, (IT0) + 3); } while (0)
    P6A_FETCH(hc, sq, t, idA, idB); r2 = 1.0f / sqrtf(sq * (1.0f / DM) + EPS);
    int tn = t + nws; if (tn < T) P6A_FETCH(hx, sqn, tn, idAn, idBn);
    v4u A0[4], B0[4]; u32x2 A1[4], B1[4];
    P6S_LOADN(A0, A1, 4, TAB, 0, idA, idB);
#pragma unroll 1
    for (;;) {
        P6S_LOADN(B0, B1, 4, TAB, 4, idA, idB); P6S_DOTS(A0, A1, 0);
        P6S_LOADN(A0, A1, 4, TAB, 8, idA, idB); P6S_DOTS(B0, B1, 4);
        P6S_LOADN(B0, B1, 4, TAB, 12, idA, idB); P6S_DOTS(A0, A1, 8);
        const bool more = tn < T;
        if (more) P6S_LOADN(A0, A1, 4, TAB, 0, idAn, idBn);
        P6S_DOTS(B0, B1, 12);
        if (!more) break;
        t = tn; idA = idAn; idB = idBn; r2 = 1.0f / sqrtf(sqn * (1.0f / DM) + EPS);
#pragma unroll
        for (int i = 0; i < 8; ++i) hc[i] = hx[i];
        tn += nws; if (tn < T) P6A_FETCH(hx, sqn, tn, idAn, idBn);
    }
#undef P6S_DOTS
#undef P6S_DOT1
#undef P6A_FETCH
}
__device__ __forceinline__ void p6b_up(Frame& F) {
    const int lane = F.lane, gq = lane >> 3, s = lane & 7, x = F.bid & 7, wsl = (F.bid >> 3) * NWAVES + F.wave, nws = (F.G >> 3) * NWAVES;
    const unsigned char* TAB = F.ws + WS_EU + (size_t)x * NEXP * 192;
    const int* IDX = (const int*)(F.ws + WS_IDX); const float* GATE = (const float*)(F.ws + WS_GATE); const float* ESC = (const float*)(F.ws + WS_ESC);
    const float* U = (const float*)(F.ws + WS_U); float* ssz = (float*)(F.ws + WS_SSZ);
    int t = wsl; if (t >= T) return;
    int idA, idB, idAn = 0, idBn = 0; float cA, cB, gAn = 0.f, gBn = 0.f, uAn = 0.f, uBn = 0.f, sdA = 0.f, sdB = 0.f, suA = 0.f, suB = 0.f; f32x4 h4, h4n = {0.f, 0.f, 0.f, 0.f};
    const size_t zoff = 256 * x + 32 * s + 4 * gq;
#define P6B_FETCH1(TT) do { idAn = IDX[(size_t)(TT) * 128 + lane]; idBn = IDX[(size_t)(TT) * 128 + 64 + lane]; gAn = GATE[(size_t)(TT) * 128 + lane]; gBn = GATE[(size_t)(TT) * 128 + 64 + lane]; \
        uAn = 0.f; uBn = 0.f; _Pragma("unroll") for (int xx = 0; xx < 8; ++xx) { uAn += U[((size_t)xx * T + (TT)) * 128 + lane]; uBn += U[((size_t)xx * T + (TT)) * 128 + 64 + lane]; } \
        h4n = *(const f32x4*)(F.out + (size_t)(TT) * DM + zoff); } while (0)
#define P6B_FETCH2() do { sdA = ESC[idAn]; sdB = ESC[idBn]; suA = ESC[NEXP + idAn]; suB = ESC[NEXP + idBn]; } while (0)
#define P6B_COEF() do { cA = gAn * gelu_erf(uAn * sdA) * suA; cB = gBn * gelu_erf(uBn * sdB) * suB; } while (0)
#define P6_PIN16(Y, B_) asm volatile("" : "+v"(Y[B_]), "+v"(Y[B_ + 1]), "+v"(Y[B_ + 2]), "+v"(Y[B_ + 3]), "+v"(Y[B_ + 4]), "+v"(Y[B_ + 5]), "+v"(Y[B_ + 6]), "+v"(Y[B_ + 7]), \
        "+v"(Y[B_ + 8]), "+v"(Y[B_ + 9]), "+v"(Y[B_ + 10]), "+v"(Y[B_ + 11]), "+v"(Y[B_ + 12]), "+v"(Y[B_ + 13]), "+v"(Y[B_ + 14]), "+v"(Y[B_ + 15]))
#define P6S_AXPY1(BA, BB, q_, IT_, NXT_) do { const float ce_ = __shfl(((IT_) < 8) ? cA : cB, gq + 8 * ((IT_) & 7)); \
        const f32x32 w_ = P6S_DEC(BA, BB, q_); _Pragma("unroll") for (int i = 0; i < 32; ++i) y[i] += ce_ * w_[i]; \
        P6_PIN16(y, 0); P6_PIN16(y, 16); asm volatile("" : "+v"(NXT_)); } while (0)
#define P6S_AXPY(BA, BB, IT0) do { P6S_AXPY1(BA, BB, 0, (IT0), BA[1].x); P6S_AXPY1(BA, BB, 1, (IT0) + 1, pin_); } while (0)
    P6B_FETCH1(t); P6B_FETCH2(); P6B_COEF(); idA = idAn; idB = idBn; h4 = h4n;
    int tn = t + nws; if (tn < T) P6B_FETCH1(tn);
    v4u A0[2], B0[2]; u32x2 A1[2], B1[2];
    P6S_LOADN(A0, A1, 2, TAB, 0, idA, idB);
    const bool b2 = (gq & 4) != 0, b1 = (gq & 2) != 0, b0 = (gq & 1) != 0; int pin_ = 0;
#pragma unroll 1
    for (;;) {
        float y[32];
#pragma unroll
        for (int i = 0; i < 32; ++i) y[i] = 0.f;
        const bool more = tn < T;
        P6S_LOADN(B0, B1, 2, TAB, 2, idA, idB); P6S_AXPY(A0, A1, 0);
        P6S_LOADN(A0, A1, 2, TAB, 4, idA, idB); P6S_AXPY(B0, B1, 2);
        if (more) P6B_FETCH2();
        P6S_LOADN(B0, B1, 2, TAB, 6, idA, idB); P6S_AXPY(A0, A1, 4);
        P6S_LOADN(A0, A1, 2, TAB, 8, idA, idB); P6S_AXPY(B0, B1, 6);
        P6S_LOADN(B0, B1, 2, TAB, 10, idA, idB); P6S_AXPY(A0, A1, 8);
        P6S_LOADN(A0, A1, 2, TAB, 12, idA, idB); P6S_AXPY(B0, B1, 10);
        P6S_LOADN(B0, B1, 2, TAB, 14, idA, idB); P6S_AXPY(A0, A1, 12);
        if (more) P6S_LOADN(A0, A1, 2, TAB, 0, idAn, idBn);
        P6S_AXPY(B0, B1, 14);
        float k16[16], k8[8], k4[4];
#pragma unroll
        for (int j = 0; j < 16; ++j) { const float keep = b2 ? y[16 + j] : y[j], send = b2 ? y[j] : y[16 + j]; k16[j] = keep + __shfl_xor(send, 32); }
#pragma unroll
        for (int j = 0; j < 8; ++j) { const float keep = b1 ? k16[8 + j] : k16[j], send = b1 ? k16[j] : k16[8 + j]; k8[j] = keep + __shfl_xor(send, 16); }
#pragma unroll
        for (int j = 0; j < 4; ++j) { const float keep = b0 ? k8[4 + j] : k8[j], send = b0 ? k8[j] : k8[4 + j]; k4[j] = keep + __shfl_xor(send, 8); }
        const f32x4 z = {h4[0] + k4[0], h4[1] + k4[1], h4[2] + k4[2], h4[3] + k4[3]};
        *(f32x4*)(F.out + (size_t)t * DM + zoff) = z;
        const float ss = wave_sum((z[0] * z[0] + z[1] * z[1]) + (z[2] * z[2] + z[3] * z[3]));
        if (lane == 0) atomicAdd(ssz + t, ss);
        if (!more) break;
        P6B_COEF(); t = tn; idA = idAn; idB = idBn; h4 = h4n;
        tn += nws; if (tn < T) P6B_FETCH1(tn);
    }
#undef P6B_FETCH1
#undef P6B_FETCH2
#undef P6B_COEF
#undef P6S_AXPY
#undef P6S_AXPY1
#undef P6_PIN16
}
#undef P6S_LOADN
#undef P6S_DEC
__device__ __forceinline__ void p6c_norm(Frame& F) {
    const int lane = F.lane; const float* ssz = (const float*)(F.ws + WS_SSZ);
    for (int t = F.gw; t < T; t += F.NGW) {
        f32x4* row = (f32x4*)(F.out + (size_t)t * DM);
        const float rf = 1.0f / sqrtf(__hip_atomic_load(ssz + t, __ATOMIC_RELAXED, __HIP_MEMORY_SCOPE_AGENT) * (1.0f / DM) + EPS);
#pragma unroll
        for (int i = 0; i < 8; ++i) row[64 * i + lane] = row[64 * i + lane] * rf * ((const f32x4*)F.final_norm)[64 * i + lane];
    }
}
#define TRP(p) ((((p) & 7) << 4) + ((p) >> 3))
#define P6_ID(E0, E1, IT) (int)(((IT) & 1) ? (((IT) < 8 ? (E0) : (E1))[((IT) & 7) >> 1] >> 16) : (((IT) < 8 ? (E0) : (E1))[((IT) & 7) >> 1] & 0xffffu))
__device__ __forceinline__ void p6_rot(Frame& F) {
    const int lane = opq(F.lane), gq = lane >> 3, s = lane & 7, x0 = F.bid & 7;
    const int* IDX = (const int*)(F.ws + WS_IDX); const float* GATE = (const float*)(F.ws + WS_GATE); const float* ESC = (const float*)(F.ws + WS_ESC); const float* ssq = (const float*)(F.ws + WS_SSQ);
    typedef _Float16 h16x4 __attribute__((ext_vector_type(4)));
    LAS unsigned char* wl = F.lds + F.wave * 19520;
    LAS _Float16* LZ = (LAS _Float16*)wl;
    LAS unsigned short* LID = (LAS unsigned short*)(wl + 16384);
    LAS float* LDOT = (LAS float*)(wl + 17408);
    LAS float* LSS = (LAS float*)(wl + 19456);
    LAS float* LHS = (LAS float*)(wl + 19472);
    LAS unsigned char* LZ8 = wl;
    const unsigned char* HB8 = F.ws + WS_HB8;
#pragma unroll 1
    for (int tbase = F.gw; tbase < T; tbase += 4 * F.NGW) {
#pragma unroll
    for (int j = 0; j < 4; ++j) { const int t = tbase + F.NGW * j; const bool ok = t < T;
        LID[j * 128 + TRP(lane)] = (unsigned short)(ok ? IDX[(size_t)t * 128 + lane] : 0); LID[j * 128 + TRP(64 + lane)] = (unsigned short)(ok ? IDX[(size_t)t * 128 + 64 + lane] : 0);
        LDOT[j * 128 + lane] = 0.f; LDOT[j * 128 + 64 + lane] = 0.f; if (lane == 0) LSS[j] = 0.f;
        if (ok) {
            if (lane == 0) LHS[j] = 1.0f / P5_HS;
#pragma unroll
            for (int i = 0; i < 4; ++i) *(LAS u32x2*)(LZ8 + j * 2048 + 8 * (64 * i + lane)) = ((const u32x2*)(HB8 + (size_t)t * DM))[64 * i + lane];
        } }
    LDS_WAIT(); asm volatile("" ::: "memory");
#define P6R_LOAD(BA, BB, TAB, IT0) do { _Pragma("unroll") for (int q_ = 0; q_ < 4; ++q_) { const int it_ = (IT0) + q_; const int e_ = __shfl((it_ < 8) ? idA : idB, gq + 8 * (it_ & 7)); \
        const unsigned char* rp_ = (TAB) + (size_t)e_ * 192; BA[q_] = *(const U3*)(rp_ + 12 * s); BB[q_] = *(const U3*)(rp_ + 96 + 12 * s); } } while (0)
#define P6R_DEC(BA, BB, q_) __builtin_amdgcn_cvt_scalef32_pk32_f32_fp6((u32x6){BA[q_].a, BA[q_].b, BA[q_].c, BB[q_].a, BB[q_].b, BB[q_].c}, 1.0f)
    {
    LAS int* LDI = (LAS int*)LDOT;
#define P6I_LOAD(S, TB, IDA, IDB, IT0) do { _Pragma("unroll") for (int q_ = 0; q_ < 8; ++q_) { const int e_ = P6_ID(IDA, IDB, (IT0) + q_); \
        S[q_] = *(const v4u*)((TB) + (size_t)e_ * 128); } __builtin_amdgcn_sched_barrier(0); } while (0)
#define P6I_DOT(S, IT0) do { _Pragma("unroll") for (int q_ = 0; q_ < 8; ++q_) { int a0_ = 0, a1_ = 0; \
        a0_ = __builtin_amdgcn_sdot4((int)S[q_].x, (int)hq.x, a0_, false); a1_ = __builtin_amdgcn_sdot4((int)S[q_].y, (int)hq.y, a1_, false); \
        a0_ = __builtin_amdgcn_sdot4((int)S[q_].z, (int)hq.z, a0_, false); a1_ = __builtin_amdgcn_sdot4((int)S[q_].w, (int)hq.w, a1_, false); \
        int v_ = a0_ + a1_; v_ += dppi<0xB1>(v_); v_ += dppi<0x4E>(v_); v_ += dppi<0x141>(v_); \
        if (s == 0 && okc) (void)__hip_atomic_fetch_add(LDI + j * 128 + gq * 16 + (IT0) + q_, v_, __ATOMIC_RELAXED, __HIP_MEMORY_SCOPE_WORKGROUP); } \
        __builtin_amdgcn_sched_barrier(0); } while (0)
    v4u SA[8], SB[8]; v4u idA, idB; const unsigned char* TAB;
    {
        const int xs = (2 * x0) & 15; TAB = F.ws + WS_ED + (size_t)xs * NEXP * 128 + 16 * s;
        idA = *(const LAS v4u*)(LID + gq * 16); idB = *(const LAS v4u*)(LID + gq * 16 + 8);
        P6I_LOAD(SA, TAB, idA, idB, 0);
    }
#pragma unroll 1
    for (int n = 0; n < 64; ++n) {
        const int j = n & 3, xs = (2 * x0 + (n >> 2)) & 15; const bool okc = (tbase + F.NGW * j) < T;
        const v4u hq = *(const LAS v4u*)(LZ8 + j * 2048 + 128 * xs + 16 * s);
        const int n1 = n < 63 ? n + 1 : 63, j1 = n1 & 3, xs1 = (2 * x0 + (n1 >> 2)) & 15;
        const unsigned char* TAB1 = F.ws + WS_ED + (size_t)xs1 * NEXP * 128 + 16 * s;
        const v4u idA1 = *(const LAS v4u*)(LID + j1 * 128 + gq * 16), idB1 = *(const LAS v4u*)(LID + j1 * 128 + gq * 16 + 8);
        P6I_LOAD(SB, TAB, idA, idB, 8);
        P6I_DOT(SA, 0);
        P6I_LOAD(SA, TAB1, idA1, idB1, 0);
        P6I_DOT(SB, 8);
        idA = idA1; idB = idB1; TAB = TAB1;
    }
#undef P6I_LOAD
#undef P6I_DOT
    }
    LDS_WAIT(); asm volatile("" ::: "memory");
#pragma unroll 1
    for (int j = 0; j < 4; ++j) {
        const int t = tbase + F.NGW * j; if (t >= T) break;
        const float r2 = 1.0f / sqrtf(__hip_atomic_load(ssq + t, __ATOMIC_RELAXED, __HIP_MEMORY_SCOPE_AGENT) * (1.0f / DM) + EPS);
        const int idA = LID[j * 128 + TRP(lane)], idB = LID[j * 128 + TRP(64 + lane)];
        const float hr = LHS[j] * r2;
        const float cA = GATE[(size_t)t * 128 + lane] * gelu_erf((float)((LAS int*)LDOT)[j * 128 + TRP(lane)] * hr * ESC[idA]) * ESC[NEXP + idA];
        const float cB = GATE[(size_t)t * 128 + 64 + lane] * gelu_erf((float)((LAS int*)LDOT)[j * 128 + TRP(64 + lane)] * hr * ESC[idB]) * ESC[NEXP + idB];
        LDOT[j * 128 + TRP(lane)] = cA; LDOT[j * 128 + TRP(64 + lane)] = cB;
    }
    LDS_WAIT(); asm volatile("" ::: "memory");
    const bool b0 = (gq & 1) != 0; int pin_ = 0;
    {
#define P6R_LOADI(BA, BB, TAB, IT0, IDA, IDB) do { _Pragma("unroll") for (int q_ = 0; q_ < 4; ++q_) { const int e_ = P6_ID(IDA, IDB, (IT0) + q_); \
        const unsigned char* rp_ = (TAB) + (size_t)e_ * 192; BA[q_] = *(const U3*)(rp_ + 12 * s); BB[q_] = *(const U3*)(rp_ + 96 + 12 * s); } } while (0)
#define P6R_PIN16(Y, B_) asm volatile("" : "+v"(Y[B_]), "+v"(Y[B_ + 1]), "+v"(Y[B_ + 2]), "+v"(Y[B_ + 3]), "+v"(Y[B_ + 4]), "+v"(Y[B_ + 5]), "+v"(Y[B_ + 6]), "+v"(Y[B_ + 7]))
#define P6R_AXPY1(BA, BB, q_, IT_, NXT_) do { const float ce_ = cev[(IT_) >> 2][(IT_) & 3]; \
        const f32x32 w_ = P6R_DEC(BA, BB, q_); const f32x2 ce2_ = {ce_, ce_}; _Pragma("unroll") for (int i = 0; i < 16; ++i) y2[i] = __builtin_elementwise_fma((f32x2){w_[2 * i], w_[2 * i + 1]}, ce2_, y2[i]); \
        P6R_PIN16(y2, 0); P6R_PIN16(y2, 8); asm volatile("" : "+v"(NXT_)); } while (0)
#define P6R_AXPY(BA, BB, IT0) do { P6R_AXPY1(BA, BB, 0, (IT0), BA[1].a); P6R_AXPY1(BA, BB, 1, (IT0) + 1, BA[2].a); P6R_AXPY1(BA, BB, 2, (IT0) + 2, BA[3].a); P6R_AXPY1(BA, BB, 3, (IT0) + 3, pin_); } while (0)
    U3 A0[4], B0[4], A1[4], B1[4];
    v4u idA, idB; const unsigned char* TAB; unsigned hqn;
    {
        const int x = x0 & 7; TAB = F.ws + WS_EU + (size_t)x * NEXP * 192;
        idA = *(const LAS v4u*)(LID + gq * 16); idB = *(const LAS v4u*)(LID + gq * 16 + 8);
        hqn = *(const unsigned*)(HB8 + (size_t)tbase * DM + 256 * x + 32 * s + 4 * gq);
        P6R_LOADI(A0, A1, TAB, 0, idA, idB);
    }
#pragma unroll 1
    for (int n = 0; n < 32; ++n) {
        const int j = n & 3, x = (x0 + (n >> 2)) & 7; const bool okc = (tbase + F.NGW * j) < T;
        const f32x4 h4 = {(float)((int)(hqn << 24) >> 24) * (1.0f / P5_HS), (float)((int)(hqn << 16) >> 24) * (1.0f / P5_HS), (float)((int)(hqn << 8) >> 24) * (1.0f / P5_HS), (float)((int)hqn >> 24) * (1.0f / P5_HS)};
        f32x4 cev[4];
#pragma unroll
        for (int i = 0; i < 4; ++i) cev[i] = *(const LAS f32x4*)(LDOT + j * 128 + gq * 16 + 4 * i);
        const int n1 = n < 31 ? n + 1 : 31, j1 = n1 & 3, x1 = (x0 + (n1 >> 2)) & 7; const int t1 = (tbase + F.NGW * j1) < T ? tbase + F.NGW * j1 : tbase;
        const unsigned char* TAB1 = F.ws + WS_EU + (size_t)x1 * NEXP * 192;
        const v4u idA1 = *(const LAS v4u*)(LID + j1 * 128 + gq * 16), idB1 = *(const LAS v4u*)(LID + j1 * 128 + gq * 16 + 8);
        f32x2 y2[16];
#pragma unroll
        for (int i = 0; i < 16; ++i) y2[i] = (f32x2){0.f, 0.f};
        P6R_LOADI(B0, B1, TAB, 4, idA, idB);
        hqn = *(const unsigned*)(HB8 + (size_t)t1 * DM + 256 * x1 + 32 * s + 4 * gq);
        P6R_AXPY(A0, A1, 0);
        P6R_LOADI(A0, A1, TAB, 8, idA, idB); P6R_AXPY(B0, B1, 4);
        P6R_LOADI(B0, B1, TAB, 12, idA, idB); P6R_AXPY(A0, A1, 8);
        P6R_LOADI(A0, A1, TAB1, 0, idA1, idB1); P6R_AXPY(B0, B1, 12);
        idA = idA1; idB = idB1; TAB = TAB1;
        float y[32], k16[16], k8[8], k4[4];
#pragma unroll
        for (int i = 0; i < 16; ++i) { y[2 * i] = y2[i].x; y[2 * i + 1] = y2[i].y; }
#pragma unroll
        for (int i = 0; i < 16; ++i) { const auto r_ = __builtin_amdgcn_permlane32_swap(__float_as_uint(y[i]), __float_as_uint(y[16 + i]), false, false); k16[i] = __uint_as_float(r_[0]) + __uint_as_float(r_[1]); }
#pragma unroll
        for (int i = 0; i < 8; ++i) { const auto r_ = __builtin_amdgcn_permlane16_swap(__float_as_uint(k16[i]), __float_as_uint(k16[8 + i]), false, false); k8[i] = __uint_as_float(r_[0]) + __uint_as_float(r_[1]); }
#pragma unroll
        for (int i = 0; i < 4; ++i) { const float keep = b0 ? k8[4 + i] : k8[i], send = b0 ? k8[i] : k8[4 + i]; k4[i] = keep + dppf<0x128>(send); }
        const f32x4 z = {h4[0] + k4[0], h4[1] + k4[1], h4[2] + k4[2], h4[3] + k4[3]};
        if (okc) *(LAS h16x4*)(LZ + j * 2048 + 256 * x + 32 * s + 4 * gq) = (h16x4){(_Float16)z[0], (_Float16)z[1], (_Float16)z[2], (_Float16)z[3]};
        const float ss = wave_sum_fast((z[0] * z[0] + z[1] * z[1]) + (z[2] * z[2] + z[3] * z[3]));
        if (lane == 0 && okc) LSS[j] = LSS[j] + ss;
    }
#undef P6R_AXPY
#undef P6R_AXPY1
#undef P6R_PIN16
#undef P6R_LOADI
    }
#undef P6R_LOAD
#undef P6R_DEC
    LDS_WAIT(); asm volatile("" ::: "memory");
#pragma unroll 1
    for (int j = 0; j < 4; ++j) {
        const int t = tbase + F.NGW * j; if (t >= T) break;
        f32x4* row = (f32x4*)(F.out + (size_t)t * DM);
        const float rf = 1.0f / sqrtf(LSS[j] * (1.0f / DM) + EPS);
#pragma unroll
        for (int i = 0; i < 8; ++i) { const h16x4 zv = *(const LAS h16x4*)(LZ + j * 2048 + 256 * i + 4 * lane); const f32x4 w = ((const f32x4*)F.final_norm)[64 * i + lane];
            row[64 * i + lane] = (f32x4){(float)zv[0] * rf * w[0], (float)zv[1] * rf * w[1], (float)zv[2] * rf * w[2], (float)zv[3] * rf * w[3]}; }
    }
    asm volatile("s_waitcnt vmcnt(0) lgkmcnt(0)" ::: "memory");
    }
}
typedef unsigned gu32;
#define XB_TMO      128
#define XB_XCNT(j)  (256  + 64 * (j))
#define XB_XSUB(j)  (1280 + 64 * (j))
#define XB_XGEN(j)  (2304 + 64 * (j))
#define XB_TOP      3328
#define XB_TOPGEN   3392
#define XCD_BAR_WORDS 3456
#define XB_SPIN_CAP (1u << 18)

__device__ __forceinline__ unsigned xb_ld(unsigned* p)              { return __hip_atomic_load(p, __ATOMIC_RELAXED, __HIP_MEMORY_SCOPE_AGENT); }
__device__ __forceinline__ unsigned xb_add(unsigned* p, unsigned v) { return __hip_atomic_fetch_add(p, v, __ATOMIC_RELAXED, __HIP_MEMORY_SCOPE_AGENT); }
__device__ __forceinline__ unsigned xb_xcc_id() { return (unsigned)__builtin_amdgcn_s_getreg((3 << 11) | 20) & 0xFu; }
#define XB_SPIN(cond, bar) do { unsigned _sp = 0; while (cond) { __builtin_amdgcn_s_sleep(1); \
    if ((++_sp & 255u) == 0u) { if (xb_ld(&(bar)[XB_TMO])) break; if (_sp > XB_SPIN_CAP) { atomicAdd(&(bar)[XB_TMO], 1u); break; } } } } while (0)

struct XcdBarrier {
    unsigned* bar; unsigned x;
    volatile LAS unsigned* st;
};

__device__ __forceinline__ XcdBarrier xcd_barrier_post(unsigned* bar, volatile LAS unsigned* st) {
    XcdBarrier b; b.bar = bar; b.x = xb_xcc_id(); b.st = st;
    if (threadIdx.x == 0) (void)xb_add(&bar[XB_XCNT(b.x)], 1u);
    return b;
}
__device__ __forceinline__ void xcd_barrier_complete(unsigned* bar, unsigned x, unsigned& nloc, unsigned& nx) {
    const unsigned G = gridDim.x * gridDim.y * gridDim.z;
    unsigned sum, cnt, mine, sp = 0u;
    for (;;) {
        sum = 0u; cnt = 0u; mine = 0u;
#pragma unroll
        for (unsigned j = 0; j < 16; ++j) { const unsigned c = xb_ld(&bar[XB_XCNT(j)]); sum += c; cnt += (c > 0u) ? 1u : 0u; mine = (j == x) ? c : mine; }
        if (sum == G) break;
        __builtin_amdgcn_s_sleep(1);
        if ((++sp & 255u) == 0u) { if (xb_ld(&bar[XB_TMO])) break; if (sp > XB_SPIN_CAP) { atomicAdd(&bar[XB_TMO], 1u); break; } }
    }
    nloc = mine > 0u ? mine : 1u; nx = cnt > 0u ? cnt : 1u;
}

__device__ __forceinline__ void xcd_barrier(const XcdBarrier& b) {
    asm volatile("s_waitcnt vmcnt(0)" ::: "memory");
    __syncthreads();
    if (threadIdx.x == 0) {
        unsigned* bar = b.bar;
        __builtin_amdgcn_s_waitcnt(0);
        unsigned nloc = b.st[0], nx = b.st[1];
        if (nloc == 0u) { xcd_barrier_complete(bar, b.x, nloc, nx); b.st[0] = nloc; b.st[1] = nx; }
        const unsigned old = xb_add(&bar[XB_XSUB(b.x)], 1u);
        const unsigned gen = old / nloc;
        if (old + 1u == (gen + 1u) * nloc) {
            __builtin_amdgcn_fence(__ATOMIC_RELEASE, "agent");
            asm volatile("s_waitcnt vmcnt(0)" ::: "memory");
            const unsigned og = xb_add(&bar[XB_TOP], 1u);
            const unsigned tg = og / nx;
            if (og + 1u == (tg + 1u) * nx) xb_add(&bar[XB_TOPGEN], 1u);
            else XB_SPIN(xb_ld(&bar[XB_TOPGEN]) == tg, bar);
            __builtin_amdgcn_fence(__ATOMIC_ACQUIRE, "agent");
            xb_add(&bar[XB_XGEN(b.x)], 1u);
            asm volatile("s_waitcnt vmcnt(0)" ::: "memory");
        } else {
            XB_SPIN(xb_ld(&bar[XB_XGEN(b.x)]) == gen, bar);
            __builtin_amdgcn_fence(__ATOMIC_ACQUIRE, "agent");
            asm volatile("s_waitcnt vmcnt(0)" ::: "memory");
        }
    }
    __syncthreads();
}

constexpr int NPH = 10;
struct Args { const float* in[13]; float* out; unsigned char* ws; int ph_lo, ph_hi; };
__global__ void __launch_bounds__(NWAVES * 64, 2) mk_fwd(Args a) {
    extern __shared__ __attribute__((aligned(16))) unsigned char lds[];
    cg::grid_group grid = cg::this_grid();
    Frame F;
    F.lds = (LAS unsigned char*)lds; F.tid = threadIdx.x; F.lane = F.tid & 63; F.wave = __builtin_amdgcn_readfirstlane(F.tid >> 6);
    F.G = gridDim.x; F.bid = blockIdx.x; F.gw = F.bid * NWAVES + F.wave; F.NGW = F.G * NWAVES;
    F.x = a.in[0]; F.attn_norm = a.in[1]; F.w_in = a.in[2]; F.sinks = a.in[3]; F.w_attn = a.in[4]; F.w_ret = a.in[5]; F.w_out = a.in[6]; F.ffn_norm = a.in[7];
    F.w_q = a.in[8]; F.sub_keys = a.in[9]; F.e_down = a.in[10]; F.e_up = a.in[11]; F.final_norm = a.in[12]; F.out = a.out; F.ws = a.ws;
    unsigned char* ws = a.ws;
    const int lo = a.ph_lo, hi = a.ph_hi;
#define IN(k) (lo <= (k) && (k) < hi)
    volatile LAS unsigned* MISC = (volatile LAS unsigned*)(F.lds + LDS_BYTES - 256);
    if (F.tid < 32) MISC[F.tid] = 0u;
    __syncthreads();
    XcdBarrier xbar = xcd_barrier_post((unsigned*)(ws + 16384), MISC + 8);
#define SEAM(k) do { if (IN(k) && IN((k) + 1)) { if (lo < 0) grid.sync(); else xcd_barrier(xbar); } } while (0)
    pg8::bf16_t* PROJ = (pg8::bf16_t*)(ws + WS_PROJ);
    float* KV = F.out;
    if (IN(0)) { if (PEER_FP8 == 3) p0_experts_fp6s(F, 0, 2 * NEXP - p0_defer_rows(F.G), F.gw, F.NGW); p0_prologue(F); if (PEER_FP8 == 1) p0_experts_fp8(F); if (PEER_FP8 == 2) p0_experts_fp6(F); }
    SEAM(0);
    if (IN(1)) {
        pg8::Gemm g{(const pg8::bf16_t*)(ws + WS_XB), (const pg8::bf16_t*)(ws + WS_WIN), T, NPROJ, GEMM1_FP8 ? DM / 2 : DM}; pg8::StaticOrder S; S.init(T, NPROJ, F.G, F.bid); S.ilv = ((NPROJ / 256) % 2 == 0) ? 1 + 22 : 0;
        pg8::EpiProj E{PROJ, (const float*)(ws + WS_R1), (const pg8::f32x4*)(ws + WS_ROPE), (GEMM1_FP8 && !GEMM1_I8) ? 1.0f / (G1_XS * G1_WS) : 0.0f};
        pg8::gemm_phase<pg8::EpiProj, pg8::StaticOrder, true, true, (GEMM1_FP8 ? (GEMM1_I8 ? 2 : 1) : 0)>(F.lds, g, S, E);
        const int tailc = ((T / 256) * (NPROJ / 256)) % F.G;
        if (PEER_FP8 == 3 && IN(0) && tailc != 0 && F.bid >= tailc) { __syncthreads(); p0_experts_fp6s(F, 2 * NEXP - P0_DEFER, 2 * NEXP, (F.bid - tailc) * NWAVES + F.wave, (F.G - tailc) * NWAVES); }
    }
    SEAM(1);
    if (IN(2)) { p2_attn_mfma(F); p2_kv_mfma(F, KV); }
    SEAM(2);
    if (IN(3)) p2_scan(F, KV);
    SEAM(3);
    if (IN(4)) p2_retout_mfma(F, KV);
    SEAM(4);
    if (IN(5)) {
        constexpr float p3fix = P3_FP8 ? 1.0f / (P3_AS * G1_WS) : 1.0f;
#if P3_FUSED
        { pg8::Gemm g{(const pg8::bf16_t*)(ws + WS_AO), (const pg8::bf16_t*)(ws + WS_WA), T, DM, 3072 / 2}; pg8::StaticOrder S; S.init(T, DM, F.G, F.bid);
          pg8::EpiMerge E{PROJ, C_GA, C_GT, (pg8::bf16_t*)(ws + WS_MG8), p3fix, P4_FP8 ? P3_AS : 0.0f};
          pg8::gemm_phase<pg8::EpiMerge, pg8::StaticOrder, true, true, true>(F.lds, g, S, E); }
#else
        { pg8::Gemm g{(const pg8::bf16_t*)(ws + WS_AO), (const pg8::bf16_t*)(ws + WS_WA), T, DM, P3_FP8 ? 512 : 1024}; pg8::StaticOrder S; S.init(T, DM, F.G, F.bid);
          pg8::EpiGate1 E{(pg8::bf16_t*)F.out, PROJ, C_GA, p3fix};
          pg8::gemm_phase<pg8::EpiGate1, pg8::StaticOrder, true, true, (P3_FP8 != 0)>(F.lds, g, S, E); }
        { pg8::Gemm g{(const pg8::bf16_t*)(ws + WS_RO), (const pg8::bf16_t*)(ws + WS_WR), T, DM, P3_FP8 ? DM / 2 : DM}; pg8::StaticOrder S; S.init(T, DM, F.G, F.bid);
          pg8::EpiGate2 E{(const pg8::bf16_t*)F.out, PROJ, C_GT, (pg8::bf16_t*)(ws + WS_XB), p3fix, P4_FP8 ? P3_AS : 0.0f};
          pg8::gemm_phase<pg8::EpiGate2, pg8::StaticOrder, true, true, (P3_FP8 != 0)>(F.lds, g, S, E); }
#endif
    }
    SEAM(5);
    if (IN(6)) {
        pg8::Gemm g{(const pg8::bf16_t*)(ws + WS_MG8), (const pg8::bf16_t*)(ws + WS_WO), T, DM, P4_FP8 ? DM / 2 : DM}; pg8::StaticOrder S; S.init(T, DM, F.G, F.bid);
        pg8::EpiHres E{ws + WS_XB, (const float*)(ws + WS_XS), (pg8::bf16_t*)(ws + WS_AO), (float*)(ws + WS_SSQ), P4_FP8 ? 1.0f / (P3_AS * G1_WS) : 1.0f, P5_I8 ? P5_HS : 0.0f};
        pg8::gemm_phase<pg8::EpiHres, pg8::StaticOrder, true, true, (P4_FP8 != 0)>(F.lds, g, S, E);
    }
    SEAM(6);
    if (IN(7)) {
        pg8::Gemm g{(const pg8::bf16_t*)(ws + (P5_I8 ? WS_HB8 : WS_AO)), (const pg8::bf16_t*)(ws + WS_WQ), T, DM, P5_I8 ? DM / 2 : DM};
        constexpr float p5fix = P5_I8 ? 1.0f / (P5_HS * I8_WS) : 1.0f;
        if (F.G == (T / 256) * (DM / 256)) {
            pg8::StaticOrder S; S.init(T, DM, F.G, F.bid);
            EpiQryLds E{F, (const float*)(ws + WS_SSQ), p5fix};
            pg8::gemm_phase<EpiQryLds, pg8::StaticOrder, true, true, (P5_I8 ? 2 : 0)>(F.lds, g, S, E);
        } else {
        pg8::StaticOrder S; S.init(T, DM, F.G, F.bid);
        pg8::EpiQry E{PROJ, (const float*)(ws + WS_SSQ), p5fix};
        pg8::gemm_phase<pg8::EpiQry, pg8::StaticOrder, true, true, (P5_I8 ? 2 : 0)>(F.lds, g, S, E);
        asm volatile("s_waitcnt vmcnt(0)" ::: "memory"); __syncthreads();
        __builtin_amdgcn_fence(__ATOMIC_ACQUIRE, "agent"); asm volatile("s_waitcnt vmcnt(0)" ::: "memory"); __syncthreads();
        pg8::Unit uu; for (int i = 0; S.next(i, uu); ++i) p5_topk_v2(F, uu.pm, uu.pn);
        }
    }
    SEAM(8);
    if (PEER_FP8 == 3) {
        if (IN(9)) p6_rot(F);
    } else {
        if (IN(9)) { if (PEER_FP8 == 2) p6_peer_fp6(F); else p6_peer2<(PEER_FP8 == 1)>(F); }
    }
#undef IN
#undef SEAM
}
}

#ifndef MK_N_LAUNCHES
#define MK_N_LAUNCHES 1
#endif
extern "C" void kernel_launch(void* const* d_in, const int* in_sizes, int n_in, void* d_out, int out_size, void* d_ws, size_t ws_size, hipStream_t stream) {
    using namespace mk;
    static int grid = 0;
    if (grid == 0) {
        if (n_in != 13 || out_size != T * DM || ws_size < WS_END) { fprintf(stderr, "kernel_launch: unexpected problem (n_in %d, out %d, ws %zu)\n", n_in, out_size, ws_size); grid = -1; return; }
        int dev = 0, cus = 0, per_cu = 0;
        if (hipGetDevice(&dev) != hipSuccess || hipDeviceGetAttribute(&cus, hipDeviceAttributeMultiprocessorCount, dev) != hipSuccess) { grid = -1; return; }
        if (hipFuncSetAttribute((const void*)mk_fwd, hipFuncAttributeMaxDynamicSharedMemorySize, LDS_BYTES) != hipSuccess) { fprintf(stderr, "kernel_launch: hipFuncSetAttribute failed\n"); grid = -1; return; }
        if (hipOccupancyMaxActiveBlocksPerMultiprocessor(&per_cu, (const void*)mk_fwd, NWAVES * 64, LDS_BYTES) != hipSuccess || per_cu < 1) { fprintf(stderr, "kernel_launch: occupancy query says %d\n", per_cu); per_cu = 1; }
        (void)hipGetLastError();
        grid = cus * (per_cu < 1 ? 1 : per_cu);
        if (grid > 256) grid = 256;
    }
    if (grid < 0) return;
    (void)hipMemsetAsync((char*)d_ws + WS_CTL, 0, CTL_BYTES, stream);
    Args a{};
    for (int i = 0; i < 13; ++i) a.in[i] = (const float*)d_in[i];
    a.out = (float*)d_out; a.ws = (unsigned char*)d_ws;
#if MK_N_LAUNCHES == 1
    a.ph_lo = 0; a.ph_hi = NPH;
    void* args[] = {&a};
    hipError_t e = hipLaunchCooperativeKernel((const void*)mk_fwd, dim3(grid), dim3(NWAVES * 64), args, LDS_BYTES, stream);
    if (e != hipSuccess) fprintf(stderr, "kernel_launch: cooperative launch failed: %s (grid %d)\n", hipGetErrorString(e), grid);
#else
    for (int ph = 0; ph < NPH; ++ph) { a.ph_lo = ph; a.ph_hi = ph + 1; hipLaunchKernelGGL(mk_fwd, dim3(grid), dim3(NWAVES * 64), LDS_BYTES, stream, a); }
#endif
}
```
